# Optimizing an MI355X kernel written in HIP

```python
import jax, jax.numpy as jnp
from jax import lax
import numpy as np

D_MODEL = 1024
BATCH = 8
SEQ = 4096
DEPTH = 1

EPS = 1e-6
D_MIX = D_MODEL
GLA_HEADS = 4
GLA_DK = 64
GLA_DV = 128
GLA_GATE_RANK = 16
GLA_GATE_NORM = 16.0
GLA_CHUNK = 64
MLA_HEADS = 8
MLA_NOPE = 64
MLA_ROPE = 32
MLA_DV = 64
MLA_Q_RANK = 384
MLA_KV_RANK = 256
ROPE_THETA = 10000.0
Q_BLOCK = 128
N_GROUPS = 4
EXPERTS_PER_GROUP = 8
N_EXPERTS = N_GROUPS * EXPERTS_PER_GROUP
TOP_K = 2
D_EXPERT = 256
EXPERT_BLOCK = 128

IN_WIDTHS = (GLA_HEADS * GLA_DK, GLA_HEADS * GLA_DK, GLA_HEADS * GLA_DV, GLA_GATE_RANK,
             GLA_HEADS * GLA_DV, MLA_Q_RANK, MLA_KV_RANK, MLA_ROPE)
D_IN = 2 * GLA_HEADS * GLA_DK + 2 * GLA_HEADS * GLA_DV + GLA_GATE_RANK + MLA_Q_RANK + MLA_KV_RANK + MLA_ROPE

kernel_name = "hybrid_gla_mla_hier_moe"


def _split_points():
    pts, acc = [], 0
    for w in IN_WIDTHS[:-1]:
        acc += w
        pts.append(acc)
    return pts


def rmsnorm(x, w):
    x32 = x.astype(jnp.float32)
    y = x32 * lax.rsqrt(jnp.mean(x32 * x32, axis=-1, keepdims=True) + EPS)
    return (y * w.astype(jnp.float32)).astype(x.dtype)


def rope(x, pos):
    half = x.shape[-1] // 2
    inv = ROPE_THETA ** (-jnp.arange(half, dtype=jnp.float32) / half)
    ang = pos.astype(jnp.float32)[..., None] * inv
    cos, sin = jnp.cos(ang), jnp.sin(ang)
    x1, x2 = x[..., :half].astype(jnp.float32), x[..., half:].astype(jnp.float32)
    return jnp.concatenate([x1 * cos - x2 * sin, x1 * sin + x2 * cos], axis=-1).astype(x.dtype)


def gla_mixer(q, k, v, gate_lr, out_gate, gate_up, gate_bias, norm_w):
    B, S, _ = q.shape
    H, C = GLA_HEADS, GLA_CHUNK
    nc = S // C
    f32 = jnp.float32

    def heads(t, d):
        return t.reshape(B, nc, C, H, d).transpose(0, 3, 1, 2, 4).astype(f32)

    q = heads(q, GLA_DK) * (GLA_DK ** -0.5)
    k = heads(k, GLA_DK)
    v = heads(v, GLA_DV)
    z = (gate_lr @ gate_up + gate_bias).astype(f32)
    log_a = heads(jax.nn.log_sigmoid(z) / GLA_GATE_NORM, GLA_DK)
    b = jnp.cumsum(log_a, axis=3)
    b_last = b[:, :, :, -1:, :]
    q_e = q * jnp.exp(b)
    k_e = k * jnp.exp(-b)
    causal = jnp.tril(jnp.ones((C, C), dtype=bool))
    att = jnp.where(causal, jnp.einsum('bhnid,bhnjd->bhnij', q_e, k_e), 0.0)
    o_intra = jnp.einsum('bhnij,bhnjv->bhniv', att, v)
    upd = jnp.einsum('bhnjd,bhnjv->bhndv', k * jnp.exp(b_last - b), v)
    decay = jnp.exp(b_last[:, :, :, 0, :])

    def step(state, xs):
        d, u = xs
        return d[..., None] * state + u, state

    s0 = jnp.zeros((B, H, GLA_DK, GLA_DV), f32)
    _, s_prev = lax.scan(step, s0, (jnp.moveaxis(decay, 2, 0), jnp.moveaxis(upd, 2, 0)))
    s_prev = jnp.moveaxis(s_prev, 0, 2)
    o = o_intra + jnp.einsum('bhnid,bhndv->bhniv', q_e, s_prev)
    o = o * lax.rsqrt(jnp.mean(o * o, axis=-1, keepdims=True) + EPS) * norm_w.astype(f32)
    o = o.transpose(0, 2, 3, 1, 4).reshape(B, S, H * GLA_DV)
    return (o * jax.nn.silu(out_gate.astype(f32))).astype(out_gate.dtype)


def mla_mixer(c_q, c_kv, k_rope, positions, q_norm_w, w_uq, kv_norm_w, w_ukv):
    B, S, _ = c_q.shape
    H = MLA_HEADS
    q = (rmsnorm(c_q, q_norm_w) @ w_uq).reshape(B, S, H, MLA_NOPE + MLA_ROPE)
    q_nope = q[..., :MLA_NOPE]
    q_rope = rope(q[..., MLA_NOPE:], positions[:, :, None])
    kv = (rmsnorm(c_kv, kv_norm_w) @ w_ukv).reshape(B, S, H, MLA_NOPE + MLA_DV)
    k_nope, v = kv[..., :MLA_NOPE], kv[..., MLA_NOPE:]
    k_r = rope(k_rope, positions)
    scale = (MLA_NOPE + MLA_ROPE) ** -0.5
    nb = S // Q_BLOCK
    key_pos = jnp.arange(S)

    def block(args):
        qn, qr, i = args
        s = jnp.einsum('bqhd,bkhd->bhqk', qn, k_nope) + jnp.einsum('bqhr,bkr->bhqk', qr, k_r)
        q_pos = i * Q_BLOCK + jnp.arange(Q_BLOCK)
        s = jnp.where(key_pos[None, :] <= q_pos[:, None], s.astype(jnp.float32) * scale, -jnp.inf)
        p = jax.nn.softmax(s, axis=-1).astype(v.dtype)
        return jnp.einsum('bhqk,bkhd->bqhd', p, v)

    qn_b = q_nope.reshape(B, nb, Q_BLOCK, H, MLA_NOPE).transpose(1, 0, 2, 3, 4)
    qr_b = q_rope.reshape(B, nb, Q_BLOCK, H, MLA_ROPE).transpose(1, 0, 2, 3, 4)
    out = lax.map(block, (qn_b, qr_b, jnp.arange(nb)))
    return out.transpose(1, 0, 2, 3, 4).reshape(B, S, H * MLA_DV)


def hier_moe(x, wg, bg, we, be, w_gate, w_up, w_down):
    B, S, D = x.shape
    N = B * S
    xf = x.reshape(N, D)
    f32 = jnp.float32
    g_logits = (xf @ wg).astype(f32) + bg.astype(f32)
    g_prob = jax.nn.softmax(g_logits, axis=-1)
    g_sel = jnp.argmax(g_logits, axis=-1).astype(jnp.int32)
    p_g = jnp.take_along_axis(g_prob, g_sel[:, None], axis=1)
    e_logits = ((xf @ we).astype(f32) + be.astype(f32)).reshape(N, N_GROUPS, EXPERTS_PER_GROUP)
    e_logits = jnp.take_along_axis(e_logits, g_sel[:, None, None], axis=1)[:, 0]
    e_prob = jax.nn.softmax(e_logits, axis=-1)
    top_p, top_i = lax.top_k(e_prob, TOP_K)
    gate = p_g * top_p / jnp.sum(top_p, axis=-1, keepdims=True)
    expert_id = (g_sel[:, None] * EXPERTS_PER_GROUP + top_i.astype(jnp.int32)).reshape(-1)
    NK = N * TOP_K
    tok = jnp.repeat(jnp.arange(N, dtype=jnp.int32), TOP_K)
    order = jnp.argsort(expert_id)
    se, stok, sgate = expert_id[order], tok[order], gate.reshape(-1)[order]
    counts = jnp.bincount(expert_id, length=N_EXPERTS).astype(jnp.int32)
    starts = jnp.cumsum(counts) - counts
    padded = (counts + EXPERT_BLOCK - 1) // EXPERT_BLOCK * EXPERT_BLOCK
    pend = jnp.cumsum(padded)
    pstarts = pend - padded
    dest = pstarts[se] + (jnp.arange(NK, dtype=jnp.int32) - starts[se])
    nblk = -(-NK // EXPERT_BLOCK) + N_EXPERTS
    x_buf = jnp.zeros((nblk * EXPERT_BLOCK, D), xf.dtype).at[dest].set(xf[stok])
    blk_start = jnp.arange(nblk, dtype=jnp.int32) * EXPERT_BLOCK
    blk_expert = jnp.clip(jnp.searchsorted(pend, blk_start, side='right'), 0, N_EXPERTS - 1)

    def expert_block(args):
        xb, e = args
        hdn = jax.nn.silu(xb @ w_gate[e]) * (xb @ w_up[e])
        return hdn @ w_down[e]

    y_buf = lax.map(expert_block, (x_buf.reshape(nblk, EXPERT_BLOCK, D), blk_expert))
    y = y_buf.reshape(nblk * EXPERT_BLOCK, D)[dest] * sgate[:, None].astype(xf.dtype)
    out = jax.ops.segment_sum(y, stok, num_segments=N)
    return out.reshape(B, S, D)


def setup_inputs(seed: int = 0) -> dict:
    key = jax.random.key(seed)
    ks = jax.random.split(key, 24)
    f32 = jnp.float32
    L, D = DEPTH, D_MODEL

    def nrm(k, shape, scale):
        return jax.random.normal(k, shape, f32) * scale

    def gain(k, shape):
        return 1.0 + 0.02 * jax.random.normal(k, shape, f32)

    x = jax.random.normal(ks[0], (BATCH, SEQ, D), f32)
    offsets = jax.random.randint(ks[1], (BATCH, 1), 0, 2048, dtype=jnp.int32)
    positions = (offsets + jnp.arange(SEQ, dtype=jnp.int32)[None, :]).astype(jnp.int32)
    return {
        'x': x,
        'positions': positions,
        'attn_norm_w': gain(ks[2], (L, D)),
        'w_in': nrm(ks[3], (L, D, D_IN), D ** -0.5),
        'gla_gate_up': nrm(ks[4], (L, GLA_GATE_RANK, GLA_HEADS * GLA_DK), GLA_GATE_RANK ** -0.5),
        'gla_gate_bias': nrm(ks[5], (L, GLA_HEADS * GLA_DK), 0.02),
        'gla_norm_w': gain(ks[6], (L, GLA_DV)),
        'mla_q_norm_w': gain(ks[7], (L, MLA_Q_RANK)),
        'mla_w_uq': nrm(ks[8], (L, MLA_Q_RANK, MLA_HEADS * (MLA_NOPE + MLA_ROPE)), MLA_Q_RANK ** -0.5),
        'mla_kv_norm_w': gain(ks[9], (L, MLA_KV_RANK)),
        'mla_w_ukv': nrm(ks[10], (L, MLA_KV_RANK, MLA_HEADS * (MLA_NOPE + MLA_DV)), MLA_KV_RANK ** -0.5),
        'w_out': nrm(ks[11], (L, D_MIX, D), D_MIX ** -0.5),
        'ffn_norm_w': gain(ks[12], (L, D)),
        'router_group_w': nrm(ks[13], (L, D, N_GROUPS), D ** -0.5),
        'router_group_b': nrm(ks[14], (L, N_GROUPS), 0.01),
        'router_expert_w': nrm(ks[15], (L, D, N_EXPERTS), D ** -0.5),
        'router_expert_b': nrm(ks[16], (L, N_EXPERTS), 0.01),
        'expert_w_gate': nrm(ks[17], (L, N_EXPERTS, D, D_EXPERT), D ** -0.5),
        'expert_w_up': nrm(ks[18], (L, N_EXPERTS, D, D_EXPERT), D ** -0.5),
        'expert_w_down': nrm(ks[19], (L, N_EXPERTS, D_EXPERT, D), D_EXPERT ** -0.5),
        'final_norm_w': gain(ks[20], (D,)),
    }


def reference(x, positions, attn_norm_w, w_in, gla_gate_up, gla_gate_bias, gla_norm_w,
              mla_q_norm_w, mla_w_uq, mla_kv_norm_w, mla_w_ukv, w_out, ffn_norm_w,
              router_group_w, router_group_b, router_expert_w, router_expert_b,
              expert_w_gate, expert_w_up, expert_w_down, final_norm_w):
    h = x
    for l in range(DEPTH):
        xn = rmsnorm(h, attn_norm_w[l])
        g_q, g_k, g_v, g_lr, g_og, m_cq, m_ckv, m_kr = jnp.split(xn @ w_in[l], _split_points(), axis=-1)
        y_gla = gla_mixer(g_q, g_k, g_v, g_lr, g_og, gla_gate_up[l], gla_gate_bias[l], gla_norm_w[l])
        y_mla = mla_mixer(m_cq, m_ckv, m_kr, positions, mla_q_norm_w[l], mla_w_uq[l],
                          mla_kv_norm_w[l], mla_w_ukv[l])
        h = h + jnp.concatenate([y_gla, y_mla], axis=-1) @ w_out[l]
        h = h + hier_moe(rmsnorm(h, ffn_norm_w[l]), router_group_w[l], router_group_b[l],
                         router_expert_w[l], router_expert_b[l], expert_w_gate[l],
                         expert_w_up[l], expert_w_down[l])
    return rmsnorm(h, final_norm_w)
```

```cpp
#include <hip/hip_runtime.h>
#include <hip/hip_cooperative_groups.h>
#include <cstdio>
#include <cstdint>
#include <cmath>
namespace cg = cooperative_groups;

#ifndef ENABLE_GLA
#define ENABLE_GLA 1
#endif
#ifndef ENABLE_MLA
#define ENABLE_MLA 1
#endif
#ifndef ENABLE_MOE
#define ENABLE_MOE 1
#endif

#define LAS __attribute__((address_space(3)))
typedef unsigned short bf16_t;
typedef short bf16x8 __attribute__((ext_vector_type(8)));
typedef short s16x4 __attribute__((ext_vector_type(4)));
typedef float f32x4 __attribute__((ext_vector_type(4)));
typedef float f32x2 __attribute__((ext_vector_type(2)));
typedef float f32x16 __attribute__((ext_vector_type(16)));
typedef unsigned u32x4 __attribute__((ext_vector_type(4)));
typedef unsigned u32x2 __attribute__((ext_vector_type(2)));
typedef __bf16 bf16x2_t __attribute__((ext_vector_type(2)));

constexpr int NTOK = 32768, DM = 1024, SEQ = 4096, NBATCH = 8;
constexpr int NP = 2304;
constexpr int Q_OFF = 0, K_OFF = 256, V_OFF = 512, OG_OFF = 1024, CQ_OFF = 1536, CKV_OFF = 1920, KR_OFF = 2176, LR_OFF = 2208;
constexpr int NEXP = 32, ECAP = 32768;
constexpr float EPS = 1e-6f;
constexpr float QSCALE = 0.10206207261596575f * 1.4426950408889634f;

constexpr size_t MiB = 1u << 20;
constexpr size_t WS_CNT = 0;
constexpr size_t WS_RS1 = 1 * MiB;
constexpr size_t WS_SSQQ = 2 * MiB;
constexpr size_t WS_SSQKV = 2 * MiB + 256 * 1024;
constexpr size_t WS_SSQ2 = 2 * MiB + 512 * 1024;
constexpr size_t WS_CS = 4 * MiB;
constexpr size_t WS_LTOK = 8 * MiB;
constexpr size_t WS_LGATE = 12 * MiB;
constexpr size_t WS_WIN = 16 * MiB;
constexpr size_t WS_WUQ = 21 * MiB;
constexpr size_t WS_WUKV = 22 * MiB;
constexpr size_t WS_WOUT = 23 * MiB;
constexpr size_t WS_WR = 25 * MiB;
constexpr size_t WS_WGU = 26 * MiB;
constexpr size_t WS_WD = 58 * MiB;
constexpr size_t WS_DEC = 74 * MiB;
constexpr size_t WS_XB = 80 * MiB;
constexpr size_t WS_PROJ = 144 * MiB;
constexpr size_t WS_QB = 288 * MiB;
constexpr size_t WS_KVB = 336 * MiB;
constexpr size_t WS_Y = 400 * MiB;
constexpr size_t WS_END = 464 * MiB;

struct Params {
  const float* in[21];
  float* out;
  unsigned char* ws;
};

__device__ __forceinline__ unsigned pk2(float lo, float hi) { f32x2 v = {lo, hi}; bf16x2_t b = __builtin_convertvector(v, bf16x2_t); return __builtin_bit_cast(unsigned, b); }
__device__ __forceinline__ float bf2f(unsigned short h) { return __uint_as_float(((unsigned)h) << 16); }
__device__ __forceinline__ float bflo(unsigned w) { return __uint_as_float(w << 16); }
__device__ __forceinline__ float bfhi(unsigned w) { return __uint_as_float(w & 0xffff0000u); }
__device__ __forceinline__ int perm32(int rho) { const int n = rho >> 4, i = rho & 15; return 8 * (i >> 2) + 4 * n + (i & 3); }
__device__ __forceinline__ float wave_sum(float v) {
#pragma unroll
  for (int o = 1; o < 64; o <<= 1) v += __shfl_xor(v, o);
  return v;
}
#define LDS_WAIT() asm volatile("s_waitcnt lgkmcnt(0)" ::: "memory")

namespace g8 {
constexpr int BM = 256, BK = 64, HALF = 128, HTB = HALF * BK * 2, STAGE_BYTES = 8 * HTB, NXCD = 8, WGM = 8;
__device__ __forceinline__ int lds_byte(int r, int c) { const int st = (r >> 4) * 2 + (c >> 5), rr = r & 15, cc = c & 31, ob = rr * 64 + cc * 2; return st * 1024 + (ob ^ (((ob >> 9) & 1) << 5)); }
__device__ __forceinline__ void stage_rc(int b, int& R, int& C) { const int st = b / 1024, sb = b % 1024, swz = sb ^ (((sb >> 9) & 1) << 5); R = (st >> 1) * 16 + swz / 64; C = (st & 1) * 32 + (swz % 64) / 2; }

struct Unit { const char* A; const char* B; int a, b, c, d; };

template <class Epi, class Sched>
__device__ __forceinline__ void gemm_phase(LAS unsigned char* lds, const int K, const Sched& S, const Epi& E) {
  const int tid = threadIdx.x, wid = __builtin_amdgcn_readfirstlane(tid >> 6), lane = tid & 63, wr = wid >> 2, wc = wid & 3, fr = lane & 15, fq = lane >> 4;
  const int nt = K / BK;
  int R[2], C[2];
#pragma unroll
  for (int i = 0; i < 2; ++i) stage_rc(tid * 16 + i * 8192, R[i], C[i]);
  constexpr bool GA = Sched::GATHER;
  unsigned oB[2], oA[2][2];
  LAS unsigned* onxt = (LAS unsigned*)(lds + STAGE_BYTES + 1024) + tid;
#pragma unroll
  for (int i = 0; i < 2; ++i) oB[i] = (unsigned)(R[i] * S.ldb + C[i]) * 2u;
  const size_t hB = (size_t)HALF * S.ldb * 2, hA = GA ? (size_t)0 : (size_t)HALF * S.lda * 2;
  const size_t kstep = (size_t)(BK * 2);
  const unsigned ldsw = (unsigned)wid * 1024u;
  const int aoff = lds_byte(wr * 64 + fr, fq * 8), boff = lds_byte(wc * 32 + fr, fq * 8);
#define G8_SA(b, h) (((b) * 2 + (h)) * HTB)
#define G8_SB(b, h) ((4 + (b) * 2 + (h)) * HTB)
#define G8_STAGE(bufoff, gbase, off2) do { _Pragma("unroll") for (int _i = 0; _i < 2; ++_i) \
    __builtin_amdgcn_global_load_lds((const unsigned*)((const char*)(gbase) + (off2)[_i]), (LAS unsigned*)(lds + (bufoff) + ldsw + _i * 8192), 16, 0, 0); } while (0)
#define G8_LDA(dst, b, h) do { _Pragma("unroll") for (int m = 0; m < 4; ++m) _Pragma("unroll") for (int k = 0; k < 2; ++k) dst[m][k] = *(const LAS bf16x8*)(lds + G8_SA(b, h) + aoff + m * 2048 + k * 1024); } while (0)
#define G8_LDB(dst, b, h) do { _Pragma("unroll") for (int n = 0; n < 2; ++n) _Pragma("unroll") for (int k = 0; k < 2; ++k) dst[n][k] = *(const LAS bf16x8*)(lds + G8_SB(b, h) + boff + n * 2048 + k * 1024); } while (0)
#define G8_MMA(ai, bj, At, Bt) do { __builtin_amdgcn_s_setprio(1); _Pragma("unroll") for (int m = 0; m < 4; ++m) _Pragma("unroll") for (int n = 0; n < 2; ++n) _Pragma("unroll") for (int k = 0; k < 2; ++k) \
    acc[ai][bj][m][n] = __builtin_amdgcn_mfma_f32_16x16x32_bf16(Bt[n][k], At[m][k], acc[ai][bj][m][n], 0, 0, 0); __builtin_amdgcn_s_setprio(0); } while (0)
#define G8_WAIT_V(n) asm volatile("s_waitcnt vmcnt(" #n ")" ::: "memory")
#define G8_WAIT_L(n) asm volatile("s_waitcnt lgkmcnt(" #n ")" ::: "memory")
#define G8_BAR __builtin_amdgcn_s_barrier()
#define G8_SCHED __builtin_amdgcn_sched_barrier(0)
  Unit cur, nxt; int ui = 0;
  if (!S.next(0, cur)) return;
  S.offs(cur, R, C, oA);
  f32x4 acc[2][2][4][2];
#pragma unroll
  for (int a = 0; a < 2; ++a)
#pragma unroll
    for (int b = 0; b < 2; ++b)
#pragma unroll
      for (int m = 0; m < 4; ++m)
#pragma unroll
        for (int n = 0; n < 2; ++n) acc[a][b][m][n] = (f32x4){0.f, 0.f, 0.f, 0.f};
  bf16x8 At[4][2], B0[2][2], B1[2][2];
  const char* cA = cur.A; const char* cB = cur.B;
  G8_STAGE(G8_SB(0, 0), cB, oB); G8_STAGE(G8_SB(0, 1), cB + hB, oB); G8_STAGE(G8_SA(0, 0), cA, oA[0]); G8_STAGE(G8_SA(0, 1), cA + hA, oA[GA]);
  if (wr == 1) G8_BAR;
  G8_WAIT_V(2); G8_BAR;
  G8_STAGE(G8_SB(1, 0), cB + kstep, oB); G8_STAGE(G8_SA(1, 0), cA + kstep, oA[0]); G8_STAGE(G8_SB(1, 1), cB + kstep + hB, oB);
  G8_WAIT_V(6); G8_BAR;
  for (;;) {
    const bool has_next = S.next(ui + 1, nxt);
    if (GA && has_next) {
      unsigned oAn[2][2]; S.offs(nxt, R, C, oAn);
#pragma unroll
      for (int h = 0; h < 2; ++h)
#pragma unroll
        for (int i = 0; i < 2; ++i) onxt[(h * 2 + i) * 512] = oAn[h][i];
    }
    const char* nA = has_next ? nxt.A : cA; const char* nB = has_next ? nxt.B : cB;
#pragma unroll 1
    for (int t = 0; t < nt; t += 2) {
      const bool last = (t == nt - 2);
      const char* a1 = cA + (size_t)(t + 1) * kstep;
      const char* a2 = last ? nA : cA + (size_t)(t + 2) * kstep; const char* b2 = last ? nB : cB + (size_t)(t + 2) * kstep;
      const char* a3 = a2 + kstep; const char* b3 = b2 + kstep;
      G8_LDB(B0, 0, 0); G8_LDB(B1, 0, 1); G8_SCHED; G8_LDA(At, 0, 0); G8_STAGE(G8_SA(1, 1), a1 + hA, oA[GA]);
      G8_WAIT_V(8); G8_WAIT_L(0); G8_BAR; G8_MMA(0, 0, At, B0); G8_MMA(0, 1, At, B1); G8_BAR; G8_SCHED;
      if (GA && last && has_next) {
#pragma unroll
        for (int h = 0; h < 2; ++h)
#pragma unroll
          for (int i = 0; i < 2; ++i) oA[h][i] = onxt[(h * 2 + i) * 512];
      }
      G8_LDA(At, 0, 1); G8_STAGE(G8_SB(0, 0), b2, oB); G8_STAGE(G8_SB(0, 1), b2 + hB, oB); G8_STAGE(G8_SA(0, 0), a2, oA[0]);
      G8_WAIT_V(8); G8_WAIT_L(0); G8_BAR; G8_MMA(1, 0, At, B0); G8_MMA(1, 1, At, B1); G8_BAR; G8_SCHED;
      G8_LDB(B0, 1, 0); G8_LDB(B1, 1, 1); G8_SCHED; G8_LDA(At, 1, 0); G8_STAGE(G8_SA(0, 1), a2 + hA, oA[GA]);
      G8_WAIT_V(8); G8_WAIT_L(0); G8_BAR; G8_MMA(0, 0, At, B0); G8_MMA(0, 1, At, B1); G8_BAR; G8_SCHED;
      G8_LDA(At, 1, 1); G8_STAGE(G8_SB(1, 0), b3, oB); G8_STAGE(G8_SB(1, 1), b3 + hB, oB); G8_STAGE(G8_SA(1, 0), a3, oA[0]);
      G8_WAIT_V(8); G8_WAIT_L(0); G8_BAR; G8_MMA(1, 0, At, B0); G8_MMA(1, 1, At, B1); G8_BAR; G8_SCHED;
    }
    if (wr == 0) G8_BAR;
    E(acc, cur, wr, wc, fr, fq);
    if (!has_next) break;
#pragma unroll
    for (int a = 0; a < 2; ++a)
#pragma unroll
      for (int b = 0; b < 2; ++b)
#pragma unroll
        for (int m = 0; m < 4; ++m)
#pragma unroll
          for (int n = 0; n < 2; ++n) acc[a][b][m][n] = (f32x4){0.f, 0.f, 0.f, 0.f};
    cur = nxt; cA = nA; cB = nB; ++ui;
    if (wr == 1) G8_BAR;
  }
  G8_WAIT_V(0);
  G8_BAR;
#undef G8_SA
#undef G8_SB
#undef G8_STAGE
#undef G8_LDA
#undef G8_LDB
#undef G8_MMA
#undef G8_WAIT_V
#undef G8_WAIT_L
#undef G8_BAR
#undef G8_SCHED
}

struct DenseSched {
  static constexpr bool GATHER = false;
  const char* A; const char* B; int lda, ldb; int nM, nN, nwg, G, c;
  __device__ __forceinline__ void init(const void* A_, int lda_, const void* B_, int ldb_, int M, int N, int G_, int c_) {
    A = (const char*)A_; B = (const char*)B_; lda = lda_; ldb = ldb_; nM = M / BM; nN = N / BM; nwg = nM * nN; G = G_; c = c_; }
  __device__ __forceinline__ bool next(int i, Unit& u) const {
    const long L = (long)i * G + c; if (L >= nwg) return false;
    int wgid = (int)L; { const int q = nwg / NXCD, r = nwg % NXCD, xcd = wgid % NXCD, off = wgid / NXCD; wgid = (xcd < r ? xcd * (q + 1) : r * (q + 1) + (xcd - r) * q) + off; }
    const int nig = WGM * nN, gid = wgid / nig, fm = gid * WGM, gsz = (nM - fm) < WGM ? (nM - fm) : WGM;
    const int pm = fm + ((wgid % nig) % gsz), pn = (wgid % nig) / gsz;
    u.a = pm; u.b = pn; u.c = 0; u.d = 0;
    u.A = A + (size_t)pm * BM * lda * 2; u.B = B + (size_t)pn * BM * ldb * 2; return true;
  }
  __device__ __forceinline__ void offs(const Unit&, const int (&R)[2], const int (&C)[2], unsigned (&o)[2][2]) const {
#pragma unroll
    for (int h = 0; h < 2; ++h)
#pragma unroll
      for (int i = 0; i < 2; ++i) o[h][i] = (unsigned)(R[i] * lda + C[i]) * 2u;
  }
};
}

__device__ __forceinline__ u32x4 pack8(const f32x4& a, const f32x4& b) { u32x4 w; w.x = pk2(a[0], a[1]); w.y = pk2(a[2], a[3]); w.z = pk2(b[0], b[1]); w.w = pk2(b[2], b[3]); return w; }

__device__ __forceinline__ void rope4(f32x4& a, f32x4& b, const f32x2* cs) {
#pragma unroll
  for (int j = 0; j < 4; ++j) { const float c = cs[j].x, s = cs[j].y, x1 = a[j], x2 = b[j]; a[j] = x1 * c - x2 * s; b[j] = x1 * s + x2 * c; }
}

struct EpiInproj {
  bf16_t* PROJ; const float* rs1; float* ssqq; float* ssqkv; const f32x2* CS;
  __device__ __forceinline__ void operator()(const f32x4 (&acc)[2][2][4][2], const g8::Unit& u, int wr, int wc, int fr, int fq) const {
    asm volatile("" : "+v"(fr), "+v"(fq));
    const int pm = u.a, pn = u.b;
    const bool cq0 = (pn == 6 || pn == 7), cq1 = (pn == 6), ckv0 = (pn == 8), ckv1 = (pn == 7);
#pragma unroll
    for (int ai = 0; ai < 2; ++ai)
#pragma unroll
      for (int m = 0; m < 4; ++m) {
        asm volatile("" ::: "memory");
        const int row = pm * 256 + ai * 128 + wr * 64 + m * 16 + fr;
        const float rs = rs1[row];
        float sq = 0.f, skv = 0.f;
#pragma unroll
        for (int bj = 0; bj < 2; ++bj) {
          const int G = 8 * pn + 4 * bj + wc;
          f32x4 v0 = acc[ai][bj][m][0] * rs, v1 = acc[ai][bj][m][1] * rs;
          if (G == 68) {
            f32x2 cs[4];
#pragma unroll
            for (int j = 0; j < 4; ++j) cs[j] = CS[(size_t)row * 16 + 4 * fq + j];
            rope4(v0, v1, cs);
            u32x2 w0, w1; w0.x = pk2(v0[0], v0[1]); w0.y = pk2(v0[2], v0[3]); w1.x = pk2(v1[0], v1[1]); w1.y = pk2(v1[2], v1[3]);
            *(u32x2*)(PROJ + (size_t)row * NP + KR_OFF + 4 * fq) = w0;
            *(u32x2*)(PROJ + (size_t)row * NP + KR_OFF + 16 + 4 * fq) = w1;
          } else {
            *(u32x4*)(PROJ + (size_t)row * NP + 32 * G + 8 * fq) = pack8(v0, v1);
            const float s = (v0[0] * v0[0] + v0[1] * v0[1]) + (v0[2] * v0[2] + v0[3] * v0[3]) + (v1[0] * v1[0] + v1[1] * v1[1]) + (v1[2] * v1[2] + v1[3] * v1[3]);
            if (bj == 0 ? cq0 : cq1) sq += s;
            if (bj == 0 ? ckv0 : ckv1) skv += s;
          }
        }
        if (cq0) { sq += __shfl_xor(sq, 16); sq += __shfl_xor(sq, 32); if (fq == 0) atomicAdd(ssqq + row, sq); }
        if (ckv0 || ckv1) { skv += __shfl_xor(skv, 16); skv += __shfl_xor(skv, 32); if (fq == 0) atomicAdd(ssqkv + row, skv); }
      }
  }
};

struct EpiUq {
  bf16_t* QB; const float* ssqq; const f32x2* CS;
  __device__ __forceinline__ void operator()(const f32x4 (&acc)[2][2][4][2], const g8::Unit& u, int wr, int wc, int fr, int fq) const {
    asm volatile("" : "+v"(fr), "+v"(fq));
    const int pm = u.a, pn = u.b;
#pragma unroll
    for (int ai = 0; ai < 2; ++ai)
#pragma unroll
      for (int m = 0; m < 4; ++m) {
        asm volatile("" ::: "memory");
        const int row = pm * 256 + ai * 128 + wr * 64 + m * 16 + fr;
        const float rs = rsqrtf(ssqq[row] * (1.f / 384.f) + EPS) * QSCALE;
#pragma unroll
        for (int bj = 0; bj < 2; ++bj) {
          const int G = 8 * pn + 4 * bj + wc;
          f32x4 v0 = acc[ai][bj][m][0] * rs, v1 = acc[ai][bj][m][1] * rs;
          if ((G % 3) == 2) {
            f32x2 cs[4];
#pragma unroll
            for (int j = 0; j < 4; ++j) cs[j] = CS[(size_t)row * 16 + 4 * fq + j];
            rope4(v0, v1, cs);
            u32x2 w0, w1; w0.x = pk2(v0[0], v0[1]); w0.y = pk2(v0[2], v0[3]); w1.x = pk2(v1[0], v1[1]); w1.y = pk2(v1[2], v1[3]);
            *(u32x2*)(QB + (size_t)row * 768 + 32 * G + 4 * fq) = w0;
            *(u32x2*)(QB + (size_t)row * 768 + 32 * G + 16 + 4 * fq) = w1;
          } else {
            *(u32x4*)(QB + (size_t)row * 768 + 32 * G + 8 * fq) = pack8(v0, v1);
          }
        }
      }
  }
};

struct EpiUkv {
  bf16_t* KVB; const float* ssqkv;
  __device__ __forceinline__ void operator()(const f32x4 (&acc)[2][2][4][2], const g8::Unit& u, int wr, int wc, int fr, int fq) const {
    asm volatile("" : "+v"(fr), "+v"(fq));
    const int pm = u.a, pn = u.b;
#pragma unroll
    for (int ai = 0; ai < 2; ++ai)
#pragma unroll
      for (int m = 0; m < 4; ++m) {
        asm volatile("" ::: "memory");
        const int row = pm * 256 + ai * 128 + wr * 64 + m * 16 + fr;
        const float rs = rsqrtf(ssqkv[row] * (1.f / 256.f) + EPS);
#pragma unroll
        for (int bj = 0; bj < 2; ++bj) {
          const int G = 8 * pn + 4 * bj + wc;
          *(u32x4*)(KVB + (size_t)row * 1024 + 32 * G + 8 * fq) = pack8(acc[ai][bj][m][0] * rs, acc[ai][bj][m][1] * rs);
        }
      }
  }
};

struct EpiWout {
  const float* x; float* out; bf16_t* HB; float* ssq2;
  __device__ __forceinline__ void operator()(const f32x4 (&acc)[2][2][4][2], const g8::Unit& u, int wr, int wc, int fr, int fq) const {
    asm volatile("" : "+v"(fr), "+v"(fq));
    const int pm = u.a, pn = u.b;
#pragma unroll
    for (int ai = 0; ai < 2; ++ai)
#pragma unroll
      for (int m = 0; m < 4; ++m) {
        asm volatile("" ::: "memory");
        const int row = pm * 256 + ai * 128 + wr * 64 + m * 16 + fr;
        float sq = 0.f;
#pragma unroll
        for (int bj = 0; bj < 2; ++bj) {
          const int G = 8 * pn + 4 * bj + wc;
          const size_t off = (size_t)row * 1024 + 32 * G + 8 * fq;
          const f32x4 x0 = *(const f32x4*)(x + off), x1 = *(const f32x4*)(x + off + 4);
          const f32x4 v0 = acc[ai][bj][m][0] + x0, v1 = acc[ai][bj][m][1] + x1;
          *(f32x4*)(out + off) = v0; *(f32x4*)(out + off + 4) = v1;
          *(u32x4*)(HB + off) = pack8(v0, v1);
          sq += (v0[0] * v0[0] + v0[1] * v0[1]) + (v0[2] * v0[2] + v0[3] * v0[3]) + (v1[0] * v1[0] + v1[1] * v1[1]) + (v1[2] * v1[2] + v1[3] * v1[3]);
        }
        sq += __shfl_xor(sq, 16); sq += __shfl_xor(sq, 32);
        if (fq == 0) atomicAdd(ssq2 + row, sq);
      }
  }
};

template <bool GATHER_>
struct MoeSched {
  static constexpr bool GATHER = GATHER_;
  const char* A; const char* B; int lda, ldb; int ncol, total, G, c;
  const LAS int* tb; const LAS int* cn; const int* ltok; size_t bstride;
  __device__ __forceinline__ bool next(int i, g8::Unit& u) const {
    const long L = (long)i * G + c; if (L >= total) return false;
    const int rt = (int)(L / ncol), pn = (int)(L % ncol);
    int e = 0;
#pragma unroll 1
    for (int k = 1; k < NEXP; ++k) if (tb[k] <= rt) e = k;
    e = __builtin_amdgcn_readfirstlane(e);
    const int mt = rt - tb[e];
    u.a = e; u.b = mt; u.c = pn; u.d = rt;
    u.B = B + (size_t)e * bstride + (size_t)pn * 256 * ldb * 2;
    u.A = GATHER_ ? A : A + (size_t)rt * 256 * lda * 2;
    return true;
  }
  __device__ __forceinline__ void offs(const g8::Unit& u, const int (&R)[2], const int (&C)[2], unsigned (&o)[2][2]) const {
    if (GATHER_) {
      const int cnt = cn[u.a];
#pragma unroll
      for (int h = 0; h < 2; ++h)
#pragma unroll
        for (int i = 0; i < 2; ++i) { int pos = u.b * 256 + h * 128 + R[i]; pos = pos < cnt ? pos : cnt - 1; const int tok = ltok[u.a * ECAP + pos] >> 1;
          o[h][i] = (unsigned)(tok * lda + C[i]) * 2u; }
    } else {
#pragma unroll
      for (int h = 0; h < 2; ++h)
#pragma unroll
        for (int i = 0; i < 2; ++i) o[h][i] = (unsigned)(R[i] * lda + C[i]) * 2u;
    }
  }
};

struct EpiGU {
  bf16_t* HID; const float* ssq2; const int* ltok; const LAS int* cn;
  __device__ __forceinline__ void operator()(const f32x4 (&acc)[2][2][4][2], const g8::Unit& u, int wr, int wc, int fr, int fq) const {
    asm volatile("" : "+v"(fr), "+v"(fq));
    const int e = u.a, mt = u.b, pn = u.c, rt = u.d; const int cnt = cn[e];
#pragma unroll
    for (int ai = 0; ai < 2; ++ai)
#pragma unroll
      for (int m = 0; m < 4; ++m) {
        asm volatile("" ::: "memory");
        const int r = ai * 128 + wr * 64 + m * 16 + fr, pos = mt * 256 + r;
        if (pos < cnt) {
          const int tok = ltok[e * ECAP + pos] >> 1;
          const float rs = rsqrtf(ssq2[tok] * (1.f / 1024.f) + EPS);
          f32x4 h0, h1;
#pragma unroll
          for (int j = 0; j < 4; ++j) {
            const float g0 = acc[ai][0][m][0][j] * rs, u0 = acc[ai][1][m][0][j] * rs, g1 = acc[ai][0][m][1][j] * rs, u1 = acc[ai][1][m][1][j] * rs;
            h0[j] = g0 / (1.f + __expf(-g0)) * u0; h1[j] = g1 / (1.f + __expf(-g1)) * u1;
          }
          *(u32x4*)(HID + ((size_t)rt * 256 + r) * 256 + pn * 128 + wc * 32 + 8 * fq) = pack8(h0, h1);
        }
      }
  }
};

struct EpiDown {
  bf16_t* Y2; const int* ltok; const float* lgate; const LAS int* cn;
  __device__ __forceinline__ void operator()(const f32x4 (&acc)[2][2][4][2], const g8::Unit& u, int wr, int wc, int fr, int fq) const {
    asm volatile("" : "+v"(fr), "+v"(fq));
    const int e = u.a, mt = u.b, pn = u.c; const int cnt = cn[e];
#pragma unroll
    for (int ai = 0; ai < 2; ++ai)
#pragma unroll
      for (int m = 0; m < 4; ++m) {
        asm volatile("" ::: "memory");
        const int r = ai * 128 + wr * 64 + m * 16 + fr, pos = mt * 256 + r;
        if (pos < cnt) {
          const int dst = ltok[e * ECAP + pos]; const float g = lgate[e * ECAP + pos];
#pragma unroll
          for (int bj = 0; bj < 2; ++bj)
            *(u32x4*)(Y2 + (size_t)dst * 1024 + pn * 256 + bj * 128 + wc * 32 + 8 * fq) = pack8(acc[ai][bj][m][0] * g, acc[ai][bj][m][1] * g);
        }
      }
  }
};

__device__ __forceinline__ int inproj_src_col(int L) {
  if (L < 1024) return L;
  if (L < 1536) return 1040 + (L - 1024);
  if (L < 1920) return 1552 + (L - 1536);
  if (L < 2176) return 1936 + (L - 1920);
  if (L < 2208) return 2192 + (L - 2176);
  if (L < 2224) return 1024 + (L - 2208);
  return -1;
}
__device__ __forceinline__ void tr_item(const float* src, int ld, int col, const float* kscale, int k0, bf16_t* dst, int K, LAS float* scr, int lane) {
#pragma unroll 8
  for (int i = 0; i < 32; ++i) { const int kk = 2 * i + (lane >> 5); float v = 0.f;
    if (col >= 0) { v = src[(size_t)(k0 + kk) * ld + col]; if (kscale) v *= kscale[k0 + kk]; }
    scr[kk * 33 + (lane & 31)] = v; }
  LDS_WAIT();
  const int c = lane & 7;
#pragma unroll
  for (int j = 0; j < 4; ++j) { const int n = (lane >> 3) + 8 * j; const LAS float* s = scr + (8 * c) * 33 + n;
    u32x4 o; o.x = pk2(s[0 * 33], s[1 * 33]); o.y = pk2(s[2 * 33], s[3 * 33]); o.z = pk2(s[4 * 33], s[5 * 33]); o.w = pk2(s[6 * 33], s[7 * 33]);
    *(u32x4*)(dst + (size_t)n * K + 8 * c) = o; }
  LDS_WAIT();
}

__device__ __forceinline__ void p0_prologue(const Params& p, LAS unsigned char* lds, int G, int vb) {
  const int tid = threadIdx.x, lane = tid & 63, wave = tid >> 6;
  LAS float* scr = (LAS float*)(lds + wave * 8704);
  const int gw = vb * 8 + wave, NGW = G * 8;
  unsigned char* ws = p.ws;
  const float* attn_nw = p.in[2]; const float* w_in = p.in[3];
  const float* qnw = p.in[7]; const float* w_uq = p.in[8]; const float* kvnw = p.in[9]; const float* w_ukv = p.in[10];
  const float* w_out = p.in[11]; const float* fnw = p.in[12]; const float* rgw = p.in[13]; const float* rew = p.in[15];
  const float* ewg = p.in[17]; const float* ewu = p.in[18]; const float* ewd = p.in[19];
  constexpr int I_IN = 16 * 72, I_UQ = 6 * 24, I_UKV = 4 * 32, I_OUT = 16 * 32, I_R = 16 * 2, I_GU = 32 * 16 * 16, I_D = 32 * 4 * 32;
  constexpr int NITEMS = I_IN + I_UQ + I_UKV + I_OUT + I_R + I_GU + I_D;
  const int n = lane & 31;
  for (int it = gw; it < NITEMS; it += NGW) {
    int r = it;
    if (r < I_IN) { const int kb = r / 72, nb = r % 72; const int Rr = nb * 32 + n; const int L = 32 * nb + ((nb == 68) ? n : perm32(n)); (void)Rr;
      tr_item(w_in, 2224, inproj_src_col(L), attn_nw, kb * 64, (bf16_t*)(ws + WS_WIN) + (size_t)(nb * 32) * 1024 + kb * 64, 1024, scr, lane); continue; }
    r -= I_IN;
    if (r < I_UQ) { const int kb = r / 24, nb = r % 24; const int L = 32 * nb + (((nb % 3) == 2) ? n : perm32(n));
      tr_item(w_uq, 768, L, qnw, kb * 64, (bf16_t*)(ws + WS_WUQ) + (size_t)(nb * 32) * 384 + kb * 64, 384, scr, lane); continue; }
    r -= I_UQ;
    if (r < I_UKV) { const int kb = r / 32, nb = r % 32; const int L = 32 * nb + perm32(n);
      tr_item(w_ukv, 1024, L, kvnw, kb * 64, (bf16_t*)(ws + WS_WUKV) + (size_t)(nb * 32) * 256 + kb * 64, 256, scr, lane); continue; }
    r -= I_UKV;
    if (r < I_OUT) { const int kb = r / 32, nb = r % 32; const int L = 32 * nb + perm32(n);
      tr_item(w_out, 1024, L, nullptr, kb * 64, (bf16_t*)(ws + WS_WOUT) + (size_t)(nb * 32) * 1024 + kb * 64, 1024, scr, lane); continue; }
    r -= I_OUT;
    if (r < I_R) { const int kb = r / 2, nb = r % 2; const int Rr = nb * 32 + n;
      const float* src = (Rr < 4) ? rgw : rew; const int ld = (Rr < 4) ? 4 : 32; const int col = (Rr < 4) ? Rr : (Rr < 36 ? Rr - 4 : -1);
      tr_item(src, ld, col, fnw, kb * 64, (bf16_t*)(ws + WS_WR) + (size_t)(nb * 32) * 1024 + kb * 64, 1024, scr, lane); continue; }
    r -= I_R;
    if (r < I_GU) { const int e = r / 256, kb = (r % 256) / 16, nb = r % 16;
      const int pn = nb >> 3, bj = (nb >> 2) & 1; const int ch = 128 * pn + 32 * (nb & 3) + perm32(n);
      const float* src = (bj ? ewu : ewg) + (size_t)e * 1024 * 256;
      tr_item(src, 256, ch, fnw, kb * 64, (bf16_t*)(ws + WS_WGU) + ((size_t)e * 512 + nb * 32) * 1024 + kb * 64, 1024, scr, lane); continue; }
    r -= I_GU;
    { const int e = r / 128, kb = (r % 128) / 32, nb = r % 32; const int L = 32 * nb + perm32(n);
      tr_item(ewd + (size_t)e * 256 * 1024, 1024, L, nullptr, kb * 64, (bf16_t*)(ws + WS_WD) + ((size_t)e * 1024 + nb * 32) * 256 + kb * 64, 256, scr, lane); }
  }
  const float* x = p.in[0]; bf16_t* XB = (bf16_t*)(ws + WS_XB); float* rs1 = (float*)(ws + WS_RS1);
  for (int m = gw; m < NTOK; m += NGW) {
    const f32x4* xr = (const f32x4*)(x + (size_t)m * DM) + lane;
    f32x4 v[4]; float s = 0.f;
#pragma unroll
    for (int j = 0; j < 4; ++j) { v[j] = xr[64 * j]; s += (v[j].x * v[j].x + v[j].y * v[j].y) + (v[j].z * v[j].z + v[j].w * v[j].w); }
    s = wave_sum(s);
    if (lane == 0) rs1[m] = rsqrtf(s * (1.f / DM) + EPS);
    u32x2* o8 = (u32x2*)(XB + (size_t)m * DM) + lane;
#pragma unroll
    for (int j = 0; j < 4; ++j) { u32x2 w; w.x = pk2(v[j].x, v[j].y); w.y = pk2(v[j].z, v[j].w); o8[64 * j] = w; }
  }
  const int gt = vb * 512 + tid, NGT = G * 512;
  const int* pos = (const int*)p.in[1]; f32x2* CS = (f32x2*)(ws + WS_CS);
  for (int i = gt; i < NTOK * 16; i += NGT) {
    const int row = i >> 4, f = i & 15;
    const float inv = powf(10000.0f, -(float)f / 16.0f);
    const float ang = (float)pos[row] * inv;
    CS[i] = (f32x2){(float)cos((double)ang), (float)sin((double)ang)};
  }
  float* ssqq = (float*)(ws + WS_SSQQ); float* ssqkv = (float*)(ws + WS_SSQKV); float* ssq2 = (float*)(ws + WS_SSQ2);
  for (int i = gt; i < NTOK; i += NGT) { ssqq[i] = 0.f; ssqkv[i] = 0.f; ssq2[i] = 0.f; }
  if (gt < NEXP) ((int*)(ws + WS_CNT))[gt] = 0;
#if !ENABLE_GLA || !ENABLE_MLA
  { u32x4* Y = (u32x4*)(ws + WS_Y); for (int i = gt; i < NTOK * 1024 / 8; i += NGT) Y[i] = (u32x4){0u, 0u, 0u, 0u}; }
#endif
}

constexpr int AT_KSTR = 208;
constexpr int AT_KBUF = 64 * AT_KSTR, AT_VBUF = 8192;
constexpr int AT_KOFF = 0, AT_VOFF = 2 * AT_KBUF;
typedef short v4i16_t __attribute__((ext_vector_type(4)));
__device__ __forceinline__ s16x4 vtr(const LAS unsigned char* p) { return __builtin_bit_cast(s16x4, __builtin_amdgcn_ds_read_tr16_b64_v4i16((LAS v4i16_t*)p)); }

__device__ __forceinline__ void attn_unit(const Params& p, LAS unsigned char* lds, int b, int h, int qb) {
  const int tid = threadIdx.x, lane = tid & 63, r32 = lane & 31, hi = lane >> 5; const int wid = __builtin_amdgcn_readfirstlane(tid >> 6);
  const bf16_t* QB = (const bf16_t*)(p.ws + WS_QB); const bf16_t* KVB = (const bf16_t*)(p.ws + WS_KVB); const bf16_t* PROJ = (const bf16_t*)(p.ws + WS_PROJ);
  bf16_t* Y = (bf16_t*)(p.ws + WS_Y);
  const size_t rowbase = (size_t)b * SEQ; const int q0 = qb * 256;
  bf16x8 qf[6];
  { const bf16_t* qrow = QB + (rowbase + q0 + wid * 32 + r32) * 768 + h * 96 + hi * 8;
#pragma unroll
    for (int d0 = 0; d0 < 6; ++d0) qf[d0] = *(const bf16x8*)(qrow + d0 * 16); }
  f32x16 o0 = {}, o1 = {}; float mrun = -INFINITY, lrun = 0.f;
  const int NT = 4 * (qb + 1);
  const int id0 = tid, id1 = tid + 512;
  const int kv0 = id0 / 12, c0 = id0 % 12, kv1 = id1 / 12, c1 = id1 % 12;
  const bool has1 = (id1 < 768);
  const bf16_t* ks0 = (c0 < 8) ? KVB + (rowbase + kv0) * 1024 + h * 128 + c0 * 8 : PROJ + (rowbase + kv0) * NP + KR_OFF + (c0 - 8) * 8;
  const size_t kstr0 = (c0 < 8) ? (size_t)64 * 1024 : (size_t)64 * NP;
  const bf16_t* ks1 = (c1 < 8) ? KVB + (rowbase + kv1) * 1024 + h * 128 + c1 * 8 : PROJ + (rowbase + kv1) * NP + KR_OFF + (c1 - 8) * 8;
  const size_t kstr1 = (c1 < 8) ? (size_t)64 * 1024 : (size_t)64 * NP;
  const int kd0 = kv0 * AT_KSTR + c0 * 16, kd1 = kv1 * AT_KSTR + c1 * 16;
  const int vkv = tid >> 3, vc = tid & 7;
  const bf16_t* vs = KVB + (rowbase + vkv) * 1024 + h * 128 + 64 + vc * 8;
  const int vd = (vc >> 2) * 4096 + vkv * 64 + (vc & 3) * 16;
  u32x4 kr0, kr1 = {}, vr;
  kr0 = *(const u32x4*)ks0; if (has1) kr1 = *(const u32x4*)ks1; vr = *(const u32x4*)vs;
  *(LAS u32x4*)(lds + AT_KOFF + kd0) = kr0; if (has1) *(LAS u32x4*)(lds + AT_KOFF + kd1) = kr1; *(LAS u32x4*)(lds + AT_VOFF + vd) = vr;
  __syncthreads();
  const int qabs = q0 + wid * 32 + r32;
  const int voffl = ((lane >> 4) & 1) * 32 + (lane & 3) * 8 + (4 * hi + ((lane & 15) >> 2)) * 64;
  for (int t = 0; t < NT; ++t) {
    const int cur = t & 1;
    if (t + 1 < NT) { kr0 = *(const u32x4*)(ks0 + (size_t)(t + 1) * kstr0); if (has1) kr1 = *(const u32x4*)(ks1 + (size_t)(t + 1) * kstr1); vr = *(const u32x4*)(vs + (size_t)(t + 1) * 64 * 1024); }
    const bool active = (t * 64 <= q0 + wid * 32 + 31);
    if (active) {
      const LAS unsigned char* Kb = lds + AT_KOFF + cur * AT_KBUF + r32 * AT_KSTR + hi * 16;
      f32x16 p0 = {}, p1 = {};
#pragma unroll
      for (int d0 = 0; d0 < 6; ++d0) {
        const bf16x8 a0 = *(const LAS bf16x8*)(Kb + d0 * 32), a1 = *(const LAS bf16x8*)(Kb + 32 * AT_KSTR + d0 * 32);
        p0 = __builtin_amdgcn_mfma_f32_32x32x16_bf16(a0, qf[d0], p0, 0, 0, 0);
        p1 = __builtin_amdgcn_mfma_f32_32x32x16_bf16(a1, qf[d0], p1, 0, 0, 0);
      }
      if (t >= NT - 4) {
        const int kb = t * 64 + 4 * hi;
#pragma unroll
        for (int r = 0; r < 16; ++r) { const int kv = kb + (r & 3) + 8 * (r >> 2); if (kv > qabs) p0[r] = -INFINITY; if (kv + 32 > qabs) p1[r] = -INFINITY; }
      }
      float mt = fmaxf(p0[0], p1[0]);
#pragma unroll
      for (int r = 1; r < 16; ++r) mt = fmaxf(mt, fmaxf(p0[r], p1[r]));
      mt = fmaxf(mt, __shfl_xor(mt, 32));
      const float mn = fmaxf(mrun, mt);
      const float alpha = __builtin_amdgcn_exp2f(mrun - mn);
      mrun = mn; lrun *= alpha;
#pragma unroll
      for (int r = 0; r < 16; ++r) { o0[r] *= alpha; o1[r] *= alpha; }
      float ls = 0.f;
#pragma unroll
      for (int r = 0; r < 16; ++r) { p0[r] = __builtin_amdgcn_exp2f(p0[r] - mn); p1[r] = __builtin_amdgcn_exp2f(p1[r] - mn); ls += p0[r] + p1[r]; }
      lrun += ls;
      u32x4 pw[4];
#pragma unroll
      for (int s = 0; s < 2; ++s) {
        pw[s] = (u32x4){pk2(p0[8 * s + 0], p0[8 * s + 1]), pk2(p0[8 * s + 2], p0[8 * s + 3]), pk2(p0[8 * s + 4], p0[8 * s + 5]), pk2(p0[8 * s + 6], p0[8 * s + 7])};
        pw[2 + s] = (u32x4){pk2(p1[8 * s + 0], p1[8 * s + 1]), pk2(p1[8 * s + 2], p1[8 * s + 3]), pk2(p1[8 * s + 4], p1[8 * s + 5]), pk2(p1[8 * s + 6], p1[8 * s + 7])};
      }
      const LAS unsigned char* Vb = lds + AT_VOFF + cur * AT_VBUF + voffl;
#pragma unroll
      for (int ks = 0; ks < 4; ++ks) {
        const s16x4 l0 = vtr(Vb + ks * 1024), h0 = vtr(Vb + ks * 1024 + 512), l1 = vtr(Vb + 4096 + ks * 1024), h1 = vtr(Vb + 4096 + ks * 1024 + 512);
        const bf16x8 vf0 = {l0[0], l0[1], l0[2], l0[3], h0[0], h0[1], h0[2], h0[3]}, vf1 = {l1[0], l1[1], l1[2], l1[3], h1[0], h1[1], h1[2], h1[3]};
        const bf16x8 pf = __builtin_bit_cast(bf16x8, pw[ks]);
        o0 = __builtin_amdgcn_mfma_f32_32x32x16_bf16(vf0, pf, o0, 0, 0, 0);
        o1 = __builtin_amdgcn_mfma_f32_32x32x16_bf16(vf1, pf, o1, 0, 0, 0);
      }
    }
    if (t + 1 < NT) { const int nb = cur ^ 1;
      *(LAS u32x4*)(lds + AT_KOFF + nb * AT_KBUF + kd0) = kr0; if (has1) *(LAS u32x4*)(lds + AT_KOFF + nb * AT_KBUF + kd1) = kr1; *(LAS u32x4*)(lds + AT_VOFF + nb * AT_VBUF + vd) = vr; }
    __syncthreads();
  }
  lrun += __shfl_xor(lrun, 32);
  const float inv = 1.f / lrun;
  bf16_t* dst = Y + (rowbase + q0 + wid * 32 + r32) * 1024 + 512 + h * 64 + 4 * hi;
#pragma unroll
  for (int g = 0; g < 4; ++g) {
    u32x2 w0, w1; w0.x = pk2(o0[4 * g] * inv, o0[4 * g + 1] * inv); w0.y = pk2(o0[4 * g + 2] * inv, o0[4 * g + 3] * inv);
    w1.x = pk2(o1[4 * g] * inv, o1[4 * g + 1] * inv); w1.y = pk2(o1[4 * g + 2] * inv, o1[4 * g + 3] * inv);
    *(u32x2*)(dst + 8 * g) = w0; *(u32x2*)(dst + 32 + 8 * g) = w1;
  }
}

__device__ __forceinline__ void attn_phase(const Params& p, LAS unsigned char* lds, int G, int vb) {
  if (G == 256) {
    const int bh = vb >> 2, s = vb & 3;
#pragma unroll 1
    for (int i = 0; i < 4; ++i) { const int qb = (i == 0) ? 15 - s : (i == 1) ? 8 + s : (i == 2) ? 7 - s : s; attn_unit(p, lds, bh >> 3, bh & 7, qb); }
  } else {
#pragma unroll 1
    for (int u = vb; u < 1024; u += G) { const int qb = 15 - (u >> 6), bh = u & 63; attn_unit(p, lds, bh >> 3, bh & 7, qb); }
  }
}

constexpr int GL_LR = 0;
constexpr int GL_GU = 4096;
constexpr int GL_B = 8704;
constexpr int GL_SEG = 25600;
constexpr int GL_KD = 28672;
constexpr int GL_KE = 38912;
constexpr int GL_VT = 49152;
constexpr int GL_ST = 68608;
constexpr int GL_ATT = 88064;
constexpr int GL_RED = 98304;

__device__ __forceinline__ void gla_gates(const Params& p, LAS unsigned char* lds, size_t r0, int h) {
  const int tid = threadIdx.x;
  const bf16_t* PROJ = (const bf16_t*)(p.ws + WS_PROJ);
  const float* gup = p.in[4]; const float* gbias = p.in[5];
  LAS float* lrs = (LAS float*)(lds + GL_LR); LAS float* gu = (LAS float*)(lds + GL_GU); LAS float* bc = (LAS float*)(lds + GL_B); LAS float* seg = (LAS float*)(lds + GL_SEG);
  { const int row = tid >> 3, c = (tid & 7) * 2; const unsigned w = *(const unsigned*)(PROJ + (r0 + row) * NP + LR_OFF + c); lrs[row * 16 + c] = bflo(w); lrs[row * 16 + c + 1] = bfhi(w); }
  for (int i = tid; i < 16 * 64; i += 512) gu[i] = gup[(i >> 6) * 256 + h * 64 + (i & 63)];
  if (tid < 64) gu[1024 + tid] = gbias[h * 64 + tid];
  __syncthreads();
  const int d = tid & 63, sg = tid >> 6;
  float pre[8]; float run = 0.f;
#pragma unroll
  for (int i = 0; i < 8; ++i) { const int j = sg * 8 + i; float z = gu[1024 + d];
#pragma unroll
    for (int r = 0; r < 16; ++r) z += lrs[j * 16 + r] * gu[r * 64 + d];
    const float ls = fminf(z, 0.f) - log1pf(__expf(-fabsf(z)));
    run += ls * (1.f / 16.f); pre[i] = run; }
  seg[sg * 64 + d] = run;
  __syncthreads();
  float off = 0.f;
  for (int s2 = 0; s2 < sg; ++s2) off += seg[s2 * 64 + d];
#pragma unroll
  for (int i = 0; i < 8; ++i) bc[(sg * 8 + i) * 65 + d] = pre[i] + off;
  __syncthreads();
}

__device__ __forceinline__ void gla_a_item(const Params& p, LAS unsigned char* lds, int item) {
  const int tid = threadIdx.x, lane = tid & 63, r32 = lane & 31, hi = lane >> 5, wid = tid >> 6;
  const int n = item & 63, bh = item >> 6, h = bh & 3, b = bh >> 2;
  const size_t r0 = (size_t)b * SEQ + n * 64;
  const bf16_t* PROJ = (const bf16_t*)(p.ws + WS_PROJ);
  float* UPD = (float*)(p.ws + WS_Y); float* DEC = (float*)(p.ws + WS_DEC);
  gla_gates(p, lds, r0, h);
  LAS float* bc = (LAS float*)(lds + GL_B); LAS bf16_t* kdT = (LAS bf16_t*)(lds + GL_KD); LAS bf16_t* vT = (LAS bf16_t*)(lds + GL_VT);
  if (tid < 64) DEC[(size_t)item * 64 + tid] = __expf(bc[63 * 65 + tid]);
  { const int j = tid >> 3, c = tid & 7;
    const u32x4 kw = *(const u32x4*)(PROJ + (r0 + j) * NP + K_OFF + h * 64 + c * 8);
    const unsigned kk[4] = {kw.x, kw.y, kw.z, kw.w};
#pragma unroll
    for (int i = 0; i < 8; ++i) { const int d = c * 8 + i; const float kvv = (i & 1) ? bfhi(kk[i >> 1]) : bflo(kk[i >> 1]);
      const float v = kvv * __expf(bc[63 * 65 + d] - bc[j * 65 + d]); kdT[d * 72 + j] = (bf16_t)(pk2(v, 0.f) & 0xffffu); }
#pragma unroll
    for (int q = 0; q < 2; ++q) { const int id = tid + q * 512, jj = id >> 4, cc = id & 15;
      const u32x4 vw = *(const u32x4*)(PROJ + (r0 + jj) * NP + V_OFF + h * 128 + cc * 8);
      const unsigned vv[4] = {vw.x, vw.y, vw.z, vw.w};
#pragma unroll
      for (int i = 0; i < 8; ++i) vT[(cc * 8 + i) * 72 + jj] = (bf16_t)((i & 1) ? (vv[i >> 1] >> 16) : (vv[i >> 1] & 0xffffu)); }
  }
  __syncthreads();
  { const int vt = wid >> 1, dt = wid & 1; f32x16 acc = {};
#pragma unroll
    for (int ks = 0; ks < 4; ++ks) {
      const bf16x8 a = *(const LAS bf16x8*)(vT + (32 * vt + r32) * 72 + 16 * ks + 8 * hi);
      const bf16x8 bb = *(const LAS bf16x8*)(kdT + (32 * dt + r32) * 72 + 16 * ks + 8 * hi);
      acc = __builtin_amdgcn_mfma_f32_32x32x16_bf16(a, bb, acc, 0, 0, 0);
    }
    float* dst = UPD + (size_t)item * 8192 + 32 * dt + r32;
#pragma unroll
    for (int r = 0; r < 16; ++r) { const int v = 32 * vt + (r & 3) + 8 * (r >> 2) + 4 * hi; dst[(size_t)v * 64] = acc[r]; }
  }
  __syncthreads();
}

__device__ __forceinline__ void gla_scan(const Params& p, int G, int vb) {
  const float* UPD = (const float*)(p.ws + WS_Y); const float* DEC = (const float*)(p.ws + WS_DEC); bf16_t* SPT = (bf16_t*)(p.ws + WS_XB);
  for (int idx = vb * 512 + threadIdx.x; idx < 32 * 8192; idx += G * 512) {
    const int bh = idx >> 13, vd = idx & 8191, d = vd & 63;
    float S = 0.f;
#pragma unroll 8
    for (int n = 0; n < 64; ++n) { const size_t item = (size_t)bh * 64 + n; const float u = UPD[item * 8192 + vd], dc = DEC[item * 64 + d];
      SPT[item * 8192 + vd] = (bf16_t)(pk2(S, 0.f) & 0xffffu); S = dc * S + u; }
  }
}

__device__ __forceinline__ void gla_c_item(const Params& p, LAS unsigned char* lds, int item) {
  const int tid = threadIdx.x, lane = tid & 63, r32 = lane & 31, hi = lane >> 5, wid = tid >> 6;
  const int n = item & 63, bh = item >> 6, h = bh & 3, b = bh >> 2;
  const size_t r0 = (size_t)b * SEQ + n * 64;
  const bf16_t* PROJ = (const bf16_t*)(p.ws + WS_PROJ); const bf16_t* SPT = (const bf16_t*)(p.ws + WS_XB); bf16_t* Y = (bf16_t*)(p.ws + WS_Y);
  const float* gnw = p.in[6];
  gla_gates(p, lds, r0, h);
  LAS float* bc = (LAS float*)(lds + GL_B); LAS bf16_t* qe = (LAS bf16_t*)(lds + GL_KD); LAS bf16_t* ke = (LAS bf16_t*)(lds + GL_KE);
  LAS bf16_t* vT = (LAS bf16_t*)(lds + GL_VT); LAS bf16_t* sT = (LAS bf16_t*)(lds + GL_ST); LAS bf16_t* att = (LAS bf16_t*)(lds + GL_ATT); LAS float* red = (LAS float*)(lds + GL_RED);
  { const int j = tid >> 3, c = tid & 7;
    const u32x4 qw = *(const u32x4*)(PROJ + (r0 + j) * NP + Q_OFF + h * 64 + c * 8);
    const u32x4 kw = *(const u32x4*)(PROJ + (r0 + j) * NP + K_OFF + h * 64 + c * 8);
    const unsigned qq[4] = {qw.x, qw.y, qw.z, qw.w}, kk[4] = {kw.x, kw.y, kw.z, kw.w};
    float qv[8], kv[8];
#pragma unroll
    for (int i = 0; i < 8; ++i) { const float bb = bc[j * 65 + c * 8 + i];
      qv[i] = ((i & 1) ? bfhi(qq[i >> 1]) : bflo(qq[i >> 1])) * 0.125f * __expf(bb);
      kv[i] = ((i & 1) ? bfhi(kk[i >> 1]) : bflo(kk[i >> 1])) * __expf(-bb); }
    *(LAS u32x4*)(qe + j * 72 + c * 8) = (u32x4){pk2(qv[0], qv[1]), pk2(qv[2], qv[3]), pk2(qv[4], qv[5]), pk2(qv[6], qv[7])};
    *(LAS u32x4*)(ke + j * 72 + c * 8) = (u32x4){pk2(kv[0], kv[1]), pk2(kv[2], kv[3]), pk2(kv[4], kv[5]), pk2(kv[6], kv[7])};
#pragma unroll
    for (int q = 0; q < 2; ++q) { const int id = tid + q * 512, jj = id >> 4, cc = id & 15;
      const u32x4 vw = *(const u32x4*)(PROJ + (r0 + jj) * NP + V_OFF + h * 128 + cc * 8);
      const unsigned vv[4] = {vw.x, vw.y, vw.z, vw.w};
#pragma unroll
      for (int i = 0; i < 8; ++i) vT[(cc * 8 + i) * 72 + jj] = (bf16_t)((i & 1) ? (vv[i >> 1] >> 16) : (vv[i >> 1] & 0xffffu));
      const int v = id >> 3, dc = id & 7;
      *(LAS u32x4*)(sT + v * 72 + dc * 8) = *(const u32x4*)(SPT + (size_t)item * 8192 + v * 64 + dc * 8); }
  }
  __syncthreads();
  if (wid < 4) {
    const int it = wid >> 1, jt = wid & 1; f32x16 acc = {};
    if (!(it == 0 && jt == 1)) {
#pragma unroll
      for (int ks = 0; ks < 4; ++ks) {
        const bf16x8 a = *(const LAS bf16x8*)(qe + (32 * it + r32) * 72 + 16 * ks + 8 * hi);
        const bf16x8 bb = *(const LAS bf16x8*)(ke + (32 * jt + r32) * 72 + 16 * ks + 8 * hi);
        acc = __builtin_amdgcn_mfma_f32_32x32x16_bf16(a, bb, acc, 0, 0, 0);
      }
    }
#pragma unroll
    for (int r = 0; r < 16; ++r) { const int i = 32 * it + (r & 3) + 8 * (r >> 2) + 4 * hi, j = 32 * jt + r32;
      att[i * 72 + j] = (bf16_t)(pk2(j <= i ? acc[r] : 0.f, 0.f) & 0xffffu); }
  }
  __syncthreads();
  { const int it = wid >> 2, vt = wid & 3; f32x16 acc = {};
#pragma unroll
    for (int ks = 0; ks < 4; ++ks) {
      const bf16x8 a = *(const LAS bf16x8*)(att + (32 * it + r32) * 72 + 16 * ks + 8 * hi);
      const bf16x8 bb = *(const LAS bf16x8*)(vT + (32 * vt + r32) * 72 + 16 * ks + 8 * hi);
      acc = __builtin_amdgcn_mfma_f32_32x32x16_bf16(a, bb, acc, 0, 0, 0);
    }
#pragma unroll
    for (int ks = 0; ks < 4; ++ks) {
      const bf16x8 a = *(const LAS bf16x8*)(qe + (32 * it + r32) * 72 + 16 * ks + 8 * hi);
      const bf16x8 bb = *(const LAS bf16x8*)(sT + (32 * vt + r32) * 72 + 16 * ks + 8 * hi);
      acc = __builtin_amdgcn_mfma_f32_32x32x16_bf16(a, bb, acc, 0, 0, 0);
    }
    float sq[16];
#pragma unroll
    for (int r = 0; r < 16; ++r) { float s = acc[r] * acc[r];
      s += __shfl_xor(s, 1); s += __shfl_xor(s, 2); s += __shfl_xor(s, 4); s += __shfl_xor(s, 8); s += __shfl_xor(s, 16); sq[r] = s; }
    if (r32 == 0) {
#pragma unroll
      for (int r = 0; r < 16; ++r) red[(32 * it + (r & 3) + 8 * (r >> 2) + 4 * hi) * 4 + vt] = sq[r];
    }
    __syncthreads();
    const int v = 32 * vt + r32; const float nw = gnw[v];
#pragma unroll
    for (int r = 0; r < 16; ++r) { const int i = 32 * it + (r & 3) + 8 * (r >> 2) + 4 * hi;
      const float tot = (red[i * 4 + 0] + red[i * 4 + 1]) + (red[i * 4 + 2] + red[i * 4 + 3]);
      const float rinv = rsqrtf(tot * (1.f / 128.f) + EPS);
      const float og = bf2f(PROJ[(r0 + i) * NP + OG_OFF + h * 128 + v]);
      const float yv = acc[r] * rinv * nw * (og / (1.f + __expf(-og)));
      Y[(r0 + i) * 1024 + h * 128 + v] = (bf16_t)(pk2(yv, 0.f) & 0xffffu); }
  }
  __syncthreads();
}

constexpr int RT_LG = 0;
constexpr int RT_HIST = 8 * 16 * 49 * 4;
constexpr int RT_BASE = RT_HIST + 128;
__device__ __forceinline__ void router_phase(const Params& p, LAS unsigned char* lds, int G, int vb) {
  const int tid = threadIdx.x, lane = tid & 63, wave = tid >> 6;
  const bf16_t* HB = (const bf16_t*)(p.ws + WS_XB); const bf16_t* WrT = (const bf16_t*)(p.ws + WS_WR);
  const float* ssq2 = (const float*)(p.ws + WS_SSQ2); int* cnt = (int*)(p.ws + WS_CNT); int* LTOK = (int*)(p.ws + WS_LTOK); float* LGATE = (float*)(p.ws + WS_LGATE);
  const float* gbias = p.in[14]; const float* ebias = p.in[16];
  LAS float* lg = (LAS float*)(lds + RT_LG) + wave * 16 * 49; LAS int* hist = (LAS int*)(lds + RT_HIST); LAS int* basee = (LAS int*)(lds + RT_BASE);
  for (int base = vb * 8; base < NTOK / 16; base += G * 8) {
    if (tid < 32) hist[tid] = 0;
    const int r0 = (base + wave) * 16;
    f32x4 acc[3] = {{0.f, 0.f, 0.f, 0.f}, {0.f, 0.f, 0.f, 0.f}, {0.f, 0.f, 0.f, 0.f}};
    const bf16_t* arow = HB + (size_t)(r0 + (lane & 15)) * 1024 + (lane >> 4) * 8;
    const bf16_t* brow = WrT + (size_t)(lane & 15) * 1024 + (lane >> 4) * 8;
#pragma unroll 4
    for (int kk = 0; kk < 32; ++kk) {
      const bf16x8 a = *(const bf16x8*)(arow + kk * 32);
#pragma unroll
      for (int n = 0; n < 3; ++n) { const bf16x8 bb = *(const bf16x8*)(brow + (size_t)n * 16 * 1024 + kk * 32); acc[n] = __builtin_amdgcn_mfma_f32_16x16x32_bf16(a, bb, acc[n], 0, 0, 0); }
    }
#pragma unroll
    for (int n = 0; n < 3; ++n)
#pragma unroll
      for (int r = 0; r < 4; ++r) lg[((lane >> 4) * 4 + r) * 49 + 16 * n + (lane & 15)] = acc[n][r];
    __syncthreads();
    int e1 = 0, e2 = 0, lp1 = 0, lp2 = 0; float g1 = 0.f, g2 = 0.f; const int tok = r0 + lane;
    if (lane < 16) {
      const float rs = rsqrtf(ssq2[tok] * (1.f / 1024.f) + EPS);
      float gl[4]; int gs = 0;
#pragma unroll
      for (int i = 0; i < 4; ++i) gl[i] = lg[lane * 49 + i] * rs + gbias[i];
#pragma unroll
      for (int i = 1; i < 4; ++i) if (gl[i] > gl[gs]) gs = i;
      float den = 0.f;
#pragma unroll
      for (int i = 0; i < 4; ++i) den += __expf(gl[i] - gl[gs]);
      const float pg = 1.f / den;
      float el[8];
#pragma unroll
      for (int i = 0; i < 8; ++i) el[i] = lg[lane * 49 + 4 + gs * 8 + i] * rs + ebias[gs * 8 + i];
      int i1 = 0;
#pragma unroll
      for (int i = 1; i < 8; ++i) if (el[i] > el[i1]) i1 = i;
      int i2 = (i1 == 0) ? 1 : 0;
#pragma unroll
      for (int i = 0; i < 8; ++i) if (i != i1 && el[i] > el[i2]) i2 = i;
      const float t = __expf(el[i2] - el[i1]);
      g1 = pg / (1.f + t); g2 = pg * t / (1.f + t);
      e1 = gs * 8 + i1; e2 = gs * 8 + i2;
      lp1 = atomicAdd((int*)(hist + e1), 1); lp2 = atomicAdd((int*)(hist + e2), 1);
    }
    __syncthreads();
    if (tid < 32) { const int hc = hist[tid]; basee[tid] = hc ? atomicAdd(cnt + tid, hc) : 0; }
    __syncthreads();
    if (lane < 16) {
      const int p1 = e1 * ECAP + basee[e1] + lp1, p2 = e2 * ECAP + basee[e2] + lp2;
      LTOK[p1] = tok * 2; LGATE[p1] = g1; LTOK[p2] = tok * 2 + 1; LGATE[p2] = g2;
    }
    __syncthreads();
  }
}

__device__ __forceinline__ void final_phase(const Params& p, int G, int vb) {
  const int lane = threadIdx.x & 63, wave = threadIdx.x >> 6;
  const float* fw = p.in[20]; const bf16_t* Y2 = (const bf16_t*)(p.ws + WS_PROJ);
  for (int m = vb * 8 + wave; m < NTOK; m += G * 8) {
    f32x4* orow = (f32x4*)(p.out + (size_t)m * DM) + lane;
    f32x4 v[4]; float s = 0.f;
#pragma unroll
    for (int j = 0; j < 4; ++j) {
      v[j] = orow[64 * j];
#if ENABLE_MOE
      const u32x2 a = *((const u32x2*)(Y2 + (size_t)(2 * m) * 1024) + lane + 64 * j), b = *((const u32x2*)(Y2 + (size_t)(2 * m + 1) * 1024) + lane + 64 * j);
      v[j].x += bflo(a.x) + bflo(b.x); v[j].y += bfhi(a.x) + bfhi(b.x); v[j].z += bflo(a.y) + bflo(b.y); v[j].w += bfhi(a.y) + bfhi(b.y);
#endif
      s += (v[j].x * v[j].x + v[j].y * v[j].y) + (v[j].z * v[j].z + v[j].w * v[j].w);
    }
    s = wave_sum(s);
    const float rs = rsqrtf(s * (1.f / DM) + EPS);
#pragma unroll
    for (int j = 0; j < 4; ++j) { const f32x4 w = *((const f32x4*)fw + lane + 64 * j); orow[64 * j] = v[j] * rs * w; }
  }
}

constexpr int LDS_CTL = 131072;
constexpr int LDS_BYTES = 131072 + 1024 + 8192;

__global__ void __launch_bounds__(512) fwd(Params p, int ph_lo, int ph_hi) {
  extern __shared__ __attribute__((aligned(16))) unsigned char lds_raw[];
  LAS unsigned char* lds = (LAS unsigned char*)lds_raw;
  cg::grid_group grid = cg::this_grid();
  const int G = gridDim.x, bx = blockIdx.x;
  const int vb = (G % 8 == 0) ? (bx % 8) * (G / 8) + bx / 8 : bx;
  unsigned char* ws = p.ws;
#ifndef PHMASK
#define PHMASK 0x3ff
#endif
#define PH(k) (((PHMASK >> (k)) & 1) && ph_lo <= (k) && (k) < ph_hi)
#define SEAM(k) do { if (PH(k) && PH((k) + 1)) grid.sync(); } while (0)
  if (PH(0)) p0_prologue(p, lds, G, vb);
  SEAM(0);
  if (PH(1)) {
    g8::DenseSched S; S.init(ws + WS_XB, 1024, ws + WS_WIN, 1024, NTOK, NP, G, bx);
    EpiInproj E{(bf16_t*)(ws + WS_PROJ), (const float*)(ws + WS_RS1), (float*)(ws + WS_SSQQ), (float*)(ws + WS_SSQKV), (const f32x2*)(ws + WS_CS)};
    g8::gemm_phase(lds, 1024, S, E);
  }
  SEAM(1);
  if (PH(2)) {
#if ENABLE_MLA
#ifndef NO_UQ
    { g8::DenseSched S; S.init((const bf16_t*)(ws + WS_PROJ) + CQ_OFF, NP, ws + WS_WUQ, 384, NTOK, 768, G, bx);
      EpiUq E{(bf16_t*)(ws + WS_QB), (const float*)(ws + WS_SSQQ), (const f32x2*)(ws + WS_CS)};
      g8::gemm_phase(lds, 384, S, E); }
#endif
#ifndef NO_UKV
    { g8::DenseSched S; S.init((const bf16_t*)(ws + WS_PROJ) + CKV_OFF, NP, ws + WS_WUKV, 256, NTOK, 1024, G, bx);
      EpiUkv E{(bf16_t*)(ws + WS_KVB), (const float*)(ws + WS_SSQKV)};
      g8::gemm_phase(lds, 256, S, E); }
#endif
#endif
#if ENABLE_GLA
#pragma unroll 1
    for (int it = vb; it < 2048; it += G) gla_a_item(p, lds, it);
#endif
  }
  SEAM(2);
  if (PH(3)) {
#if ENABLE_GLA
    gla_scan(p, G, vb);
#endif
  }
  SEAM(3);
  if (PH(4)) {
#if ENABLE_MLA
    attn_phase(p, lds, G, vb);
#else
    { u32x4* Yz = (u32x4*)(ws + WS_Y); for (int i = vb * 512 + threadIdx.x; i < NTOK * 64; i += G * 512) Yz[(size_t)(i >> 6) * 128 + 64 + (i & 63)] = (u32x4){0u, 0u, 0u, 0u}; }
#endif
#if ENABLE_GLA
#pragma unroll 1
    for (int it = vb; it < 2048; it += G) gla_c_item(p, lds, it);
#endif
  }
  SEAM(4);
  if (PH(5)) {
    g8::DenseSched S; S.init(ws + WS_Y, 1024, ws + WS_WOUT, 1024, NTOK, 1024, G, bx);
    EpiWout E{p.in[0], p.out, (bf16_t*)(ws + WS_XB), (float*)(ws + WS_SSQ2)};
    g8::gemm_phase(lds, 1024, S, E);
  }
  SEAM(5);
#if ENABLE_MOE
  if (PH(6)) router_phase(p, lds, G, vb);
  SEAM(6);
  if (PH(7) || PH(8)) {
    LAS int* tb = (LAS int*)(lds + LDS_CTL); LAS int* cn = (LAS int*)(lds + LDS_CTL + 256);
    if (threadIdx.x == 0) { const int* cnt = (const int*)(ws + WS_CNT); int acc = 0;
      for (int e = 0; e < NEXP; ++e) { const int c = cnt[e]; cn[e] = c; tb[e] = acc; acc += (c + 255) >> 8; }
      tb[NEXP] = acc; }
    __syncthreads();
    const int T = tb[NEXP];
    if (PH(7)) {
      MoeSched<true> S; S.A = (const char*)(ws + WS_XB); S.B = (const char*)(ws + WS_WGU); S.lda = 1024; S.ldb = 1024; S.ncol = 2; S.total = T * 2; S.G = G; S.c = bx;
      S.tb = tb; S.cn = cn; S.ltok = (const int*)(ws + WS_LTOK); S.bstride = (size_t)512 * 1024 * 2;
      EpiGU E{(bf16_t*)(ws + WS_QB), (const float*)(ws + WS_SSQ2), (const int*)(ws + WS_LTOK), cn};
      g8::gemm_phase(lds, 1024, S, E);
    }
    SEAM(7);
    if (PH(8)) {
      MoeSched<false> S; S.A = (const char*)(ws + WS_QB); S.B = (const char*)(ws + WS_WD); S.lda = 256; S.ldb = 256; S.ncol = 4; S.total = T * 4; S.G = G; S.c = bx;
      S.tb = tb; S.cn = cn; S.ltok = (const int*)(ws + WS_LTOK); S.bstride = (size_t)1024 * 256 * 2;
      EpiDown E{(bf16_t*)(ws + WS_PROJ), (const int*)(ws + WS_LTOK), (const float*)(ws + WS_LGATE), cn};
      g8::gemm_phase(lds, 256, S, E);
    }
  }
  SEAM(8);
#endif
  if (PH(9)) final_phase(p, G, vb);
#undef PH
#undef SEAM
}

extern "C" void kernel_launch(void* const* d_in, const int* in_sizes, int n_in, void* d_out, int out_size,
                              void* d_ws, size_t ws_size, hipStream_t stream) {
  static int grid_blocks = 0;
  if (grid_blocks == 0) {
    if (n_in != 21 || ws_size < WS_END) { fprintf(stderr, "kernel_launch: unexpected n_in %d or ws_size %zu (< %zu)\n", n_in, ws_size, (size_t)WS_END); grid_blocks = -1; return; }
    int dev = 0, cus = 0, per_cu = 0;
    hipGetDevice(&dev);
    hipDeviceGetAttribute(&cus, hipDeviceAttributeMultiprocessorCount, dev);
    hipFuncSetAttribute((const void*)fwd, hipFuncAttributeMaxDynamicSharedMemorySize, LDS_BYTES);
    hipOccupancyMaxActiveBlocksPerMultiprocessor(&per_cu, (const void*)fwd, 512, LDS_BYTES);
    if (per_cu < 1) { fprintf(stderr, "kernel_launch: occupancy query says %d blocks/CU\n", per_cu); per_cu = 1; }
    grid_blocks = cus;
  }
  if (grid_blocks < 0) return;
  Params p{};
  for (int i = 0; i < 21; ++i) p.in[i] = (const float*)d_in[i];
  p.out = (float*)d_out; p.ws = (unsigned char*)d_ws;
  int lo = 0, hi = 10;
  void* args[] = {&p, &lo, &hi};
  hipError_t e = hipLaunchCooperativeKernel((void*)fwd, dim3(grid_blocks), dim3(512), args, LDS_BYTES, stream);
  if (e != hipSuccess) fprintf(stderr, "cooperative launch failed: %s (grid %d)\n", hipGetErrorString(e), grid_blocks);
}
```

```cpp
#include <hip/hip_runtime.h>
#include <hip/hip_cooperative_groups.h>
#include <cstdio>
#include <cstdint>
#include <cmath>
namespace cg = cooperative_groups;

#ifndef MOE_FP8
#define MOE_FP8 1
#endif
#ifndef ENABLE_GLA
#define ENABLE_GLA 1
#endif
#ifndef ENABLE_MLA
#define ENABLE_MLA 1
#endif
#ifndef ENABLE_MOE
#define ENABLE_MOE 1
#endif

#ifndef P8_DRY
#define P8_DRY false
#endif
#ifndef REPEAT_PHASE
#define REPEAT_PHASE -1
#endif
#ifndef REPEAT_SUB
#define REPEAT_SUB 3
#endif
#define NREP(k) ((REPEAT_PHASE == (k)) ? 2 : 1)
#define LAS __attribute__((address_space(3)))
typedef unsigned short bf16_t;
typedef short bf16x8 __attribute__((ext_vector_type(8)));
typedef short s16x4 __attribute__((ext_vector_type(4)));
typedef float f32x4 __attribute__((ext_vector_type(4)));
typedef float f32x2 __attribute__((ext_vector_type(2)));
typedef float f32x16 __attribute__((ext_vector_type(16)));
typedef unsigned u32x4 __attribute__((ext_vector_type(4)));
typedef unsigned u32x2 __attribute__((ext_vector_type(2)));
typedef int i32x4 __attribute__((ext_vector_type(4)));
typedef int i32x8 __attribute__((ext_vector_type(8)));
typedef __bf16 bf16x2_t __attribute__((ext_vector_type(2)));

constexpr int NTOK = 32768, DM = 1024, SEQ = 4096, NBATCH = 8;
constexpr int NP = 2304;
constexpr int Q_OFF = 0, K_OFF = 256, V_OFF = 512, OG_OFF = 1024, CQ_OFF = 1536, CKV_OFF = 1920, KR_OFF = 2176, LR_OFF = 2208;
constexpr int NEXP = 32, ECAP = 32768;
constexpr float EPS = 1e-6f;
constexpr float F8_SH = 4.f, F8_SWGU = 32.f, F8_SHID = 4.f, F8_SWD = 16.f;
constexpr float QSCALE = 0.10206207261596575f * 1.4426950408889634f;

constexpr size_t MiB = 1u << 20;
constexpr size_t WS_CNT = 0;
constexpr size_t WS_FLG = 4096;
constexpr size_t WS_BAR = 128 * 1024;
constexpr size_t WS_GUT = 64 * 1024;
constexpr size_t WS_RS1 = 1 * MiB;
constexpr size_t WS_RS2 = 1 * MiB + 512 * 1024;
constexpr size_t WS_SSQP = 2 * MiB;
constexpr size_t WS_CS = 4 * MiB;
constexpr size_t WS_LTOK = 8 * MiB;
constexpr size_t WS_LGATE = 12 * MiB;
constexpr size_t WS_WIN = 16 * MiB;
constexpr size_t WS_WUQ = 21 * MiB;
constexpr size_t WS_WUKV = 22 * MiB;
constexpr size_t WS_WOUT = 23 * MiB;
constexpr size_t WS_WR = 25 * MiB;
constexpr size_t WS_WGU = 26 * MiB;
constexpr size_t WS_WD = 58 * MiB;
constexpr size_t WS_DEC = 74 * MiB;
constexpr size_t WS_XB = 80 * MiB;
constexpr size_t WS_PROJ = 144 * MiB;
constexpr size_t WS_QB = 288 * MiB;
constexpr size_t WS_KVB = 336 * MiB;
constexpr size_t WS_Y = 400 * MiB;
constexpr size_t WS_SPT = 464 * MiB;
constexpr size_t WS_H8 = WS_KVB;
constexpr size_t WS_END = 496 * MiB;

struct Params {
  const float* in[21];
  float* out;
  unsigned char* ws;
};

__device__ __forceinline__ unsigned pk2(float lo, float hi) { f32x2 v = {lo, hi}; bf16x2_t b = __builtin_convertvector(v, bf16x2_t); return __builtin_bit_cast(unsigned, b); }
__device__ __forceinline__ float bf2f(unsigned short h) { return __uint_as_float(((unsigned)h) << 16); }
__device__ __forceinline__ float bflo(unsigned w) { return __uint_as_float(w << 16); }
__device__ __forceinline__ float bfhi(unsigned w) { return __uint_as_float(w & 0xffff0000u); }
__device__ __forceinline__ u32x2 pk8_fp8(const f32x4& a, const f32x4& b, float sc) {
  float t[8] = {a[0] * sc, a[1] * sc, a[2] * sc, a[3] * sc, b[0] * sc, b[1] * sc, b[2] * sc, b[3] * sc};
#pragma unroll
  for (int i = 0; i < 8; ++i) t[i] = fminf(fmaxf(t[i], -448.f), 448.f);
  int lo = __builtin_amdgcn_cvt_pk_fp8_f32(t[0], t[1], 0, false); lo = __builtin_amdgcn_cvt_pk_fp8_f32(t[2], t[3], lo, true);
  int hi = __builtin_amdgcn_cvt_pk_fp8_f32(t[4], t[5], 0, false); hi = __builtin_amdgcn_cvt_pk_fp8_f32(t[6], t[7], hi, true);
  u32x2 r; r.x = (unsigned)lo; r.y = (unsigned)hi; return r;
}
__device__ __forceinline__ int perm32(int rho) { const int n = rho >> 4, i = rho & 15; return 8 * (i >> 2) + 4 * n + (i & 3); }
__device__ __forceinline__ float wave_sum(float v) {
#pragma unroll
  for (int o = 1; o < 64; o <<= 1) v += __shfl_xor(v, o);
  return v;
}
#define XCD_BAR_WORDS 3456
#define LDS_WAIT() asm volatile("s_waitcnt lgkmcnt(0)" ::: "memory")
#define LBAR() asm volatile("s_waitcnt lgkmcnt(0)\n\ts_barrier" ::: "memory")

namespace g8 {
constexpr int BM = 256, BK = 64, HALF = 128, HTB = HALF * BK * 2, STAGE_BYTES = 8 * HTB, NXCD = 8, WGM = 8;
__device__ __forceinline__ int lds_byte(int r, int c) { const int st = (r >> 4) * 2 + (c >> 5), rr = r & 15, cc = c & 31, ob = rr * 64 + cc * 2; return st * 1024 + (ob ^ (((ob >> 9) & 1) << 5)); }
__device__ __forceinline__ void stage_rc(int b, int& R, int& C) { const int st = b / 1024, sb = b % 1024, swz = sb ^ (((sb >> 9) & 1) << 5); R = (st >> 1) * 16 + swz / 64; C = (st & 1) * 32 + (swz % 64) / 2; }

struct Unit { const char* A; const char* B; int a, b, c, d; };

template <int F8 = 0  , class Epi, class Sched>
__device__ __forceinline__ void gemm_phase(LAS unsigned char* lds, const int K, const Sched& S, const Epi& E) {
  const int tid = threadIdx.x, wid = __builtin_amdgcn_readfirstlane(tid >> 6), lane = tid & 63, wr = wid >> 2, wc = wid & 3, fr = lane & 15, fq = lane >> 4;
  const int nt = K / BK;
  int R[2], C[2];
#pragma unroll
  for (int i = 0; i < 2; ++i) stage_rc(tid * 16 + i * 8192, R[i], C[i]);
  constexpr bool GA = Sched::GATHER;
  unsigned oB[2], oA[2][2];
  LAS unsigned* onxt = (LAS unsigned*)(lds + STAGE_BYTES + 1024) + tid;
#pragma unroll
  for (int i = 0; i < 2; ++i) oB[i] = (unsigned)(R[i] * S.ldb + C[i]) * 2u;
  const size_t hB = (size_t)HALF * S.ldb * 2, hA = GA ? (size_t)0 : (size_t)HALF * S.lda * 2;
  const size_t kstep = (size_t)(BK * 2);
  const unsigned ldsw = (unsigned)wid * 1024u;
  const int aoff = lds_byte(wr * 64 + fr, fq * 8), boff = lds_byte(wc * 32 + fr, fq * 8);
#define G8_SA(b, h) (((b) * 2 + (h)) * HTB)
#define G8_SB(b, h) ((4 + (b) * 2 + (h)) * HTB)
#define G8_STAGE_X(bufoff, gbase, off2, AUX) do { _Pragma("unroll") for (int _i = 0; _i < 2; ++_i) \
    __builtin_amdgcn_global_load_lds((const unsigned*)((const char*)(gbase) + (off2)[_i]), (LAS unsigned*)(lds + (bufoff) + ldsw + _i * 8192), 16, 0, AUX); } while (0)
#define G8_STAGE(bufoff, gbase, off2) G8_STAGE_X(bufoff, gbase, off2, 0)
#define G8_STAGEA(bufoff, gbase, off2) G8_STAGE_X(bufoff, gbase, off2, (Sched::A_SC1 ? 16 : 0))
#define G8_LD16(off_) (*(const LAS i32x4*)(lds + (off_)))
#define G8_LDA(dst, b, h) do { _Pragma("unroll") for (int m = 0; m < 4; ++m) { \
    if constexpr (F8 == 2) dst##8[m] = __builtin_shufflevector(G8_LD16(G8_SA(b, h) + aoff + m * 2048), G8_LD16(G8_SA(b, h) + aoff + m * 2048 + 1024), 0, 1, 2, 3, 4, 5, 6, 7); \
    else { _Pragma("unroll") for (int k = 0; k < 2; ++k) dst[m][k] = *(const LAS bf16x8*)(lds + G8_SA(b, h) + aoff + m * 2048 + k * 1024); } } } while (0)
#define G8_LDB(dst, b, h) do { _Pragma("unroll") for (int n = 0; n < 2; ++n) { \
    if constexpr (F8 == 2) dst##8[n] = __builtin_shufflevector(G8_LD16(G8_SB(b, h) + boff + n * 2048), G8_LD16(G8_SB(b, h) + boff + n * 2048 + 1024), 0, 1, 2, 3, 4, 5, 6, 7); \
    else { _Pragma("unroll") for (int k = 0; k < 2; ++k) dst[n][k] = *(const LAS bf16x8*)(lds + G8_SB(b, h) + boff + n * 2048 + k * 1024); } } } while (0)
#define G8_MMA(ai, bj, At, Bt) do { __builtin_amdgcn_s_setprio(1); \
    if constexpr (F8 == 2) {   \
      _Pragma("unroll") for (int m = 0; m < 4; ++m) _Pragma("unroll") for (int n = 0; n < 2; ++n) \
        acc[ai][bj][m][n] = __builtin_amdgcn_mfma_scale_f32_16x16x128_f8f6f4(Bt##8[n], At##8[m], acc[ai][bj][m][n], 0, 0, 0, 0x7f7f7f7f, 0, 0x7f7f7f7f); \
    } else if constexpr (F8 == 1) { \
      _Pragma("unroll") for (int m = 0; m < 4; ++m) _Pragma("unroll") for (int n = 0; n < 2; ++n) { \
        const i32x4 b0_ = __builtin_bit_cast(i32x4, Bt[n][0]), b1_ = __builtin_bit_cast(i32x4, Bt[n][1]), a0_ = __builtin_bit_cast(i32x4, At[m][0]), a1_ = __builtin_bit_cast(i32x4, At[m][1]); \
        acc[ai][bj][m][n] = __builtin_amdgcn_mfma_scale_f32_16x16x128_f8f6f4(__builtin_shufflevector(b0_, b1_, 0, 1, 2, 3, 4, 5, 6, 7), __builtin_shufflevector(a0_, a1_, 0, 1, 2, 3, 4, 5, 6, 7), \
                                                                             acc[ai][bj][m][n], 0, 0, 0, 0x7f7f7f7f, 0, 0x7f7f7f7f); } \
    } else { \
      _Pragma("unroll") for (int m = 0; m < 4; ++m) _Pragma("unroll") for (int n = 0; n < 2; ++n) _Pragma("unroll") for (int k = 0; k < 2; ++k) \
        acc[ai][bj][m][n] = __builtin_amdgcn_mfma_f32_16x16x32_bf16(Bt[n][k], At[m][k], acc[ai][bj][m][n], 0, 0, 0); } \
    __builtin_amdgcn_s_setprio(0); } while (0)
#define G8_WAIT_V(n) asm volatile("s_waitcnt vmcnt(" #n ")" ::: "memory")
#define G8_WAIT_L(n) asm volatile("s_waitcnt lgkmcnt(" #n ")" ::: "memory")
#define G8_BAR __builtin_amdgcn_s_barrier()
#define G8_SCHED __builtin_amdgcn_sched_barrier(0)
  Unit cur, nxt; int ui = 0;
  if (!S.next(0, cur)) return;
  S.offs(cur, R, C, oA);
  f32x4 acc[2][2][4][2];
#pragma unroll
  for (int a = 0; a < 2; ++a)
#pragma unroll
    for (int b = 0; b < 2; ++b)
#pragma unroll
      for (int m = 0; m < 4; ++m)
#pragma unroll
        for (int n = 0; n < 2; ++n) acc[a][b][m][n] = (f32x4){0.f, 0.f, 0.f, 0.f};
  bf16x8 At[4][2], B0[2][2], B1[2][2];
  i32x8 At8[4], B08[2], B18[2];
  const char* cA = cur.A; const char* cB = cur.B;
  G8_STAGE(G8_SB(0, 0), cB, oB); G8_STAGE(G8_SB(0, 1), cB + hB, oB); G8_STAGEA(G8_SA(0, 0), cA, oA[0]); G8_STAGEA(G8_SA(0, 1), cA + hA, oA[GA]);
  if (wr == 1) G8_BAR;
  G8_WAIT_V(2); G8_BAR;
  G8_STAGE(G8_SB(1, 0), cB + kstep, oB); G8_STAGEA(G8_SA(1, 0), cA + kstep, oA[0]); G8_STAGE(G8_SB(1, 1), cB + kstep + hB, oB);
  G8_WAIT_V(6); G8_BAR;
  for (;;) {
    const bool has_next = S.next(ui + 1, nxt);
    if (GA && has_next) {
      unsigned oAn[2][2]; S.offs(nxt, R, C, oAn);
#pragma unroll
      for (int h = 0; h < 2; ++h)
#pragma unroll
        for (int i = 0; i < 2; ++i) onxt[(h * 2 + i) * 512] = oAn[h][i];
    }
    const char* nA = has_next ? nxt.A : cA; const char* nB = has_next ? nxt.B : cB;
#pragma unroll 1
    for (int t = 0; t < nt; t += 2) {
      const bool last = (t == nt - 2);
      const char* a1 = cA + (size_t)(t + 1) * kstep;
      const char* a2 = last ? nA : cA + (size_t)(t + 2) * kstep; const char* b2 = last ? nB : cB + (size_t)(t + 2) * kstep;
      const char* a3 = a2 + kstep; const char* b3 = b2 + kstep;
      G8_LDB(B0, 0, 0); G8_LDB(B1, 0, 1); G8_SCHED; G8_LDA(At, 0, 0); G8_STAGEA(G8_SA(1, 1), a1 + hA, oA[GA]);
      G8_WAIT_V(8); G8_WAIT_L(0); G8_BAR; G8_MMA(0, 0, At, B0); G8_MMA(0, 1, At, B1); G8_BAR; G8_SCHED;
      if (GA && last && has_next) {
#pragma unroll
        for (int h = 0; h < 2; ++h)
#pragma unroll
          for (int i = 0; i < 2; ++i) oA[h][i] = onxt[(h * 2 + i) * 512];
      }
      G8_LDA(At, 0, 1); G8_STAGE(G8_SB(0, 0), b2, oB); G8_STAGE(G8_SB(0, 1), b2 + hB, oB); G8_STAGEA(G8_SA(0, 0), a2, oA[0]);
      G8_WAIT_V(8); G8_WAIT_L(0); G8_BAR; G8_MMA(1, 0, At, B0); G8_MMA(1, 1, At, B1); G8_BAR; G8_SCHED;
      G8_LDB(B0, 1, 0); G8_LDB(B1, 1, 1); G8_SCHED; G8_LDA(At, 1, 0); G8_STAGEA(G8_SA(0, 1), a2 + hA, oA[GA]);
      G8_WAIT_V(8); G8_WAIT_L(0); G8_BAR; G8_MMA(0, 0, At, B0); G8_MMA(0, 1, At, B1); G8_BAR; G8_SCHED;
      G8_LDA(At, 1, 1); G8_STAGE(G8_SB(1, 0), b3, oB); G8_STAGE(G8_SB(1, 1), b3 + hB, oB); G8_STAGEA(G8_SA(1, 0), a3, oA[0]);
      G8_WAIT_V(8); G8_WAIT_L(0); G8_BAR; G8_MMA(1, 0, At, B0); G8_MMA(1, 1, At, B1); G8_BAR; G8_SCHED;
    }
    if (wr == 0) G8_BAR;
    E(acc, cur, wr, wc, fr, fq);
    if (!has_next) break;
#pragma unroll
    for (int a = 0; a < 2; ++a)
#pragma unroll
      for (int b = 0; b < 2; ++b)
#pragma unroll
        for (int m = 0; m < 4; ++m)
#pragma unroll
          for (int n = 0; n < 2; ++n) acc[a][b][m][n] = (f32x4){0.f, 0.f, 0.f, 0.f};
    cur = nxt; cA = nA; cB = nB; ++ui;
    if (wr == 1) G8_BAR;
  }
  G8_WAIT_V(0);
  G8_BAR;
#undef G8_SA
#undef G8_SB
#undef G8_STAGE
#undef G8_STAGEA
#undef G8_STAGE_X
#undef G8_LD16
#undef G8_LDA
#undef G8_LDB
#undef G8_MMA
#undef G8_WAIT_V
#undef G8_WAIT_L
#undef G8_BAR
#undef G8_SCHED
}

struct DenseSched {
  static constexpr bool GATHER = false, A_SC1 = false;
  const char* A; const char* B; int lda, ldb; int nM, nN, nwg, G, c;
  __device__ __forceinline__ void init(const void* A_, int lda_, const void* B_, int ldb_, int M, int N, int G_, int c_) {
    A = (const char*)A_; B = (const char*)B_; lda = lda_; ldb = ldb_; nM = M / BM; nN = N / BM; nwg = nM * nN; G = G_; c = c_; }
  __device__ __forceinline__ bool next(int i, Unit& u) const {
    const long L = (long)i * G + c; if (L >= nwg) return false;
    int wgid = (int)L; { const int q = nwg / NXCD, r = nwg % NXCD, xcd = wgid % NXCD, off = wgid / NXCD; wgid = (xcd < r ? xcd * (q + 1) : r * (q + 1) + (xcd - r) * q) + off; }
    const int nig = WGM * nN, gid = wgid / nig, fm = gid * WGM, gsz = (nM - fm) < WGM ? (nM - fm) : WGM;
    const int pm = fm + ((wgid % nig) % gsz), pn = (wgid % nig) / gsz;
    u.a = pm; u.b = pn; u.c = 0; u.d = 0;
    u.A = A + (size_t)pm * BM * lda * 2; u.B = B + (size_t)pn * BM * ldb * 2; return true;
  }
  __device__ __forceinline__ void offs(const Unit&, const int (&R)[2], const int (&C)[2], unsigned (&o)[2][2]) const {
#pragma unroll
    for (int h = 0; h < 2; ++h)
#pragma unroll
      for (int i = 0; i < 2; ++i) o[h][i] = (unsigned)(R[i] * lda + C[i]) * 2u;
  }
};
}

__device__ __forceinline__ u32x4 pack8(const f32x4& a, const f32x4& b) { u32x4 w; w.x = pk2(a[0], a[1]); w.y = pk2(a[2], a[3]); w.z = pk2(b[0], b[1]); w.w = pk2(b[2], b[3]); return w; }

__device__ __forceinline__ __amdgpu_buffer_rsrc_t mk_rsrc(const void* base) { return __builtin_amdgcn_make_buffer_rsrc((void*)base, 0, 0x7fffffff, 0x00020000); }

__device__ __forceinline__ void rope4(f32x4& a, f32x4& b, const f32x2* cs) {
#pragma unroll
  for (int j = 0; j < 4; ++j) { const float c = cs[j].x, s = cs[j].y, x1 = a[j], x2 = b[j]; a[j] = x1 * c - x2 * s; b[j] = x1 * s + x2 * c; }
}

#define EPI_ROW(ri) (((ri) >> 2) * 128 + wr * 64 + ((ri) & 3) * 16 + fr)
#define EPI_FENCE() asm volatile("" ::: "memory")

struct EpiInproj {
  bf16_t* PROJ; const float* rs1; float* ssqp; const f32x2* CS;
  __device__ __forceinline__ void operator()(const f32x4 (&acc)[2][2][4][2], const g8::Unit& u, int wr, int wc, int fr, int fq) const {
    asm volatile("" : "+v"(fr), "+v"(fq));
    const int pm = u.a, pn = u.b;
    const bool cq0 = (pn == 6 || pn == 7), cq1 = (pn == 6), ckv0 = (pn == 8), ckv1 = (pn == 7);
    float rsv[8];
#pragma unroll
    for (int ri = 0; ri < 8; ++ri) rsv[ri] = rs1[pm * 256 + EPI_ROW(ri)];
#pragma unroll
    for (int ri = 0; ri < 8; ++ri) {
      EPI_FENCE();
      const int ai = ri >> 2, m = ri & 3;
      const int row = pm * 256 + EPI_ROW(ri);
      const float rs = rsv[ri];
      float sq = 0.f, skv = 0.f;
#pragma unroll
      for (int bj = 0; bj < 2; ++bj) {
        const int G = 8 * pn + 4 * bj + wc;
        f32x4 v0 = acc[ai][bj][m][0] * rs, v1 = acc[ai][bj][m][1] * rs;
        if (G == 68) {
          f32x2 cs[4];
#pragma unroll
          for (int j = 0; j < 4; ++j) cs[j] = CS[(size_t)row * 16 + 4 * fq + j];
          rope4(v0, v1, cs);
          u32x2 w0, w1; w0.x = pk2(v0[0], v0[1]); w0.y = pk2(v0[2], v0[3]); w1.x = pk2(v1[0], v1[1]); w1.y = pk2(v1[2], v1[3]);
          *(u32x2*)(PROJ + (size_t)row * NP + KR_OFF + 4 * fq) = w0;
          *(u32x2*)(PROJ + (size_t)row * NP + KR_OFF + 16 + 4 * fq) = w1;
        } else {
          *(u32x4*)(PROJ + (size_t)row * NP + 32 * G + 8 * fq) = pack8(v0, v1);
          const float s = (v0[0] * v0[0] + v0[1] * v0[1]) + (v0[2] * v0[2] + v0[3] * v0[3]) + (v1[0] * v1[0] + v1[1] * v1[1]) + (v1[2] * v1[2] + v1[3] * v1[3]);
          if (bj == 0 ? cq0 : cq1) sq += s;
          if (bj == 0 ? ckv0 : ckv1) skv += s;
        }
      }
      if (cq0) { sq += __shfl_xor(sq, 16); sq += __shfl_xor(sq, 32); if (fq == 0) ssqp[(size_t)row * 16 + (pn - 6) * 4 + wc] = sq; }
      if (ckv0 || ckv1) { skv += __shfl_xor(skv, 16); skv += __shfl_xor(skv, 32); if (fq == 0) ssqp[(size_t)row * 16 + 8 + (pn - 7) * 4 + wc] = skv; }
    }
  }
};

struct EpiUq {
  bf16_t* QB; const float* ssqp; const f32x2* CS; bool dry;
  __device__ __forceinline__ void operator()(const f32x4 (&acc)[2][2][4][2], const g8::Unit& u, int wr, int wc, int fr, int fq) const {
    asm volatile("" : "+v"(fr), "+v"(fq));
    const int pm = u.a, pn = u.b;
    const bool rope0 = ((8 * pn + wc) % 3) == 2, rope1 = ((8 * pn + 4 + wc) % 3) == 2;
    f32x4 na, nb;
    { const f32x4* pp = (const f32x4*)(ssqp + (size_t)(pm * 256 + EPI_ROW(0)) * 16); na = pp[0]; nb = pp[1]; }
#pragma unroll
    for (int ri = 0; ri < 8; ++ri) {
      const int ai = ri >> 2, m = ri & 3;
      const int row = pm * 256 + EPI_ROW(ri);
      const f32x4 a = na, b = nb;
      EPI_FENCE();
      if (ri < 7) { const f32x4* pp = (const f32x4*)(ssqp + (size_t)(pm * 256 + EPI_ROW(ri + 1)) * 16); na = pp[0]; nb = pp[1]; }
      const float ss = ((a[0] + a[1]) + (a[2] + a[3])) + ((b[0] + b[1]) + (b[2] + b[3]));
      const float rs = rsqrtf(ss * (1.f / 384.f) + EPS) * QSCALE;
#pragma unroll
      for (int bj = 0; bj < 2; ++bj) {
        const int G = 8 * pn + 4 * bj + wc;
        f32x4 v0 = acc[ai][bj][m][0] * rs, v1 = acc[ai][bj][m][1] * rs;
        if (bj == 0 ? rope0 : rope1) {
          f32x2 cs[4];
#pragma unroll
          for (int j = 0; j < 4; ++j) cs[j] = CS[(size_t)row * 16 + 4 * fq + j];
          rope4(v0, v1, cs);
          u32x2 w0, w1; w0.x = pk2(v0[0], v0[1]); w0.y = pk2(v0[2], v0[3]); w1.x = pk2(v1[0], v1[1]); w1.y = pk2(v1[2], v1[3]);
          if (!dry || w0.x == 0x12345679u) { *(u32x2*)(QB + (size_t)row * 768 + 32 * G + 4 * fq) = w0;
          *(u32x2*)(QB + (size_t)row * 768 + 32 * G + 16 + 4 * fq) = w1; }
        } else {
          { const u32x4 w_ = pack8(v0, v1); if (!dry || w_.x == 0x12345679u) *(u32x4*)(QB + (size_t)row * 768 + 32 * G + 8 * fq) = w_; }
        }
      }
    }
  }
};

struct EpiUkv {
  bf16_t* KVB; const float* ssqp; bool dry;
  __device__ __forceinline__ void operator()(const f32x4 (&acc)[2][2][4][2], const g8::Unit& u, int wr, int wc, int fr, int fq) const {
    asm volatile("" : "+v"(fr), "+v"(fq));
    const int pm = u.a, pn = u.b;
    float rsv[8];
#pragma unroll
    for (int ri = 0; ri < 8; ++ri) { const f32x4* pp = (const f32x4*)(ssqp + (size_t)(pm * 256 + EPI_ROW(ri)) * 16 + 8); const f32x4 a = pp[0], b = pp[1]; rsv[ri] = ((a[0] + a[1]) + (a[2] + a[3])) + ((b[0] + b[1]) + (b[2] + b[3])); }
#pragma unroll
    for (int ri = 0; ri < 8; ++ri) {
      const int ai = ri >> 2, m = ri & 3;
      const int row = pm * 256 + EPI_ROW(ri);
      const float rs = rsqrtf(rsv[ri] * (1.f / 256.f) + EPS);
#pragma unroll
      for (int bj = 0; bj < 2; ++bj) {
        const int G = 8 * pn + 4 * bj + wc;
        { const u32x4 w_ = pack8(acc[ai][bj][m][0] * rs, acc[ai][bj][m][1] * rs); if (!dry || w_.x == 0x12345679u) *(u32x4*)(KVB + (size_t)row * 1024 + 32 * G + 8 * fq) = w_; }
      }
    }
  }
};

struct EpiWout {
  const float* x; bf16_t* HB; unsigned char* H8;
  __device__ __forceinline__ void operator()(const f32x4 (&acc)[2][2][4][2], const g8::Unit& u, int wr, int wc, int fr, int fq) const {
    asm volatile("" : "+v"(fr), "+v"(fq));
    const int pm = u.a, pn = u.b;
#pragma unroll
    for (int half = 0; half < 2; ++half) {
      EPI_FENCE();
      u32x4 xr[4][2];
#pragma unroll
      for (int q = 0; q < 4; ++q) { const int row = pm * 256 + EPI_ROW(half * 4 + q);
#pragma unroll
        for (int bj = 0; bj < 2; ++bj) xr[q][bj] = *(const u32x4*)(HB + (size_t)row * 1024 + 32 * (8 * pn + 4 * bj + wc) + 8 * fq); }
#pragma unroll
      for (int q = 0; q < 4; ++q) {
        const int ri = half * 4 + q, ai = ri >> 2, m = ri & 3;
        const int row = pm * 256 + EPI_ROW(ri);
#pragma unroll
        for (int bj = 0; bj < 2; ++bj) {
          const size_t off = (size_t)row * 1024 + 32 * (8 * pn + 4 * bj + wc) + 8 * fq;
          const u32x4 xw = xr[q][bj];
          const f32x4 x0 = {bflo(xw.x), bfhi(xw.x), bflo(xw.y), bfhi(xw.y)}, x1 = {bflo(xw.z), bfhi(xw.z), bflo(xw.w), bfhi(xw.w)};
          const f32x4 v0 = acc[ai][bj][m][0] + x0, v1 = acc[ai][bj][m][1] + x1;
          *(u32x4*)(HB + off) = pack8(v0, v1);
#if MOE_FP8
          *(u32x2*)(H8 + off) = pk8_fp8(v0, v1, F8_SH);
#endif
        }
      }
    }
  }
};

template <bool GATHER_>
struct MoeSched {
  static constexpr bool GATHER = GATHER_;
  static constexpr bool A_SC1 = !GATHER_;
  const char* A; const char* B; int lda, ldb; int ncol, total, G, c;
  const LAS int* tb; const LAS int* cn; const int* ltok; size_t bstride;
  int n1, r; const int* flg;
  __device__ __forceinline__ bool next(int i, g8::Unit& u) const {
    long L = (long)i * G + c;
    if (!GATHER_ && i >= n1) { if (c < r) return false; L = (long)n1 * G + (long)(i - n1) * (G - r) + (c - r); }
    if (L >= total) return false;
    const int rt = (int)(L / ncol), pn = (int)(L % ncol);
    if (!GATHER_) { unsigned sp_ = 0; while (__hip_atomic_load(flg + rt, __ATOMIC_RELAXED, __HIP_MEMORY_SCOPE_AGENT) < 16) { __builtin_amdgcn_s_sleep(2); if (++sp_ > (1u << 22)) break; } }
    int e = 0;
#pragma unroll 1
    for (int k = 1; k < NEXP; ++k) if (tb[k] <= rt) e = k;
    e = __builtin_amdgcn_readfirstlane(e);
    const int mt = rt - tb[e];
    u.a = e; u.b = mt; u.c = pn; u.d = rt;
    u.B = B + (size_t)e * bstride + (size_t)pn * 256 * ldb * 2;
    u.A = GATHER_ ? A : A + (size_t)rt * 256 * lda * 2;
    return true;
  }
  __device__ __forceinline__ void offs(const g8::Unit& u, const int (&R)[2], const int (&C)[2], unsigned (&o)[2][2]) const {
    if (GATHER_) {
      const int cnt = cn[u.a];
#pragma unroll
      for (int h = 0; h < 2; ++h)
#pragma unroll
        for (int i = 0; i < 2; ++i) { int pos = u.b * 256 + h * 128 + R[i]; pos = pos < cnt ? pos : cnt - 1; const int tok = ltok[u.a * ECAP + pos] >> 1;
          o[h][i] = (unsigned)(tok * lda + C[i]) * 2u; }
    } else {
#pragma unroll
      for (int h = 0; h < 2; ++h)
#pragma unroll
        for (int i = 0; i < 2; ++i) o[h][i] = (unsigned)(R[i] * lda + C[i]) * 2u;
    }
  }
};

struct EpiGU {
  bf16_t* HID; const float* rs2; const int* ltok; const LAS int* cn; bool dry; int* flg;
  __device__ __forceinline__ void operator()(const f32x4 (&acc)[2][2][4][2], const g8::Unit& u, int wr, int wc, int fr, int fq) const {
    asm volatile("" : "+v"(fr), "+v"(fq));
    const int e = u.a, mt = u.b, pn = u.c, rt = u.d; const int cnt = cn[e];
    const __amdgpu_buffer_rsrc_t rsrc = mk_rsrc(HID);
#pragma unroll
    for (int half = 0; half < 2; ++half) {
      EPI_FENCE();
      int tk[4]; float rsv[4];
#pragma unroll
      for (int q = 0; q < 4; ++q) { int pos = mt * 256 + EPI_ROW(half * 4 + q); pos = pos < cnt ? pos : cnt - 1; tk[q] = ltok[e * ECAP + pos] >> 1; }
#pragma unroll
      for (int q = 0; q < 4; ++q) rsv[q] = rs2[tk[q]];
#pragma unroll
      for (int q = 0; q < 4; ++q) {
        const int ri = half * 4 + q, ai = ri >> 2, m = ri & 3;
        const int r = EPI_ROW(ri), pos = mt * 256 + r;
        if (pos < cnt) {
          const float rs = rsv[q] * (MOE_FP8 ? 1.f / (F8_SH * F8_SWGU) : 1.f);
          f32x4 h0, h1;
#pragma unroll
          for (int j = 0; j < 4; ++j) {
            const float g0 = acc[ai][0][m][0][j] * rs, u0 = acc[ai][1][m][0][j] * rs, g1 = acc[ai][0][m][1][j] * rs, u1 = acc[ai][1][m][1][j] * rs;
            h0[j] = g0 / (1.f + __expf(-g0)) * u0; h1[j] = g1 / (1.f + __expf(-g1)) * u1;
          }
#if MOE_FP8
          __builtin_amdgcn_raw_buffer_store_b64(pk8_fp8(h0, h1, F8_SHID), rsrc, (int)((unsigned)((rt * 256 + r) * 256 + pn * 128 + wc * 32 + 8 * fq)), 0, 16);
#else
          { const u32x4 w_ = pack8(h0, h1); if (!dry || w_.x == 0x12345679u) __builtin_amdgcn_raw_buffer_store_b128(w_, rsrc, (int)((unsigned)(((rt * 256 + r) * 256 + pn * 128 + wc * 32 + 8 * fq) * 2)), 0, 16); }
#endif
        }
      }
    }
    asm volatile("s_waitcnt vmcnt(0)" ::: "memory");
    if (fr == 0 && fq == 0) __hip_atomic_fetch_add(flg + rt, 1, __ATOMIC_RELAXED, __HIP_MEMORY_SCOPE_AGENT);
  }
};

struct EpiDown {
  bf16_t* Y2; const int* ltok; const float* lgate; const LAS int* cn; bool dry;
  __device__ __forceinline__ void operator()(const f32x4 (&acc)[2][2][4][2], const g8::Unit& u, int wr, int wc, int fr, int fq) const {
    asm volatile("" : "+v"(fr), "+v"(fq));
    const int e = u.a, mt = u.b, pn = u.c; const int cnt = cn[e];
    int ds[8]; float gv[8];
#pragma unroll
    for (int ri = 0; ri < 8; ++ri) { int pos = mt * 256 + EPI_ROW(ri); pos = pos < cnt ? pos : cnt - 1; ds[ri] = ltok[e * ECAP + pos]; gv[ri] = lgate[e * ECAP + pos]; }
#pragma unroll
    for (int ri = 0; ri < 8; ++ri) {
      const int ai = ri >> 2, m = ri & 3;
      const int pos = mt * 256 + EPI_ROW(ri);
      if (pos < cnt) {
        const float g = gv[ri] * (MOE_FP8 ? 1.f / (F8_SHID * F8_SWD) : 1.f);
#pragma unroll
        for (int bj = 0; bj < 2; ++bj)
          { const u32x4 w_ = pack8(acc[ai][bj][m][0] * g, acc[ai][bj][m][1] * g); if (!dry || w_.x == 0x12345679u) *(u32x4*)(Y2 + (size_t)ds[ri] * 1024 + pn * 256 + wc * 64 + bj * 32 + 8 * fq) = w_; }
      }
    }
  }
};

__device__ __forceinline__ int inproj_src_col(int L) {
  if (L < 1024) return L;
  if (L < 1536) return 1040 + (L - 1024);
  if (L < 1920) return 1552 + (L - 1536);
  if (L < 2176) return 1936 + (L - 1920);
  if (L < 2208) return 2192 + (L - 2176);
  if (L < 2224) return 1024 + (L - 2208);
  return -1;
}
__device__ __forceinline__ void tr_item(const float* src, int ld, int cbase, int nvalid, bool permute, const float* kscale, int k0, bf16_t* dst, int K, LAS float* scr, int lane) {
  if (nvalid > 0) {
    f32x4 v[8];
#pragma unroll
    for (int i = 0; i < 8; ++i) v[i] = *(const f32x4*)(src + (size_t)(k0 + i * 8 + (lane >> 3)) * ld + cbase + (lane & 7) * 4);
#pragma unroll
    for (int i = 0; i < 8; ++i) { const int kk = i * 8 + (lane >> 3); const float sc = kscale ? kscale[k0 + kk] : 1.f; LAS float* w = scr + kk * 33 + (lane & 7) * 4;
      w[0] = v[i].x * sc; w[1] = v[i].y * sc; w[2] = v[i].z * sc; w[3] = v[i].w * sc; }
  }
  LDS_WAIT();
  const int c = lane & 7;
#pragma unroll
  for (int j = 0; j < 4; ++j) { const int n = (lane >> 3) + 8 * j; const int sc_ = permute ? perm32(n) : n; const LAS float* s = scr + (8 * c) * 33 + sc_;
    u32x4 o = {0u, 0u, 0u, 0u};
    if (sc_ < nvalid) { o.x = pk2(s[0 * 33], s[1 * 33]); o.y = pk2(s[2 * 33], s[3 * 33]); o.z = pk2(s[4 * 33], s[5 * 33]); o.w = pk2(s[6 * 33], s[7 * 33]); }
    *(u32x4*)(dst + (size_t)n * K + 8 * c) = o; }
  LDS_WAIT();
}
__device__ __forceinline__ void tr_item8(const float* src, int ld, int cbase, const float* kscale, float gscale, int k0, unsigned char* dst, int K8, LAS float* scr, int lane) {
  f32x4 v[8];
#pragma unroll
  for (int i = 0; i < 8; ++i) v[i] = *(const f32x4*)(src + (size_t)(k0 + i * 8 + (lane >> 3)) * ld + cbase + (lane & 7) * 4);
#pragma unroll
  for (int i = 0; i < 8; ++i) { const int kk = i * 8 + (lane >> 3); const float sc = kscale ? kscale[k0 + kk] : 1.f; LAS float* w = scr + kk * 33 + (lane & 7) * 4;
    w[0] = v[i].x * sc; w[1] = v[i].y * sc; w[2] = v[i].z * sc; w[3] = v[i].w * sc; }
  LDS_WAIT();
  const int c = lane & 7;
#pragma unroll
  for (int j = 0; j < 4; ++j) { const int n = (lane >> 3) + 8 * j; const LAS float* s = scr + (8 * c) * 33 + perm32(n);
    const f32x4 a = {s[0 * 33], s[1 * 33], s[2 * 33], s[3 * 33]}, b = {s[4 * 33], s[5 * 33], s[6 * 33], s[7 * 33]};
    *(u32x2*)(dst + (size_t)n * K8 + 8 * c) = pk8_fp8(a, b, gscale); }
  LDS_WAIT();
}
__device__ __forceinline__ void tr_item_s(const float* src, int ld, int col, const float* kscale, int k0, bf16_t* dst, int K, LAS float* scr, int lane) {
#pragma unroll 8
  for (int i = 0; i < 32; ++i) { const int kk = 2 * i + (lane >> 5); float v = 0.f;
    if (col >= 0) { v = src[(size_t)(k0 + kk) * ld + col]; if (kscale) v *= kscale[k0 + kk]; }
    scr[kk * 33 + (lane & 31)] = v; }
  LDS_WAIT();
  const int c = lane & 7;
#pragma unroll
  for (int j = 0; j < 4; ++j) { const int n = (lane >> 3) + 8 * j; const LAS float* s = scr + (8 * c) * 33 + n;
    u32x4 o; o.x = pk2(s[0 * 33], s[1 * 33]); o.y = pk2(s[2 * 33], s[3 * 33]); o.z = pk2(s[4 * 33], s[5 * 33]); o.w = pk2(s[6 * 33], s[7 * 33]);
    *(u32x4*)(dst + (size_t)n * K + 8 * c) = o; }
  LDS_WAIT();
}

__device__ __forceinline__ void conv_gu_item(const Params& p, int r, LAS float* scr, int lane) {
  const int e = r / 256, kb = (r % 256) / 16, nb = r % 16;
  const int pn = nb >> 3, bj = (nb >> 2) & 1;
  const float* src = (bj ? p.in[18] : p.in[17]) + (size_t)e * 1024 * 256;
#if MOE_FP8
  tr_item8(src, 256, 128 * pn + 32 * (nb & 3), p.in[12], F8_SWGU, kb * 64, p.ws + WS_WGU + ((size_t)e * 512 + nb * 32) * 1024 + kb * 64, 1024, scr, lane);
#else
  tr_item(src, 256, 128 * pn + 32 * (nb & 3), 32, true, p.in[12], kb * 64, (bf16_t*)(p.ws + WS_WGU) + ((size_t)e * 512 + nb * 32) * 1024 + kb * 64, 1024, scr, lane);
#endif
}
__device__ __forceinline__ int glog8(int nb) { return (nb & ~7) + 2 * (nb & 3) + ((nb >> 2) & 1); }
__device__ __forceinline__ void conv_d_item(const Params& p, int r, LAS float* scr, int lane) {
  const int e = r / 128, kb = (r % 128) / 32, nb = r % 32;
#if MOE_FP8
  tr_item8(p.in[19] + (size_t)e * 256 * 1024, 1024, 32 * glog8(nb), nullptr, F8_SWD, kb * 64, p.ws + WS_WD + ((size_t)e * 1024 + nb * 32) * 256 + kb * 64, 256, scr, lane);
#else
  tr_item(p.in[19] + (size_t)e * 256 * 1024, 1024, 32 * glog8(nb), 32, true, nullptr, kb * 64, (bf16_t*)(p.ws + WS_WD) + ((size_t)e * 1024 + nb * 32) * 256 + kb * 64, 256, scr, lane);
#endif
}
constexpr int CONV_GU_P0 = 2048, CONV_GU_P1 = 4096, CONV_GU_P2 = 2048;
constexpr int CONV_D_P1 = 4096;

__device__ __forceinline__ void p0_prologue(const Params& p, LAS unsigned char* lds, int G, int vb) {
  const int tid = threadIdx.x, lane = tid & 63, wave = tid >> 6;
  LAS float* scr = (LAS float*)(lds + wave * 8704);
  const int gw = vb * 8 + wave, NGW = G * 8;
  unsigned char* ws = p.ws;
  const float* attn_nw = p.in[2]; const float* w_in = p.in[3];
  const float* qnw = p.in[7]; const float* w_uq = p.in[8]; const float* kvnw = p.in[9]; const float* w_ukv = p.in[10];
  const float* w_out = p.in[11]; const float* fnw = p.in[12]; const float* rgw = p.in[13]; const float* rew = p.in[15];
  const float* ewg = p.in[17]; const float* ewu = p.in[18]; const float* ewd = p.in[19];
  constexpr int I_IN = 16 * 72, I_UQ = 6 * 24, I_UKV = 4 * 32, I_OUT = 16 * 32, I_R = 16 * 2, I_GU = 32 * 16 * 16, I_D = 32 * 4 * 32;
  const int n = lane & 31;
  const int NITEMS = I_IN + I_UQ + I_UKV + I_OUT + I_R + ((G == 256) ? CONV_GU_P0 : I_GU + I_D);
  auto xconv = [&]() {
    const float* x = p.in[0]; bf16_t* XB = (bf16_t*)(ws + WS_XB); float* rs1 = (float*)(ws + WS_RS1);
    f32x4 v[4], w[4];
    { const int m = gw, m2 = m + NGW;
      const f32x4* xr = (const f32x4*)(x + (size_t)(m < NTOK ? m : 0) * DM) + lane; const f32x4* xr2 = (const f32x4*)(x + (size_t)(m2 < NTOK ? m2 : 0) * DM) + lane;
#pragma unroll
      for (int j = 0; j < 4; ++j) { v[j] = xr[64 * j]; w[j] = xr2[64 * j]; } }
#pragma unroll 1
    for (int m = gw; m < NTOK; m += 2 * NGW) {
      const int m2 = m + NGW; const bool has2 = m2 < NTOK;
      const int mn = m + 2 * NGW, mn2 = mn + NGW;
      f32x4 nv[4], nw[4];
      { const f32x4* xr = (const f32x4*)(x + (size_t)(mn < NTOK ? mn : m) * DM) + lane; const f32x4* xr2 = (const f32x4*)(x + (size_t)(mn2 < NTOK ? mn2 : m) * DM) + lane;
#pragma unroll
        for (int j = 0; j < 4; ++j) { nv[j] = xr[64 * j]; nw[j] = xr2[64 * j]; } }
      float s = 0.f, s2 = 0.f;
#pragma unroll
      for (int j = 0; j < 4; ++j) { s += (v[j].x * v[j].x + v[j].y * v[j].y) + (v[j].z * v[j].z + v[j].w * v[j].w); s2 += (w[j].x * w[j].x + w[j].y * w[j].y) + (w[j].z * w[j].z + w[j].w * w[j].w); }
      s = wave_sum(s); s2 = wave_sum(s2);
      if (lane == 0) { rs1[m] = rsqrtf(s * (1.f / DM) + EPS); if (has2) rs1[m2] = rsqrtf(s2 * (1.f / DM) + EPS); }
      u32x2* o8 = (u32x2*)(XB + (size_t)m * DM) + lane; u32x2* o82 = (u32x2*)(XB + (size_t)m2 * DM) + lane;
#pragma unroll
      for (int j = 0; j < 4; ++j) { u32x2 q; q.x = pk2(v[j].x, v[j].y); q.y = pk2(v[j].z, v[j].w); o8[64 * j] = q; }
      if (has2) {
#pragma unroll
        for (int j = 0; j < 4; ++j) { u32x2 q; q.x = pk2(w[j].x, w[j].y); q.y = pk2(w[j].z, w[j].w); o82[64 * j] = q; }
      }
#pragma unroll
      for (int j = 0; j < 4; ++j) { v[j] = nv[j]; w[j] = nw[j]; }
    }
  };
  auto wconv = [&]() {
  for (int it = gw; it < NITEMS; it += NGW) {
    int r = it;
    if (r < I_IN) { const int kb = r / 72, nb = r % 72; const int c0 = inproj_src_col(32 * nb); const int nv = (nb < 69) ? 32 : (nb == 69 ? 16 : 0);
      tr_item(w_in, 2224, c0 < 0 ? 0 : c0, nv, nb != 68, attn_nw, kb * 64, (bf16_t*)(ws + WS_WIN) + (size_t)(nb * 32) * 1024 + kb * 64, 1024, scr, lane); continue; }
    r -= I_IN;
    if (r < I_UQ) { const int kb = r / 24, nb = r % 24;
      tr_item(w_uq, 768, 32 * nb, 32, (nb % 3) != 2, qnw, kb * 64, (bf16_t*)(ws + WS_WUQ) + (size_t)(nb * 32) * 384 + kb * 64, 384, scr, lane); continue; }
    r -= I_UQ;
    if (r < I_UKV) { const int kb = r / 32, nb = r % 32;
      tr_item(w_ukv, 1024, 32 * nb, 32, true, kvnw, kb * 64, (bf16_t*)(ws + WS_WUKV) + (size_t)(nb * 32) * 256 + kb * 64, 256, scr, lane); continue; }
    r -= I_UKV;
    if (r < I_OUT) { const int kb = r / 32, nb = r % 32;
      tr_item(w_out, 1024, 32 * nb, 32, true, nullptr, kb * 64, (bf16_t*)(ws + WS_WOUT) + (size_t)(nb * 32) * 1024 + kb * 64, 1024, scr, lane); continue; }
    r -= I_OUT;
    if (r < I_R) { const int kb = r / 2, nb = r % 2; const int Rr = nb * 32 + n;
      const float* src = (Rr < 4) ? rgw : rew; const int ld = (Rr < 4) ? 4 : 32; const int col = (Rr < 4) ? Rr : (Rr < 36 ? Rr - 4 : -1);
      tr_item_s(src, ld, col, fnw, kb * 64, (bf16_t*)(ws + WS_WR) + (size_t)(nb * 32) * 1024 + kb * 64, 1024, scr, lane); continue; }
    r -= I_R;
    if (r < I_GU) { conv_gu_item(p, r, scr, lane); continue; }
    r -= I_GU;
    conv_d_item(p, r, scr, lane);
  }
  };
  if (wave & 1) { xconv(); wconv(); } else { wconv(); xconv(); }
  const int gt = vb * 512 + tid, NGT = G * 512;
  const int* pos = (const int*)p.in[1]; f32x2* CS = (f32x2*)(ws + WS_CS);
  for (int i = gt; i < NTOK * 16; i += NGT) {
    const int row = i >> 4, f = i & 15;
    const float inv = powf(10000.0f, -(float)f / 16.0f);
    const float ang = (float)pos[row] * inv;
    CS[i] = (f32x2){(float)cos((double)ang), (float)sin((double)ang)};
  }
  if (gt < NEXP) ((int*)(ws + WS_CNT))[gt] = 0;
  if (gt < 512) ((int*)(ws + WS_FLG))[gt] = 0;
  if (gt < 4096) { const int dd = gt >> 4, rr = gt & 15; ((bf16_t*)(ws + WS_GUT))[gt] = (bf16_t)(pk2(p.in[4][rr * 256 + dd], 0.f) & 0xffffu); }
#if !ENABLE_GLA || !ENABLE_MLA
  { u32x4* Y = (u32x4*)(ws + WS_Y); for (int i = gt; i < NTOK * 1024 / 8; i += NGT) Y[i] = (u32x4){0u, 0u, 0u, 0u}; }
#endif
}

constexpr int AT_KSTR = 208;
constexpr int AT_KBUF = 64 * AT_KSTR, AT_VBUF = 8192;
constexpr int AT_KOFF = 0, AT_VOFF = 2 * AT_KBUF;
typedef short v4i16_t __attribute__((ext_vector_type(4)));
__device__ __forceinline__ s16x4 vtr(const LAS unsigned char* p) { return __builtin_bit_cast(s16x4, __builtin_amdgcn_ds_read_tr16_b64_v4i16((LAS v4i16_t*)p)); }

template <bool DO_NEXT>
__device__ __forceinline__ void attn_step(const LAS unsigned char* Kn, const LAS unsigned char* Vc, const bf16x8 (&qf)[6], f32x16& pc0, f32x16& pc1, f32x16& pn0, f32x16& pn1,
                                          f32x16& o0, f32x16& o1, float& mrun, float& lrun, const bool first, const bool diag, const int kb, const int qabs, const int r32, const int hi, const int voffl) {
  const LAS unsigned char* Kb = Kn + r32 * AT_KSTR + hi * 16;
  bf16x8 kf[6];
#pragma unroll
  for (int d0 = 0; d0 < 3; ++d0) { kf[2 * d0] = *(const LAS bf16x8*)(Kb + d0 * 32); kf[2 * d0 + 1] = *(const LAS bf16x8*)(Kb + 32 * AT_KSTR + d0 * 32); }
  __builtin_amdgcn_sched_barrier(0);
  if (diag) {
#pragma unroll
    for (int r = 0; r < 16; ++r) { const int kv = kb + 4 * hi + (r & 3) + 8 * (r >> 2); if (kv > qabs) pc0[r] = -INFINITY; if (kv + 32 > qabs) pc1[r] = -INFINITY; }
  }
  float ma = fmaxf(fmaxf(pc0[0], pc0[1]), pc1[0]), mb = fmaxf(fmaxf(pc0[2], pc0[3]), pc1[1]);
  ma = fmaxf(fmaxf(ma, pc1[2]), pc1[3]);
#pragma unroll
  for (int r = 4; r < 16; r += 4) { ma = fmaxf(fmaxf(ma, pc0[r]), pc0[r + 1]); mb = fmaxf(fmaxf(mb, pc0[r + 2]), pc0[r + 3]); ma = fmaxf(fmaxf(ma, pc1[r]), pc1[r + 1]); mb = fmaxf(fmaxf(mb, pc1[r + 2]), pc1[r + 3]); }
  float mt = fmaxf(ma, mb);
  { auto rr = __builtin_amdgcn_permlane32_swap(__float_as_uint(mt), __float_as_uint(mt), false, false); mt = fmaxf(__uint_as_float(rr[0]), __uint_as_float(rr[1])); }
  if (first || __any(mt > 8.0f)) {
    const float dl = first ? mt : fmaxf(mt, 0.f);
    mrun += dl;
    const float alpha = __builtin_amdgcn_exp2f(-dl);
    lrun *= alpha;
#pragma unroll
    for (int r = 0; r < 16; ++r) { pc0[r] -= dl; pc1[r] -= dl; o0[r] *= alpha; o1[r] *= alpha; }
  }
  const LAS unsigned char* Vb = Vc + voffl;
  f32x16 negm;
#pragma unroll
  for (int r = 0; r < 16; ++r) negm[r] = -mrun;
  if (DO_NEXT) {
#pragma unroll
    for (int d0 = 0; d0 < 3; ++d0) {
      pn0 = __builtin_amdgcn_mfma_f32_32x32x16_bf16(kf[2 * d0], qf[d0], d0 ? pn0 : negm, 0, 0, 0);
      pn1 = __builtin_amdgcn_mfma_f32_32x32x16_bf16(kf[2 * d0 + 1], qf[d0], d0 ? pn1 : negm, 0, 0, 0);
    }
  }
  __builtin_amdgcn_sched_barrier(0);
#pragma unroll
  for (int d0 = 3; d0 < 6; ++d0) { kf[2 * (d0 - 3)] = *(const LAS bf16x8*)(Kb + d0 * 32); kf[2 * (d0 - 3) + 1] = *(const LAS bf16x8*)(Kb + 32 * AT_KSTR + d0 * 32); }
  s16x4 vl[4], vh[4];
#pragma unroll
  for (int ks = 0; ks < 2; ++ks) { vl[2 * ks] = vtr(Vb + ks * 1024); vh[2 * ks] = vtr(Vb + ks * 1024 + 512); vl[2 * ks + 1] = vtr(Vb + 4096 + ks * 1024); vh[2 * ks + 1] = vtr(Vb + 4096 + ks * 1024 + 512); }
  __builtin_amdgcn_sched_barrier(0);
#pragma unroll
  for (int r = 0; r < 16; ++r) { pc0[r] = __builtin_amdgcn_exp2f(pc0[r]); pc1[r] = __builtin_amdgcn_exp2f(pc1[r]); }
  if (DO_NEXT) {
#pragma unroll
    for (int d0 = 3; d0 < 6; ++d0) {
      pn0 = __builtin_amdgcn_mfma_f32_32x32x16_bf16(kf[2 * (d0 - 3)], qf[d0], pn0, 0, 0, 0);
      pn1 = __builtin_amdgcn_mfma_f32_32x32x16_bf16(kf[2 * (d0 - 3) + 1], qf[d0], pn1, 0, 0, 0);
    }
  }
  float sacc = pc0[0] + pc1[0];
#pragma unroll
  for (int r = 1; r < 16; ++r) { sacc += pc0[r]; sacc += pc1[r]; if ((r & 1) == 1) asm volatile("" : "+v"(sacc)); }
  lrun += sacc;
  u32x4 pw[4];
#pragma unroll
  for (int s = 0; s < 2; ++s) {
    pw[s] = (u32x4){pk2(pc0[8 * s + 0], pc0[8 * s + 1]), pk2(pc0[8 * s + 2], pc0[8 * s + 3]), pk2(pc0[8 * s + 4], pc0[8 * s + 5]), pk2(pc0[8 * s + 6], pc0[8 * s + 7])};
    pw[2 + s] = (u32x4){pk2(pc1[8 * s + 0], pc1[8 * s + 1]), pk2(pc1[8 * s + 2], pc1[8 * s + 3]), pk2(pc1[8 * s + 4], pc1[8 * s + 5]), pk2(pc1[8 * s + 6], pc1[8 * s + 7])};
  }
  s16x4 wl[4], wh[4];
#pragma unroll
  for (int ks = 2; ks < 4; ++ks) { wl[2 * (ks - 2)] = vtr(Vb + ks * 1024); wh[2 * (ks - 2)] = vtr(Vb + ks * 1024 + 512); wl[2 * (ks - 2) + 1] = vtr(Vb + 4096 + ks * 1024); wh[2 * (ks - 2) + 1] = vtr(Vb + 4096 + ks * 1024 + 512); }
  __builtin_amdgcn_sched_barrier(0);
#pragma unroll
  for (int ks = 0; ks < 2; ++ks) {
    const bf16x8 vf0 = {vl[2 * ks][0], vl[2 * ks][1], vl[2 * ks][2], vl[2 * ks][3], vh[2 * ks][0], vh[2 * ks][1], vh[2 * ks][2], vh[2 * ks][3]};
    const bf16x8 vf1 = {vl[2 * ks + 1][0], vl[2 * ks + 1][1], vl[2 * ks + 1][2], vl[2 * ks + 1][3], vh[2 * ks + 1][0], vh[2 * ks + 1][1], vh[2 * ks + 1][2], vh[2 * ks + 1][3]};
    const bf16x8 pf = __builtin_bit_cast(bf16x8, pw[ks]);
    o0 = __builtin_amdgcn_mfma_f32_32x32x16_bf16(vf0, pf, o0, 0, 0, 0);
    o1 = __builtin_amdgcn_mfma_f32_32x32x16_bf16(vf1, pf, o1, 0, 0, 0);
  }
#pragma unroll
  for (int ks = 2; ks < 4; ++ks) { const int q = 2 * (ks - 2);
    const bf16x8 vf0 = {wl[q][0], wl[q][1], wl[q][2], wl[q][3], wh[q][0], wh[q][1], wh[q][2], wh[q][3]};
    const bf16x8 vf1 = {wl[q + 1][0], wl[q + 1][1], wl[q + 1][2], wl[q + 1][3], wh[q + 1][0], wh[q + 1][1], wh[q + 1][2], wh[q + 1][3]};
    const bf16x8 pf = __builtin_bit_cast(bf16x8, pw[ks]);
    o0 = __builtin_amdgcn_mfma_f32_32x32x16_bf16(vf0, pf, o0, 0, 0, 0);
    o1 = __builtin_amdgcn_mfma_f32_32x32x16_bf16(vf1, pf, o1, 0, 0, 0);
  }
}
__device__ __forceinline__ void attn_qk0(const LAS unsigned char* Kt, const bf16x8 (&qf)[6], f32x16& p0, f32x16& p1, const int r32, const int hi) {
  const LAS unsigned char* Kb = Kt + r32 * AT_KSTR + hi * 16;
  const f32x16 z = {};
#pragma unroll
  for (int d0 = 0; d0 < 6; ++d0) {
    const bf16x8 a0 = *(const LAS bf16x8*)(Kb + d0 * 32), a1 = *(const LAS bf16x8*)(Kb + 32 * AT_KSTR + d0 * 32);
    p0 = __builtin_amdgcn_mfma_f32_32x32x16_bf16(a0, qf[d0], d0 ? p0 : z, 0, 0, 0);
    p1 = __builtin_amdgcn_mfma_f32_32x32x16_bf16(a1, qf[d0], d0 ? p1 : z, 0, 0, 0);
  }
}

template <int MODE>
__device__ __forceinline__ void attn_unit(const Params& p, LAS unsigned char* lds, int b, int h, int qb) {
  int tid_ = threadIdx.x; asm volatile("" : "+v"(tid_));
  const int tid = tid_, lane = tid & 63, r32 = lane & 31, hi = lane >> 5; const int wid = __builtin_amdgcn_readfirstlane(tid >> 6);
  const bf16_t* QB = (const bf16_t*)(p.ws + WS_QB); const bf16_t* KVB = (const bf16_t*)(p.ws + WS_KVB); const bf16_t* PROJ = (const bf16_t*)(p.ws + WS_PROJ);
  bf16_t* Y = (bf16_t*)(p.ws + WS_Y);
  const size_t rowbase = (size_t)b * SEQ; const int q0 = qb * 256;
  bf16x8 qf[6];
  { const bf16_t* qrow = QB + (rowbase + q0 + wid * 32 + r32) * 768 + h * 96 + hi * 8;
#pragma unroll
    for (int d0 = 0; d0 < 6; ++d0) qf[d0] = *(const bf16x8*)(qrow + d0 * 16); }
  f32x16 o0 = {}, o1 = {}; float mrun = 0.f, lrun = 0.f;
  const int NT = 4 * (qb + 1);
  const int id0 = tid, id1 = (tid < 256) ? tid + 512 : tid;
  const int kv0 = id0 / 12, c0 = id0 % 12, kv1 = id1 / 12, c1 = id1 % 12;
  const bf16_t* ks0 = (c0 < 8) ? KVB + (rowbase + kv0) * 1024 + h * 128 + c0 * 8 : PROJ + (rowbase + kv0) * NP + KR_OFF + (c0 - 8) * 8;
  const size_t kstr0 = (c0 < 8) ? (size_t)64 * 1024 : (size_t)64 * NP;
  const bf16_t* ks1 = (c1 < 8) ? KVB + (rowbase + kv1) * 1024 + h * 128 + c1 * 8 : PROJ + (rowbase + kv1) * NP + KR_OFF + (c1 - 8) * 8;
  const size_t kstr1 = (c1 < 8) ? (size_t)64 * 1024 : (size_t)64 * NP;
  const int kd0 = kv0 * AT_KSTR + c0 * 16, kd1 = kv1 * AT_KSTR + c1 * 16;
  const int vkv = tid >> 3, vc = tid & 7;
  const bf16_t* vs = KVB + (rowbase + vkv) * 1024 + h * 128 + 64 + vc * 8;
  const int vd = (vc >> 2) * 4096 + vkv * 64 + (vc & 3) * 16;
  u32x4 kA0 = {}, kA1 = {}, vA = {}, kB0 = {}, kB1 = {}, vB = {};
#define AT_LOADK(K0, K1, u) do { if (MODE == 2) break; const int u_ = (MODE == 1) ? 0 : ((u) < NT ? (u) : NT - 1); K0 = *(const u32x4*)(ks0 + (size_t)u_ * kstr0); K1 = *(const u32x4*)(ks1 + (size_t)u_ * kstr1); } while (0)
#define AT_LOADV(V, u) do { if (MODE == 2) break; const int u_ = (MODE == 1) ? 0 : ((u) < NT ? (u) : NT - 1); V = *(const u32x4*)(vs + (size_t)u_ * 64 * 1024); } while (0)
#define AT_STOREK(K0, K1, buf) do { *(LAS u32x4*)(lds + AT_KOFF + (buf) * AT_KBUF + kd0) = K0; *(LAS u32x4*)(lds + AT_KOFF + (buf) * AT_KBUF + kd1) = K1; } while (0)
#define AT_STOREV(V, buf) do { *(LAS u32x4*)(lds + AT_VOFF + (buf) * AT_VBUF + vd) = V; } while (0)
  AT_LOADK(kA0, kA1, 0); AT_LOADV(vA, 0); AT_LOADK(kB0, kB1, 1);
  AT_STOREK(kA0, kA1, 0); AT_STOREV(vA, 0); AT_STOREK(kB0, kB1, 1);
  AT_LOADK(kA0, kA1, 2); AT_LOADV(vB, 1); AT_LOADK(kB0, kB1, 3); AT_LOADV(vA, 2);
  LBAR();
  const int qabs = q0 + wid * 32 + r32;
  const int voffl = ((lane >> 4) & 1) * 32 + (lane & 3) * 8 + (4 * hi + ((lane & 15) >> 2)) * 64;
  const int wlast = q0 + wid * 32 + 31;
  f32x16 pa0, pa1, pb0, pb1;
  if (wid >= 4) __builtin_amdgcn_s_setprio(1);
  attn_qk0(lds + AT_KOFF, qf, pa0, pa1, r32, hi);
  LBAR();
#pragma unroll 1
  for (int t = 0; t < NT; t += 2) {
    if (MODE != 3 && t * 64 <= wlast) {
      attn_step<true>(lds + AT_KOFF + AT_KBUF, lds + AT_VOFF, qf, pa0, pa1, pb0, pb1, o0, o1, mrun, lrun, t == 0, t >= NT - 4, t * 64, qabs, r32, hi, voffl);
    }
    AT_STOREK(kA0, kA1, 0); AT_STOREV(vB, 1);
    AT_LOADK(kA0, kA1, t + 4); AT_LOADV(vB, t + 3);
    LBAR();
    if (MODE != 3 && (t + 1) * 64 <= wlast) {
      attn_step<true>(lds + AT_KOFF, lds + AT_VOFF + AT_VBUF, qf, pb0, pb1, pa0, pa1, o0, o1, mrun, lrun, false, t + 1 >= NT - 4, (t + 1) * 64, qabs, r32, hi, voffl);
    }
    AT_STOREK(kB0, kB1, 1); AT_STOREV(vA, 0);
    AT_LOADK(kB0, kB1, t + 5); AT_LOADV(vA, t + 4);
    LBAR();
  }
#undef AT_LOADK
#undef AT_LOADV
#undef AT_STOREK
#undef AT_STOREV
  __builtin_amdgcn_s_setprio(0);
  lrun += __shfl_xor(lrun, 32);
  const float inv = 1.f / lrun;
  bf16_t* dst = Y + (rowbase + q0 + wid * 32 + r32) * 1024 + 512 + h * 64 + 4 * hi;
#pragma unroll
  for (int g = 0; g < 4; ++g) {
    u32x2 w0, w1; w0.x = pk2(o0[4 * g] * inv, o0[4 * g + 1] * inv); w0.y = pk2(o0[4 * g + 2] * inv, o0[4 * g + 3] * inv);
    w1.x = pk2(o1[4 * g] * inv, o1[4 * g + 1] * inv); w1.y = pk2(o1[4 * g + 2] * inv, o1[4 * g + 3] * inv);
    if (MODE == 0 || w0.x == 0x12345679u) { *(u32x2*)(dst + 8 * g) = w0; *(u32x2*)(dst + 32 + 8 * g) = w1; }
  }
}

template <int MODE>
__device__ __forceinline__ void attn_phase(const Params& p, LAS unsigned char* lds, int G, int vb) {
  if (G == 256) {
    const int bh = vb >> 2, s = vb & 3;
#pragma unroll 1
    for (int i = 0; i < 4; ++i) { const int qb = (i == 0) ? 15 - s : (i == 1) ? 8 + s : (i == 2) ? 7 - s : s; attn_unit<MODE>(p, lds, bh >> 3, bh & 7, qb); }
  } else {
#pragma unroll 1
    for (int u = vb; u < 1024; u += G) { const int qb = 15 - (u >> 6), bh = u & 63; attn_unit<MODE>(p, lds, bh >> 3, bh & 7, qb); }
  }
}

constexpr int GL_BC = 0;
constexpr int GL_QE = 17408;
constexpr int GL_KE = 26624;
constexpr int GL_KD = 35840;
constexpr int GL_V = 44032;
constexpr int GL_ST = 60416;
constexpr int GL_RED = 78848;
constexpr int GL_TOT = 80896;
__device__ __forceinline__ int crow(int r, int hi) { return (r & 3) + 8 * (r >> 2) + 4 * hi; }

__device__ __forceinline__ void gla_gates_mfma(const bf16x8 lrA, const bf16x8 guB, const float bias_d, LAS float* bc, LAS float* tot0, int dt, int jt, int r32, int hi) {
  const f32x16 zero = {};
  const f32x16 z = __builtin_amdgcn_mfma_f32_32x32x16_bf16(lrA, guB, zero, 0, 0, 0);
  float la[16];
#pragma unroll
  for (int r = 0; r < 16; ++r) { const float zz = z[r] + bias_d; la[r] = (fminf(zz, 0.f) - __logf(1.f + __expf(-fabsf(zz)))) * (1.f / 16.f); }
  float s[4], o[4];
#pragma unroll
  for (int g = 0; g < 4; ++g) { la[4 * g + 1] += la[4 * g]; la[4 * g + 2] += la[4 * g + 1]; la[4 * g + 3] += la[4 * g + 2]; s[g] = la[4 * g + 3]; }
#pragma unroll
  for (int g = 0; g < 4; ++g) { auto rr = __builtin_amdgcn_permlane32_swap(__float_as_uint(s[g]), __float_as_uint(s[g]), false, false); o[g] = __uint_as_float(hi ? rr[0] : rr[1]); }
  float off = 0.f;
#pragma unroll
  for (int g = 0; g < 4; ++g) { const float add = off + (hi ? o[g] : 0.f);
#pragma unroll
    for (int q = 0; q < 4; ++q) la[4 * g + q] += add;
    off += s[g] + o[g]; }
#pragma unroll
  for (int r = 0; r < 16; ++r) bc[(32 * jt + crow(r, hi)) * 68 + 32 * dt + r32] = la[r];
  if (jt == 0 && hi == 0) tot0[32 * dt + r32] = off;
}

__device__ __forceinline__ bf16x8 trfrag(const LAS unsigned char* p, int off_lo, int off_hi) {
  const s16x4 l = vtr(p + off_lo), h = vtr(p + off_hi);
  return (bf16x8){l[0], l[1], l[2], l[3], h[0], h[1], h[2], h[3]};
}

__device__ __forceinline__ void gla_a_phase(const Params& p, LAS unsigned char* lds, int G, int vb) {
  const int tid = threadIdx.x, lane = tid & 63, r32 = lane & 31, hi = lane >> 5; const int wid = __builtin_amdgcn_readfirstlane(tid >> 6);
  const bf16_t* PROJ = (const bf16_t*)(p.ws + WS_PROJ); const bf16_t* GUT = (const bf16_t*)(p.ws + WS_GUT);
  bf16_t* UPD = (bf16_t*)(p.ws + WS_Y); float* DEC = (float*)(p.ws + WS_DEC); const float* gbias = p.in[5];
  LAS float* bc = (LAS float*)(lds + GL_BC);
  const int j = tid >> 3, c = tid & 7;
  u32x4 kq, v0, v1, lr0 = {}, gub = {}; float gbs = 0.f;
  LAS float* tot0 = (LAS float*)(lds + GL_TOT);
#define GLA_A_LOAD(item_) do { const int n_ = (item_) & 63, bh_ = (item_) >> 6, h_ = bh_ & 3, b_ = bh_ >> 2; const size_t r0_ = (size_t)b_ * SEQ + n_ * 64; \
    if (wid < 4) { lr0 = *(const u32x4*)(PROJ + (r0_ + 32 * (wid >> 1) + r32) * NP + LR_OFF + 8 * hi); \
      gub = *(const u32x4*)(GUT + (h_ * 64 + 32 * (wid & 1) + r32) * 16 + 8 * hi); gbs = gbias[h_ * 64 + 32 * (wid & 1) + r32]; } \
    kq = *(const u32x4*)(PROJ + (r0_ + j) * NP + K_OFF + h_ * 64 + c * 8); \
    v0 = *(const u32x4*)(PROJ + (r0_ + (tid >> 4)) * NP + V_OFF + h_ * 128 + (tid & 15) * 8); \
    v1 = *(const u32x4*)(PROJ + (r0_ + 32 + (tid >> 4)) * NP + V_OFF + h_ * 128 + (tid & 15) * 8); } while (0)
  int item = vb;
  if (item < 2048) GLA_A_LOAD(item);
#pragma unroll 1
  for (; item < 2048; item += G) {
    if (wid < 4) gla_gates_mfma(__builtin_bit_cast(bf16x8, lr0), __builtin_bit_cast(bf16x8, gub), gbs, bc, tot0, wid & 1, wid >> 1, r32, hi);
    LBAR();
    {
      const unsigned kk[4] = {kq.x, kq.y, kq.z, kq.w}; float kd[8];
#pragma unroll
      for (int i = 0; i < 8; ++i) { const int d = c * 8 + i; const float kv = (i & 1) ? bfhi(kk[i >> 1]) : bflo(kk[i >> 1]); const float t0 = tot0[d];
        kd[i] = kv * __expf((bc[63 * 68 + d] + t0) - (bc[j * 68 + d] + (j >= 32 ? t0 : 0.f))); }
      *(LAS u32x4*)(lds + GL_KD + (c >> 2) * 4096 + j * 64 + (c & 3) * 16) = (u32x4){pk2(kd[0], kd[1]), pk2(kd[2], kd[3]), pk2(kd[4], kd[5]), pk2(kd[6], kd[7])};
      const int jj = tid >> 4, cc = tid & 15;
      *(LAS u32x4*)(lds + GL_V + (cc >> 2) * 4096 + jj * 64 + (cc & 3) * 16) = v0;
      *(LAS u32x4*)(lds + GL_V + (cc >> 2) * 4096 + (32 + jj) * 64 + (cc & 3) * 16) = v1;
      if (tid < 64) DEC[(size_t)item * 64 + tid] = __expf(bc[63 * 68 + tid] + tot0[tid]);
    }
    if (item + G < 2048) GLA_A_LOAD(item + G);
    LBAR();
    { const int vt = wid >> 1, dt = wid & 1; f32x16 acc = {};
      const int lo = ((lane >> 4) & 1) * 32 + (lane & 3) * 8 + (8 * hi + ((lane & 15) >> 2)) * 64;
#pragma unroll
      for (int ks = 0; ks < 4; ++ks) {
        const bf16x8 a = trfrag(lds + GL_V + vt * 4096, lo + ks * 1024, lo + ks * 1024 + 256);
        const bf16x8 bb = trfrag(lds + GL_KD + dt * 4096, lo + ks * 1024, lo + ks * 1024 + 256);
        acc = __builtin_amdgcn_mfma_f32_32x32x16_bf16(a, bb, acc, 0, 0, 0);
      }
      bf16_t* dst = UPD + (size_t)item * 8192 + 32 * dt + r32;
#pragma unroll
      for (int r = 0; r < 16; ++r) dst[(size_t)(32 * vt + crow(r, hi)) * 64] = (bf16_t)(pk2(acc[r], 0.f) & 0xffffu);
    }
  }
  LBAR();
#undef GLA_A_LOAD
}

__device__ __forceinline__ void gla_scan(const Params& p, int G, int vb) {
  const bf16_t* UPD = (const bf16_t*)(p.ws + WS_Y); const float* DEC = (const float*)(p.ws + WS_DEC); bf16_t* SPT = (bf16_t*)(p.ws + WS_SPT);
  for (int idx = vb * 512 + threadIdx.x; idx < 32 * 4096; idx += G * 512) {
    const int bh = idx >> 12, vd = (idx & 4095) * 2, d = vd & 63;
    float S0 = 0.f, S1 = 0.f;
#pragma unroll 16
    for (int n = 0; n < 64; ++n) { const size_t item = (size_t)bh * 64 + n;
      const unsigned uw = *(const unsigned*)(UPD + item * 8192 + vd); const f32x2 dc = *(const f32x2*)(DEC + item * 64 + d);
      *(unsigned*)(SPT + item * 8192 + vd) = pk2(S0, S1); S0 = dc.x * S0 + bflo(uw); S1 = dc.y * S1 + bfhi(uw); }
  }
}

__device__ __forceinline__ void gla_scan_block(const Params& p, LAS unsigned char* lds, int bh) {
  const bf16_t* UPD = (const bf16_t*)(p.ws + WS_Y); const float* DEC = (const float*)(p.ws + WS_DEC); bf16_t* SPT = (bf16_t*)(p.ws + WS_SPT);
  const int tid = threadIdx.x, d8 = tid & 7;
  LAS float* dl = (LAS float*)lds;
  for (int i = tid; i < 1024; i += 512) *(LAS f32x4*)(dl + 4 * i) = *(const f32x4*)(DEC + (size_t)bh * 4096 + 4 * i);
  __syncthreads();
  const size_t base = (size_t)bh * 64 * 8192 + (size_t)tid * 8;
  f32x4 S[4] = {};
#pragma unroll 1
  for (int n0 = 0; n0 < 64; n0 += 8) {
    u32x4 u[8][2];
#pragma unroll
    for (int k = 0; k < 8; ++k) { u[k][0] = *(const u32x4*)(UPD + base + (size_t)(n0 + k) * 8192); u[k][1] = *(const u32x4*)(UPD + base + (size_t)(n0 + k) * 8192 + 4096); }
#pragma unroll
    for (int k = 0; k < 8; ++k) {
      const f32x4 da = *(LAS f32x4*)(dl + (n0 + k) * 64 + d8 * 8), db = *(LAS f32x4*)(dl + (n0 + k) * 64 + d8 * 8 + 4);
      *(u32x4*)(SPT + base + (size_t)(n0 + k) * 8192) = pack8(S[0], S[1]);
      *(u32x4*)(SPT + base + (size_t)(n0 + k) * 8192 + 4096) = pack8(S[2], S[3]);
#pragma unroll
      for (int r = 0; r < 2; ++r) { const u32x4 w = u[k][r];
        S[2 * r][0] = da[0] * S[2 * r][0] + bflo(w.x); S[2 * r][1] = da[1] * S[2 * r][1] + bfhi(w.x);
        S[2 * r][2] = da[2] * S[2 * r][2] + bflo(w.y); S[2 * r][3] = da[3] * S[2 * r][3] + bfhi(w.y);
        S[2 * r + 1][0] = db[0] * S[2 * r + 1][0] + bflo(w.z); S[2 * r + 1][1] = db[1] * S[2 * r + 1][1] + bfhi(w.z);
        S[2 * r + 1][2] = db[2] * S[2 * r + 1][2] + bflo(w.w); S[2 * r + 1][3] = db[3] * S[2 * r + 1][3] + bfhi(w.w); }
    }
  }
  __syncthreads();
}

template <int MODE>
__device__ __forceinline__ void gla_c_phase(const Params& p, LAS unsigned char* lds, int G, int vb, int k0, int k1) {
  int tid_ = threadIdx.x; asm volatile("" : "+v"(tid_));
  const int tid = tid_, lane = tid & 63, r32 = lane & 31, hi = lane >> 5; const int wid = __builtin_amdgcn_readfirstlane(tid >> 6);
  const bf16_t* PROJ = (const bf16_t*)(p.ws + WS_PROJ); const bf16_t* GUT = (const bf16_t*)(p.ws + WS_GUT); const bf16_t* SPT = (const bf16_t*)(p.ws + WS_SPT);
  bf16_t* Y = (bf16_t*)(p.ws + WS_Y); const float* gbias = p.in[5]; const float* gnw = p.in[6];
  LAS float* bc = (LAS float*)(lds + GL_BC); LAS bf16_t* QE = (LAS bf16_t*)(lds + GL_QE); LAS bf16_t* KE = (LAS bf16_t*)(lds + GL_KE); LAS bf16_t* ST = (LAS bf16_t*)(lds + GL_ST);
  LAS float* red = (LAS float*)(lds + GL_RED);
  const int j = tid >> 3, c = tid & 7;
  const int it = wid & 1, vt = wid >> 1;
  u32x4 qq, kq, v0, v1, s0, s1, lr0 = {}, gub = {}; float gbs = 0.f; u32x2 og[4];
  LAS float* tot0 = (LAS float*)(lds + GL_TOT);
#define GLA_C_LOAD(item_) do { const int n_ = (item_) & 63, bh_ = (item_) >> 6, h_ = bh_ & 3, b_ = bh_ >> 2; const size_t r0_ = (size_t)b_ * SEQ + n_ * 64; \
    if (wid < 4) { lr0 = *(const u32x4*)(PROJ + (r0_ + 32 * (wid >> 1) + r32) * NP + LR_OFF + 8 * hi); \
      gub = *(const u32x4*)(GUT + (h_ * 64 + 32 * (wid & 1) + r32) * 16 + 8 * hi); gbs = gbias[h_ * 64 + 32 * (wid & 1) + r32]; } \
    qq = *(const u32x4*)(PROJ + (r0_ + j) * NP + Q_OFF + h_ * 64 + c * 8); \
    kq = *(const u32x4*)(PROJ + (r0_ + j) * NP + K_OFF + h_ * 64 + c * 8); \
    v0 = *(const u32x4*)(PROJ + (r0_ + (tid >> 4)) * NP + V_OFF + h_ * 128 + (tid & 15) * 8); \
    v1 = *(const u32x4*)(PROJ + (r0_ + 32 + (tid >> 4)) * NP + V_OFF + h_ * 128 + (tid & 15) * 8); \
    s0 = *(const u32x4*)(SPT + (size_t)(item_) * 8192 + (size_t)tid * 8); s1 = *(const u32x4*)(SPT + (size_t)(item_) * 8192 + 4096 + (size_t)tid * 8); \
    _Pragma("unroll") for (int g_ = 0; g_ < 4; ++g_) og[g_] = *(const u32x2*)(PROJ + (r0_ + 32 * it + r32) * NP + OG_OFF + h_ * 128 + 32 * vt + 8 * g_ + 4 * hi); } while (0)
  f32x4 nwr[4];
  { const float* gnw_l = gnw; asm volatile("" : "+v"(gnw_l));
#pragma unroll
  for (int g = 0; g < 4; ++g) nwr[g] = *(const f32x4*)(gnw_l + 32 * vt + 8 * g + 4 * hi); }
  int item = vb + k0 * G; const int iend = vb + (k1 < 64 ? k1 : 64) * G;
  if (item < iend && item < 2048) GLA_C_LOAD(item);
#define GLA_C_LOAD_NEXT(it_) do { if (MODE != 2) GLA_C_LOAD(it_); } while (0)
#pragma unroll 1
  for (; item < iend && item < 2048; item += G) {
    const int n = item & 63, bh = item >> 6, h = bh & 3, b = bh >> 2; const size_t r0 = (size_t)b * SEQ + n * 64;
    if (wid < 4) gla_gates_mfma(__builtin_bit_cast(bf16x8, lr0), __builtin_bit_cast(bf16x8, gub), gbs, bc, tot0, wid & 1, wid >> 1, r32, hi);
    LBAR();
    {
      const unsigned q4[4] = {qq.x, qq.y, qq.z, qq.w}, k4[4] = {kq.x, kq.y, kq.z, kq.w}; float qv[8], kv[8];
#pragma unroll
      for (int i = 0; i < 8; ++i) { const float bb = bc[j * 68 + c * 8 + i] + (j >= 32 ? tot0[c * 8 + i] : 0.f);
        qv[i] = ((i & 1) ? bfhi(q4[i >> 1]) : bflo(q4[i >> 1])) * 0.125f * __expf(bb);
        kv[i] = ((i & 1) ? bfhi(k4[i >> 1]) : bflo(k4[i >> 1])) * __expf(-bb); }
      *(LAS u32x4*)(QE + j * 72 + c * 8) = (u32x4){pk2(qv[0], qv[1]), pk2(qv[2], qv[3]), pk2(qv[4], qv[5]), pk2(qv[6], qv[7])};
      *(LAS u32x4*)(KE + j * 72 + c * 8) = (u32x4){pk2(kv[0], kv[1]), pk2(kv[2], kv[3]), pk2(kv[4], kv[5]), pk2(kv[6], kv[7])};
      const int jj = tid >> 4, cc = tid & 15;
      *(LAS u32x4*)(lds + GL_V + (cc >> 2) * 4096 + jj * 64 + (cc & 3) * 16) = v0;
      *(LAS u32x4*)(lds + GL_V + (cc >> 2) * 4096 + (32 + jj) * 64 + (cc & 3) * 16) = v1;
      *(LAS u32x4*)(ST + (tid >> 3) * 72 + (tid & 7) * 8) = s0;
      *(LAS u32x4*)(ST + (64 + (tid >> 3)) * 72 + (tid & 7) * 8) = s1;
    }
    u32x2 ogc[4];
#pragma unroll
    for (int g = 0; g < 4; ++g) ogc[g] = og[g];
    if (item + G < iend && item + G < 2048) GLA_C_LOAD_NEXT(item + G);
    LBAR();
    f32x16 acc = {};
    {
      bf16x8 qf[4];
#pragma unroll
      for (int ks = 0; ks < 4; ++ks) qf[ks] = *(const LAS bf16x8*)(QE + (32 * it + r32) * 72 + 16 * ks + 8 * hi);
      const int i_abs = 32 * it + r32;
      const int lo = ((lane >> 4) & 1) * 32 + (lane & 3) * 8 + (4 * hi + ((lane & 15) >> 2)) * 64;
#pragma unroll
      for (int jt = 0; jt < 2; ++jt) {
        if (jt <= it) {
          f32x16 at = {};
#pragma unroll
          for (int ks = 0; ks < 4; ++ks) {
            const bf16x8 a = *(const LAS bf16x8*)(KE + (32 * jt + r32) * 72 + 16 * ks + 8 * hi);
            at = __builtin_amdgcn_mfma_f32_32x32x16_bf16(a, qf[ks], at, 0, 0, 0);
          }
#pragma unroll
          for (int r = 0; r < 16; ++r) if (32 * jt + crow(r, hi) > i_abs) at[r] = 0.f;
#pragma unroll
          for (int s = 0; s < 2; ++s) {
            const u32x4 pw = (u32x4){pk2(at[8 * s + 0], at[8 * s + 1]), pk2(at[8 * s + 2], at[8 * s + 3]), pk2(at[8 * s + 4], at[8 * s + 5]), pk2(at[8 * s + 6], at[8 * s + 7])};
            const int ks = 2 * jt + s;
            const bf16x8 vf = trfrag(lds + GL_V + vt * 4096, lo + ks * 1024, lo + ks * 1024 + 512);
            acc = __builtin_amdgcn_mfma_f32_32x32x16_bf16(vf, __builtin_bit_cast(bf16x8, pw), acc, 0, 0, 0);
          }
        }
      }
#pragma unroll
      for (int ks = 0; ks < 4; ++ks) {
        const bf16x8 a = *(const LAS bf16x8*)(ST + (32 * vt + r32) * 72 + 16 * ks + 8 * hi);
        acc = __builtin_amdgcn_mfma_f32_32x32x16_bf16(a, qf[ks], acc, 0, 0, 0);
      }
    }
    float sq = 0.f;
#pragma unroll
    for (int r = 0; r < 16; ++r) sq += acc[r] * acc[r];
    red[(32 * it + r32) * 8 + vt * 2 + hi] = sq;
    LBAR();
    {
      const LAS f32x4* rr = (const LAS f32x4*)(red + (32 * it + r32) * 8);
      const f32x4 ra = rr[0], rb = rr[1];
      const float tot = ((ra[0] + ra[1]) + (ra[2] + ra[3])) + ((rb[0] + rb[1]) + (rb[2] + rb[3]));
      const float rinv = rsqrtf(tot * (1.f / 128.f) + EPS);
      bf16_t* dst = Y + (r0 + 32 * it + r32) * 1024 + h * 128 + 32 * vt + 4 * hi;
#pragma unroll
      for (int g = 0; g < 4; ++g) {
        const f32x4 nw = nwr[g];
        const float o0 = bflo(ogc[g].x), o1 = bfhi(ogc[g].x), o2 = bflo(ogc[g].y), o3 = bfhi(ogc[g].y);
        const float y0 = acc[4 * g + 0] * rinv * nw[0] * (o0 / (1.f + __expf(-o0)));
        const float y1 = acc[4 * g + 1] * rinv * nw[1] * (o1 / (1.f + __expf(-o1)));
        const float y2 = acc[4 * g + 2] * rinv * nw[2] * (o2 / (1.f + __expf(-o2)));
        const float y3 = acc[4 * g + 3] * rinv * nw[3] * (o3 / (1.f + __expf(-o3)));
        u32x2 w; w.x = pk2(y0, y1); w.y = pk2(y2, y3);
        if (MODE == 0 || w.x == 0x12345679u) *(u32x2*)(dst + 8 * g) = w;
      }
    }
  }
  LBAR();
#undef GLA_C_LOAD
}

constexpr int RT_LG = 0;
constexpr int RT_HIST = 8 * 16 * 49 * 4;
constexpr int RT_BASE = RT_HIST + 128;
__device__ __forceinline__ void router_phase(const Params& p, LAS unsigned char* lds, int G, int vb) {
  const int tid = threadIdx.x, lane = tid & 63, wave = tid >> 6;
  const bf16_t* HB = (const bf16_t*)(p.ws + WS_XB); const bf16_t* WrT = (const bf16_t*)(p.ws + WS_WR);
  float* RS2 = (float*)(p.ws + WS_RS2); int* cnt = (int*)(p.ws + WS_CNT); int* LTOK = (int*)(p.ws + WS_LTOK); float* LGATE = (float*)(p.ws + WS_LGATE);
  const float* gbias = p.in[14]; const float* ebias = p.in[16];
  LAS float* lg = (LAS float*)(lds + RT_LG) + wave * 16 * 49; LAS int* hist = (LAS int*)(lds + RT_HIST); LAS int* basee = (LAS int*)(lds + RT_BASE);
  for (int base = vb * 8; base < NTOK / 16; base += G * 8) {
    if (tid < 32) hist[tid] = 0;
    const int r0 = (base + wave) * 16;
    f32x4 acc[3] = {{0.f, 0.f, 0.f, 0.f}, {0.f, 0.f, 0.f, 0.f}, {0.f, 0.f, 0.f, 0.f}};
    const bf16_t* arow = HB + (size_t)(r0 + (lane & 15)) * 1024 + (lane >> 4) * 8;
    const bf16_t* brow = WrT + (size_t)(lane & 15) * 1024 + (lane >> 4) * 8;
    float hsq = 0.f;
#pragma unroll 4
    for (int kk = 0; kk < 32; ++kk) {
      const bf16x8 a = *(const bf16x8*)(arow + kk * 32);
      { const u32x4 aw = __builtin_bit_cast(u32x4, a); const float e0 = bflo(aw.x), e1 = bfhi(aw.x), e2 = bflo(aw.y), e3 = bfhi(aw.y), e4 = bflo(aw.z), e5 = bfhi(aw.z), e6 = bflo(aw.w), e7 = bfhi(aw.w);
        hsq += ((e0 * e0 + e1 * e1) + (e2 * e2 + e3 * e3)) + ((e4 * e4 + e5 * e5) + (e6 * e6 + e7 * e7)); }
#pragma unroll
      for (int n = 0; n < 3; ++n) { const bf16x8 bb = *(const bf16x8*)(brow + (size_t)n * 16 * 1024 + kk * 32); acc[n] = __builtin_amdgcn_mfma_f32_16x16x32_bf16(a, bb, acc[n], 0, 0, 0); }
    }
    hsq += __shfl_xor(hsq, 16); hsq += __shfl_xor(hsq, 32);
#pragma unroll
    for (int n = 0; n < 3; ++n)
#pragma unroll
      for (int r = 0; r < 4; ++r) lg[((lane >> 4) * 4 + r) * 49 + 16 * n + (lane & 15)] = acc[n][r];
    __syncthreads();
    int e1 = 0, e2 = 0, lp1 = 0, lp2 = 0; float g1 = 0.f, g2 = 0.f; const int tok = r0 + lane;
    if (lane < 16) {
      const float rs = rsqrtf(hsq * (1.f / 1024.f) + EPS);
      RS2[tok] = rs;
      float gl[4]; int gs = 0;
#pragma unroll
      for (int i = 0; i < 4; ++i) gl[i] = lg[lane * 49 + i] * rs + gbias[i];
#pragma unroll
      for (int i = 1; i < 4; ++i) if (gl[i] > gl[gs]) gs = i;
      float den = 0.f;
#pragma unroll
      for (int i = 0; i < 4; ++i) den += __expf(gl[i] - gl[gs]);
      const float pg = 1.f / den;
      float el[8];
#pragma unroll
      for (int i = 0; i < 8; ++i) el[i] = lg[lane * 49 + 4 + gs * 8 + i] * rs + ebias[gs * 8 + i];
      int i1 = 0;
#pragma unroll
      for (int i = 1; i < 8; ++i) if (el[i] > el[i1]) i1 = i;
      int i2 = (i1 == 0) ? 1 : 0;
#pragma unroll
      for (int i = 0; i < 8; ++i) if (i != i1 && el[i] > el[i2]) i2 = i;
      const float t = __expf(el[i2] - el[i1]);
      g1 = pg / (1.f + t); g2 = pg * t / (1.f + t);
      e1 = gs * 8 + i1; e2 = gs * 8 + i2;
      lp1 = atomicAdd((int*)(hist + e1), 1); lp2 = atomicAdd((int*)(hist + e2), 1);
    }
    __syncthreads();
    if (tid < 32) { const int hc = hist[tid]; basee[tid] = hc ? atomicAdd(cnt + tid, hc) : 0; }
    __syncthreads();
    if (lane < 16) {
      const int p1 = e1 * ECAP + basee[e1] + lp1, p2 = e2 * ECAP + basee[e2] + lp2;
      LTOK[p1] = tok * 2; LGATE[p1] = g1; LTOK[p2] = tok * 2 + 1; LGATE[p2] = g2;
    }
    __syncthreads();
  }
}

__device__ __forceinline__ void final_phase(const Params& p, int G, int vb, float pc1, float pc2) {
  const int lane = threadIdx.x & 63, wave = threadIdx.x >> 6;
  const float* fw = p.in[20]; const bf16_t* Y2 = (const bf16_t*)(p.ws + WS_PROJ); const bf16_t* HB = (const bf16_t*)(p.ws + WS_XB);
  for (int m = vb * 8 + wave; m < NTOK; m += G * 8) {
    f32x4* orow = (f32x4*)(p.out + (size_t)m * DM) + lane;
    f32x4 v[4]; float s = 0.f;
#pragma unroll
    for (int j = 0; j < 4; ++j) {
      const u32x2 hh = *((const u32x2*)(HB + (size_t)m * 1024) + lane + 64 * j);
      v[j] = (f32x4){bflo(hh.x), bfhi(hh.x), bflo(hh.y), bfhi(hh.y)};
#if ENABLE_MOE
      const u32x2 a = *((const u32x2*)(Y2 + (size_t)(2 * m) * 1024) + lane + 64 * j), b = *((const u32x2*)(Y2 + (size_t)(2 * m + 1) * 1024) + lane + 64 * j);
      v[j].x += bflo(a.x) + bflo(b.x); v[j].y += bfhi(a.x) + bfhi(b.x); v[j].z += bflo(a.y) + bflo(b.y); v[j].w += bfhi(a.y) + bfhi(b.y);
#endif
      s += (v[j].x * v[j].x + v[j].y * v[j].y) + (v[j].z * v[j].z + v[j].w * v[j].w);
    }
    s = wave_sum(s);
    const float rs = rsqrtf(s * (1.f / DM) + EPS);
#pragma unroll
    for (int j = 0; j < 4; ++j) { const f32x4 w = *((const f32x4*)fw + lane + 64 * j); f32x4 o = v[j] * rs * w;
#ifdef PROBE_T1
      o = o + pc1;
#endif
      orow[64 * j] = o; }
  }
}


#define XB_TMO      128
#define XB_XCNT(j)  (256  + 64 * (j))
#define XB_XSUB(j)  (1280 + 64 * (j))
#define XB_XGEN(j)  (2304 + 64 * (j))
#define XB_TOP      3328
#define XB_TOPGEN   3392
#define XB_SPIN_CAP (1u << 22)
__device__ __forceinline__ unsigned xb_ld(unsigned* p)              { return __hip_atomic_load(p, __ATOMIC_RELAXED, __HIP_MEMORY_SCOPE_AGENT); }
__device__ __forceinline__ unsigned xb_add(unsigned* p, unsigned v) { return __hip_atomic_fetch_add(p, v, __ATOMIC_RELAXED, __HIP_MEMORY_SCOPE_AGENT); }
__device__ __forceinline__ unsigned xb_xcc_id() { return (unsigned)__builtin_amdgcn_s_getreg((3 << 11) | 20) & 0xFu; }
#define XB_SPIN(cond, bar) do { unsigned _sp = 0; while (cond) { __builtin_amdgcn_s_sleep(1); \
    if ((++_sp & 255u) == 0u) { if (xb_ld(&(bar)[XB_TMO])) break; if (_sp > XB_SPIN_CAP) { atomicAdd(&(bar)[XB_TMO], 1u); break; } } } } while (0)
struct XcdBarrier { unsigned* bar; unsigned x; volatile LAS unsigned* st; };
__device__ __forceinline__ XcdBarrier xcd_barrier_post(unsigned* bar, volatile LAS unsigned* st) {
  XcdBarrier b; b.bar = bar; b.x = xb_xcc_id(); b.st = st;
  if (threadIdx.x == 0) st[2] = xb_add(&bar[XB_XCNT(b.x)], 1u);
  return b;
}
__device__ __forceinline__ void xcd_barrier_complete(unsigned* bar, unsigned x, unsigned& nloc, unsigned& nx) {
  const unsigned G = gridDim.x * gridDim.y * gridDim.z;
  unsigned sum, cnt, mine, sp = 0u;
  for (;;) {
    sum = 0u; cnt = 0u; mine = 0u;
#pragma unroll
    for (unsigned j = 0; j < 16; ++j) { const unsigned c = xb_ld(&bar[XB_XCNT(j)]); sum += c; cnt += (c > 0u) ? 1u : 0u; mine = (j == x) ? c : mine; }
    if (sum == G) break;
    __builtin_amdgcn_s_sleep(1);
    if ((++sp & 255u) == 0u) { if (xb_ld(&bar[XB_TMO])) break; if (sp > XB_SPIN_CAP) { atomicAdd(&bar[XB_TMO], 1u); break; } }
  }
  nloc = mine > 0u ? mine : 1u; nx = cnt > 0u ? cnt : 1u;
}
__device__ __forceinline__ void xcd_barrier(const XcdBarrier& b) {
  asm volatile("s_waitcnt vmcnt(0)" ::: "memory");
  __syncthreads();
  if (threadIdx.x == 0) {
    unsigned* bar = b.bar;
    __builtin_amdgcn_s_waitcnt(0);
    unsigned nloc = b.st[0], nx = b.st[1];
    if (nloc == 0u) { xcd_barrier_complete(bar, b.x, nloc, nx); b.st[0] = nloc; b.st[1] = nx; }
    const unsigned old = xb_add(&bar[XB_XSUB(b.x)], 1u);
    const unsigned gen = old / nloc;
    if (old + 1u == (gen + 1u) * nloc) {
      __builtin_amdgcn_fence(__ATOMIC_RELEASE, "agent");
      asm volatile("s_waitcnt vmcnt(0)" ::: "memory");
      const unsigned og = xb_add(&bar[XB_TOP], 1u);
      const unsigned tg = og / nx;
      if (og + 1u == (tg + 1u) * nx) xb_add(&bar[XB_TOPGEN], 1u);
      else XB_SPIN(xb_ld(&bar[XB_TOPGEN]) == tg, bar);
      xb_add(&bar[XB_XGEN(b.x)], 1u);
      __builtin_amdgcn_fence(__ATOMIC_ACQUIRE, "agent");
      asm volatile("s_waitcnt vmcnt(0)" ::: "memory");
    } else {
      XB_SPIN(xb_ld(&bar[XB_XGEN(b.x)]) == gen, bar);
      __builtin_amdgcn_fence(__ATOMIC_ACQUIRE, "agent");
      asm volatile("s_waitcnt vmcnt(0)" ::: "memory");
    }
  }
  __syncthreads();
}

constexpr int LDS_CTL = 131072;
constexpr int LDS_BYTES = 131072 + 1024 + 8192;

__global__ void __launch_bounds__(512) fwd(Params p, int ph_lo, int ph_hi) {
  extern __shared__ __attribute__((aligned(16))) unsigned char lds_raw[];
  LAS unsigned char* lds = (LAS unsigned char*)lds_raw;
  cg::grid_group grid = cg::this_grid();
  const int G = gridDim.x, bx = blockIdx.x;
  int vb = bx;
  int crr = bx;
  unsigned char* ws = p.ws;
#ifndef PHMASK
#define PHMASK 0x3ff
#endif
#define PH(k) (((PHMASK >> (k)) & 1) && ph_lo <= (k) && (k) < ph_hi)
#ifdef PROBE_T1
  LAS unsigned long long* tsx = (LAS unsigned long long*)(lds + LDS_CTL + 512);
  if (threadIdx.x == 0) tsx[0] = __builtin_amdgcn_s_memrealtime();
#define SEAM(k) do { if (PH(k) && PH((k) + 1)) grid.sync(); if (threadIdx.x == 0) tsx[(k) + 1] = __builtin_amdgcn_s_memrealtime(); } while (0)
#else
#define SEAM(k) do { if (PH(k) && PH((k) + 1)) xcd_barrier(xbar); } while (0)
#endif
  volatile LAS unsigned* xst = (volatile LAS unsigned*)(lds + LDS_CTL + 768);
  if (threadIdx.x == 0) { xst[0] = 0u; xst[1] = 0u; }
  if (blockIdx.x == 0) for (int i = threadIdx.x; i < XCD_BAR_WORDS; i += 512) ((unsigned*)(ws + WS_BAR))[i] = 0u;
  grid.sync();
  XcdBarrier xbar = xcd_barrier_post((unsigned*)(ws + WS_BAR), xst);
  if (PH(0)) for (int rep = 0; rep < ((REPEAT_PHASE == 0) ? 2 : 1); ++rep) { if (rep) grid.sync(); p0_prologue(p, lds, G, vb); }
  SEAM(0);
  {
    volatile LAS unsigned* xs = xst;
    if (threadIdx.x == 0) { unsigned pre = 0u; for (unsigned j = 0; j < xbar.x; ++j) pre += xb_ld(&xbar.bar[XB_XCNT(j)]); xs[3] = pre + xs[2]; }
    __syncthreads();
    if (G % 8 == 0) { vb = (int)xs[3]; if (vb >= G) vb = bx; const int per = G / 8; crr = (vb % per) * 8 + vb / per; }
  }
  if (PH(1)) for (int rep = 0; rep < NREP(1); ++rep) {
    if (rep) grid.sync();
    g8::DenseSched S; S.init(ws + WS_XB, 1024, ws + WS_WIN, 1024, NTOK, NP, G, crr);
    EpiInproj E{(bf16_t*)(ws + WS_PROJ), (const float*)(ws + WS_RS1), (float*)(ws + WS_SSQP), (const f32x2*)(ws + WS_CS)};
    g8::gemm_phase(lds, 1024, S, E);
    if (G == 256 && crr >= 128 && rep == 0) {
      LAS float* scr = (LAS float*)(lds + (threadIdx.x >> 6) * 8704);
      for (int r = (crr - 128) * 8 + (threadIdx.x >> 6); r < CONV_GU_P1; r += 1024) conv_gu_item(p, CONV_GU_P0 + r, scr, threadIdx.x & 63);
      for (int r = (crr - 128) * 8 + (threadIdx.x >> 6); r < CONV_D_P1; r += 1024) conv_d_item(p, r, scr, threadIdx.x & 63);
      __syncthreads();
    }
  }
  SEAM(1);
  const bool split23 = (G == 256);
  const int Gg = split23 ? 224 : G;
#define P2_GEMMS(DRY) do { \
    { g8::DenseSched S; S.init((const bf16_t*)(ws + WS_PROJ) + CQ_OFF, NP, ws + WS_WUQ, 384, NTOK, 768, Gg, crr); \
      EpiUq E{(bf16_t*)(ws + WS_QB), (const float*)(ws + WS_SSQP), (const f32x2*)(ws + WS_CS), DRY}; \
      g8::gemm_phase(lds, 384, S, E); } \
    { g8::DenseSched S; S.init((const bf16_t*)(ws + WS_PROJ) + CKV_OFF, NP, ws + WS_WUKV, 256, NTOK, 1024, Gg, split23 ? (crr + 64) % 224 : crr);     \
      EpiUkv E{(bf16_t*)(ws + WS_KVB), (const float*)(ws + WS_SSQP), DRY}; \
      g8::gemm_phase(lds, 256, S, E); } } while (0)
#define P2_GLA() gla_a_phase(p, lds, G, vb)
#define P4_GLA() gla_c_phase<0>(p, lds, G, vb, 0, 1 << 20)
  if (PH(2)) {
#if ENABLE_GLA
    P2_GLA();
#endif
#if REPEAT_PHASE == 2
    grid.sync();
    P2_GLA();
#endif
  }
  SEAM(2);
  if (PH(3)) {
#if ENABLE_MLA
    if (!split23 || crr < 224) P2_GEMMS(false);
#endif
#if ENABLE_GLA
    if (!split23) gla_scan(p, G, vb);
    else if (crr >= 224) {
      gla_scan_block(p, lds, crr - 224);
      LAS float* scr_ = (LAS float*)(lds + (threadIdx.x >> 6) * 8704);
      for (int r_ = (crr - 224) * 8 + (threadIdx.x >> 6); r_ < CONV_GU_P2; r_ += 256) conv_gu_item(p, CONV_GU_P0 + CONV_GU_P1 + r_, scr_, threadIdx.x & 63);
      for (int r_ = CONV_D_P1 + (crr - 224) * 8 + (threadIdx.x >> 6); r_ < 4096; r_ += 256) conv_d_item(p, r_, scr_, threadIdx.x & 63);
      __syncthreads();
    }
#endif
#if REPEAT_PHASE == 3
    grid.sync();
    if ((REPEAT_SUB & 1) && (!split23 || crr < 224)) P2_GEMMS(true);
    if ((REPEAT_SUB & 2) && split23 && crr >= 224) {
      gla_scan_block(p, lds, crr - 224);
      if (REPEAT_SUB & 4) { LAS float* scr_ = (LAS float*)(lds + (threadIdx.x >> 6) * 8704);
      for (int r_ = (crr - 224) * 8 + (threadIdx.x >> 6); r_ < CONV_GU_P2; r_ += 256) conv_gu_item(p, CONV_GU_P0 + CONV_GU_P1 + r_, scr_, threadIdx.x & 63);
      for (int r_ = CONV_D_P1 + (crr - 224) * 8 + (threadIdx.x >> 6); r_ < 4096; r_ += 256) conv_d_item(p, r_, scr_, threadIdx.x & 63);
      __syncthreads(); }
    }
#endif
  }
  SEAM(3);
  if (PH(4)) {
#if ENABLE_MLA && ENABLE_GLA
    if (G == 256) {
      const int bh = vb >> 2, s4 = vb & 3;
      const int odd = vb & 1;
#pragma unroll 1
      for (int k = 0; k < 8; ++k) { const int i = k >> 1;
        if (((k + odd) & 1) == 0) { const int qb = (i == 0) ? 15 - s4 : (i == 1) ? 8 + s4 : (i == 2) ? 7 - s4 : s4; attn_unit<0>(p, lds, bh >> 3, bh & 7, qb); }
        else gla_c_phase<0>(p, lds, G, vb, 2 * i, 2 * i + 2); }
    } else { attn_phase<0>(p, lds, G, vb); P4_GLA(); }
#elif ENABLE_MLA
    attn_phase<0>(p, lds, G, vb);
#else
    { u32x4* Yz = (u32x4*)(ws + WS_Y); for (int i = vb * 512 + threadIdx.x; i < NTOK * 64; i += G * 512) Yz[(size_t)(i >> 6) * 128 + 64 + (i & 63)] = (u32x4){0u, 0u, 0u, 0u}; }
#endif
#if ENABLE_GLA && !ENABLE_MLA
    P4_GLA();
#endif
#if REPEAT_PHASE == 4
    grid.sync();
#ifndef ATTN_PROBE_MODE
#define ATTN_PROBE_MODE 0
#endif
    if (REPEAT_SUB & 1) attn_phase<ATTN_PROBE_MODE>(p, lds, G, vb);
#ifndef GLA_PROBE_MODE
#define GLA_PROBE_MODE 0
#endif
    if (REPEAT_SUB & 2) gla_c_phase<GLA_PROBE_MODE>(p, lds, G, vb, 0, 1 << 20);
#endif
  }
  SEAM(4);
  if (PH(5)) for (int rep = 0; rep < NREP(5); ++rep) {
    if (rep) grid.sync();
    g8::DenseSched S; S.init(ws + WS_Y, 1024, ws + WS_WOUT, 1024, NTOK, 1024, G, crr);
    EpiWout E{p.in[0], (bf16_t*)(ws + WS_XB), ws + WS_H8};
    g8::gemm_phase(lds, 1024, S, E);
  }
  SEAM(5);
#if ENABLE_MOE
  if (PH(6)) router_phase(p, lds, G, vb);
  SEAM(6);
  if (PH(7) || PH(8)) {
    LAS int* tb = (LAS int*)(lds + LDS_CTL); LAS int* cn = (LAS int*)(lds + LDS_CTL + 256);
    if (threadIdx.x == 0) { const int* cnt = (const int*)(ws + WS_CNT); int acc = 0;
      for (int e = 0; e < NEXP; ++e) { const int c = cnt[e]; cn[e] = c; tb[e] = acc; acc += (c + 255) >> 8; }
      tb[NEXP] = acc; }
    __syncthreads();
    const int T = tb[NEXP];
    if (PH(7)) for (int rep = 0; rep < NREP(7); ++rep) {
      if (rep) grid.sync();
#if MOE_FP8
      MoeSched<true> S; S.A = (const char*)(ws + WS_H8); S.B = (const char*)(ws + WS_WGU); S.lda = 512; S.ldb = 512; S.ncol = 2; S.total = T * 2; S.G = G; S.c = vb;
      S.tb = tb; S.cn = cn; S.ltok = (const int*)(ws + WS_LTOK); S.bstride = (size_t)512 * 1024; S.n1 = 0; S.r = 0; S.flg = nullptr;
#else
      MoeSched<true> S; S.A = (const char*)(ws + WS_XB); S.B = (const char*)(ws + WS_WGU); S.lda = 1024; S.ldb = 1024; S.ncol = 2; S.total = T * 2; S.G = G; S.c = vb;
      S.tb = tb; S.cn = cn; S.ltok = (const int*)(ws + WS_LTOK); S.bstride = (size_t)512 * 1024 * 2; S.n1 = 0; S.r = 0; S.flg = nullptr;
#endif
      EpiGU E{(bf16_t*)(ws + WS_QB), (const float*)(ws + WS_RS2), (const int*)(ws + WS_LTOK), cn, rep > 0 && P8_DRY, (int*)(ws + WS_FLG)};
      g8::gemm_phase<MOE_FP8 ? 2 : 0>(lds, MOE_FP8 ? 512 : 1024, S, E);
    }
    if (PH(8)) for (int rep = 0; rep < NREP(8); ++rep) {
      if (rep) grid.sync();
#if MOE_FP8
      MoeSched<false> S; S.A = (const char*)(ws + WS_QB); S.B = (const char*)(ws + WS_WD); S.lda = 128; S.ldb = 128; S.ncol = 4; S.total = T * 4; S.G = G; S.c = vb;
      S.tb = tb; S.cn = cn; S.ltok = (const int*)(ws + WS_LTOK); S.bstride = (size_t)1024 * 256;
#else
      MoeSched<false> S; S.A = (const char*)(ws + WS_QB); S.B = (const char*)(ws + WS_WD); S.lda = 256; S.ldb = 256; S.ncol = 4; S.total = T * 4; S.G = G; S.c = vb;
      S.tb = tb; S.cn = cn; S.ltok = (const int*)(ws + WS_LTOK); S.bstride = (size_t)1024 * 256 * 2;
#endif
      { const int rr_ = (T * 2) % G, n0_ = (T * 4 + 2 * rr_ + G - 1) / G; S.r = rr_; S.n1 = n0_ > 2 ? n0_ - 2 : 0; S.flg = (const int*)(ws + WS_FLG); }
      EpiDown E{(bf16_t*)(ws + WS_PROJ), (const int*)(ws + WS_LTOK), (const float*)(ws + WS_LGATE), cn, rep > 0 && P8_DRY};
      g8::gemm_phase<MOE_FP8 ? 1 : 0>(lds, MOE_FP8 ? 128 : 256, S, E);
    }
  }
  SEAM(8);
#endif
#ifdef PROBE_T1
  __syncthreads();
  const float probe_c1 = 0.1f * log2f((float)(tsx[PROBE_T1 + 1] - tsx[PROBE_T1]) * 0.01f), probe_c2 = 0.f;
  if (PH(9)) final_phase(p, G, vb, probe_c1, probe_c2);
#else
#ifdef EXTRA_SYNCS
  for (int i = 0; i < EXTRA_SYNCS; ++i) grid.sync();
#endif
  if (PH(9)) final_phase(p, G, vb, 0.f, 0.f);
#endif
#undef PH
#undef SEAM
}

extern "C" void kernel_launch(void* const* d_in, const int* in_sizes, int n_in, void* d_out, int out_size,
                              void* d_ws, size_t ws_size, hipStream_t stream) {
  static int grid_blocks = 0;
  if (grid_blocks == 0) {
    if (n_in != 21 || ws_size < WS_END) { fprintf(stderr, "kernel_launch: unexpected n_in %d or ws_size %zu (< %zu)\n", n_in, ws_size, (size_t)WS_END); grid_blocks = -1; return; }
    int dev = 0, cus = 0, per_cu = 0;
    hipGetDevice(&dev);
    hipDeviceGetAttribute(&cus, hipDeviceAttributeMultiprocessorCount, dev);
    hipFuncSetAttribute((const void*)fwd, hipFuncAttributeMaxDynamicSharedMemorySize, LDS_BYTES);
    hipOccupancyMaxActiveBlocksPerMultiprocessor(&per_cu, (const void*)fwd, 512, LDS_BYTES);
    if (per_cu < 1) { fprintf(stderr, "kernel_launch: occupancy query says %d blocks/CU\n", per_cu); per_cu = 1; }
    grid_blocks = cus;
  }
  if (grid_blocks < 0) return;
  Params p{};
  for (int i = 0; i < 21; ++i) p.in[i] = (const float*)d_in[i];
  p.out = (float*)d_out; p.ws = (unsigned char*)d_ws;
  int lo = 0, hi = 10;
  void* args[] = {&p, &lo, &hi};
  hipError_t e = hipLaunchCooperativeKernel((void*)fwd, dim3(grid_blocks), dim3(512), args, LDS_BYTES, stream);
  if (e != hipSuccess) fprintf(stderr, "cooperative launch failed: %s (grid %d)\n", hipGetErrorString(e), grid_blocks);
}
```

```cpp
#include <hip/hip_runtime.h>
#include <hip/hip_cooperative_groups.h>
#include <cstdio>
#include <cstdint>
#include <cmath>
namespace cg = cooperative_groups;

#ifndef MOE_FP8
#define MOE_FP8 1
#endif
#ifndef ENABLE_GLA
#define ENABLE_GLA 1
#endif
#ifndef ENABLE_MLA
#define ENABLE_MLA 1
#endif
#ifndef ENABLE_MOE
#define ENABLE_MOE 1
#endif

#ifndef P8_DRY
#define P8_DRY false
#endif
#ifndef REPEAT_PHASE
#define REPEAT_PHASE -1
#endif
#ifndef REPEAT_SUB
#define REPEAT_SUB 3
#endif
#define NREP(k) ((REPEAT_PHASE == (k)) ? 2 : 1)
#define LAS __attribute__((address_space(3)))
typedef unsigned short bf16_t;
typedef short bf16x8 __attribute__((ext_vector_type(8)));
typedef short s16x4 __attribute__((ext_vector_type(4)));
typedef float f32x4 __attribute__((ext_vector_type(4)));
typedef float f32x2 __attribute__((ext_vector_type(2)));
typedef float f32x16 __attribute__((ext_vector_type(16)));
typedef unsigned u32x4 __attribute__((ext_vector_type(4)));
typedef unsigned u32x2 __attribute__((ext_vector_type(2)));
typedef int i32x4 __attribute__((ext_vector_type(4)));
typedef int i32x8 __attribute__((ext_vector_type(8)));
typedef __bf16 bf16x2_t __attribute__((ext_vector_type(2)));

constexpr int NTOK = 32768, DM = 1024, SEQ = 4096, NBATCH = 8;
constexpr int NP = 2304;
constexpr int Q_OFF = 0, K_OFF = 256, V_OFF = 512, OG_OFF = 1024, CQ_OFF = 1536, CKV_OFF = 1920, KR_OFF = 2176, LR_OFF = 2208;
constexpr int NEXP = 32, ECAP = 32768;
constexpr float EPS = 1e-6f;
constexpr float F8_SH = 4.f, F8_SWGU = 32.f, F8_SHID = 4.f, F8_SWD = 16.f;
constexpr float QSCALE = 0.10206207261596575f * 1.4426950408889634f;

constexpr size_t MiB = 1u << 20;
constexpr size_t WS_CNT = 0;
constexpr size_t WS_FLG = 4096;
constexpr size_t WS_BAR = 128 * 1024;
constexpr size_t WS_GUT = 64 * 1024;
constexpr size_t WS_RS1 = 1 * MiB;
constexpr size_t WS_RS2 = 1 * MiB + 512 * 1024;
constexpr size_t WS_SSQP = 2 * MiB;
constexpr size_t WS_CS = 4 * MiB;
constexpr size_t WS_LTOK = 8 * MiB;
constexpr size_t WS_LGATE = 12 * MiB;
constexpr size_t WS_WIN = 16 * MiB;
constexpr size_t WS_WUQ = 21 * MiB;
constexpr size_t WS_WUKV = 22 * MiB;
constexpr size_t WS_WOUT = 23 * MiB;
constexpr size_t WS_WR = 25 * MiB;
constexpr size_t WS_WGU = 26 * MiB;
constexpr size_t WS_WD = 58 * MiB;
constexpr size_t WS_DEC = 74 * MiB;
constexpr size_t WS_XB = 80 * MiB;
constexpr size_t WS_PROJ = 144 * MiB;
constexpr size_t WS_QB = 288 * MiB;
constexpr size_t WS_KVB = 336 * MiB;
constexpr size_t WS_Y = 400 * MiB;
constexpr size_t WS_SPT = 464 * MiB;
constexpr size_t WS_H8 = WS_KVB;
constexpr size_t WS_LRS2 = 496 * MiB;
constexpr size_t WS_END = 500 * MiB;

struct Params {
  const float* in[21];
  float* out;
  unsigned char* ws;
};

__device__ __forceinline__ unsigned pk2(float lo, float hi) { f32x2 v = {lo, hi}; bf16x2_t b = __builtin_convertvector(v, bf16x2_t); return __builtin_bit_cast(unsigned, b); }
__device__ __forceinline__ float bf2f(unsigned short h) { return __uint_as_float(((unsigned)h) << 16); }
__device__ __forceinline__ float bflo(unsigned w) { return __uint_as_float(w << 16); }
__device__ __forceinline__ float bfhi(unsigned w) { return __uint_as_float(w & 0xffff0000u); }
__device__ __forceinline__ u32x2 pk8_fp8(const f32x4& a, const f32x4& b, float sc) {
  float t[8] = {a[0] * sc, a[1] * sc, a[2] * sc, a[3] * sc, b[0] * sc, b[1] * sc, b[2] * sc, b[3] * sc};
#pragma unroll
  for (int i = 0; i < 8; ++i) t[i] = fminf(fmaxf(t[i], -448.f), 448.f);
  int lo = __builtin_amdgcn_cvt_pk_fp8_f32(t[0], t[1], 0, false); lo = __builtin_amdgcn_cvt_pk_fp8_f32(t[2], t[3], lo, true);
  int hi = __builtin_amdgcn_cvt_pk_fp8_f32(t[4], t[5], 0, false); hi = __builtin_amdgcn_cvt_pk_fp8_f32(t[6], t[7], hi, true);
  u32x2 r; r.x = (unsigned)lo; r.y = (unsigned)hi; return r;
}
__device__ __forceinline__ int perm32(int rho) { const int n = rho >> 4, i = rho & 15; return 8 * (i >> 2) + 4 * n + (i & 3); }
__device__ __forceinline__ float wave_sum(float v) {
#pragma unroll
  for (int o = 1; o < 64; o <<= 1) v += __shfl_xor(v, o);
  return v;
}
#define XCD_BAR_WORDS 3456
#define LDS_WAIT() asm volatile("s_waitcnt lgkmcnt(0)" ::: "memory")
#define LBAR() asm volatile("s_waitcnt lgkmcnt(0)\n\ts_barrier" ::: "memory")

namespace g8 {
constexpr int BM = 256, BK = 64, HALF = 128, HTB = HALF * BK * 2, STAGE_BYTES = 8 * HTB, NXCD = 8, WGM = 8;
__device__ __forceinline__ int lds_byte(int r, int c) { const int st = (r >> 4) * 2 + (c >> 5), rr = r & 15, cc = c & 31, ob = rr * 64 + cc * 2; return st * 1024 + (ob ^ (((ob >> 9) & 1) << 5)); }
__device__ __forceinline__ void stage_rc(int b, int& R, int& C) { const int st = b / 1024, sb = b % 1024, swz = sb ^ (((sb >> 9) & 1) << 5); R = (st >> 1) * 16 + swz / 64; C = (st & 1) * 32 + (swz % 64) / 2; }

struct Unit { const char* A; const char* B; int a, b, c, d; };

template <int F8 = 0  , class Epi, class Sched>
__device__ __forceinline__ void gemm_phase(LAS unsigned char* lds, const int K, const Sched& S, const Epi& E) {
  const int tid = threadIdx.x, wid = __builtin_amdgcn_readfirstlane(tid >> 6), lane = tid & 63, wr = wid >> 2, wc = wid & 3, fr = lane & 15, fq = lane >> 4;
  const int nt = K / BK;
  int R[2], C[2];
#pragma unroll
  for (int i = 0; i < 2; ++i) stage_rc(tid * 16 + i * 8192, R[i], C[i]);
  constexpr bool GA = Sched::GATHER;
  unsigned oB[2], oA[2][2];
  LAS unsigned* onxt = (LAS unsigned*)(lds + STAGE_BYTES + 1024) + tid;
#pragma unroll
  for (int i = 0; i < 2; ++i) oB[i] = (unsigned)(R[i] * S.ldb + C[i]) * 2u;
  const size_t hB = (size_t)HALF * S.ldb * 2, hA = GA ? (size_t)0 : (size_t)HALF * S.lda * 2;
  const size_t kstep = (size_t)(BK * 2);
  const unsigned ldsw = (unsigned)wid * 1024u;
  const int aoff = lds_byte(wr * 64 + fr, fq * 8), boff = lds_byte(wc * 32 + fr, fq * 8);
#define G8_SA(b, h) (((b) * 2 + (h)) * HTB)
#define G8_SB(b, h) ((4 + (b) * 2 + (h)) * HTB)
#define G8_STAGE_X(bufoff, gbase, off2, AUX) do { _Pragma("unroll") for (int _i = 0; _i < 2; ++_i) \
    __builtin_amdgcn_global_load_lds((const unsigned*)((const char*)(gbase) + (off2)[_i]), (LAS unsigned*)(lds + (bufoff) + ldsw + _i * 8192), 16, 0, AUX); } while (0)
#define G8_STAGE(bufoff, gbase, off2) G8_STAGE_X(bufoff, gbase, off2, 0)
#define G8_STAGEA(bufoff, gbase, off2) G8_STAGE_X(bufoff, gbase, off2, (Sched::A_SC1 ? 16 : 0))
#define G8_LD16(off_) (*(const LAS i32x4*)(lds + (off_)))
#define G8_LDA(dst, b, h) do { _Pragma("unroll") for (int m = 0; m < 4; ++m) { \
    if constexpr (F8 == 2) dst##8[m] = __builtin_shufflevector(G8_LD16(G8_SA(b, h) + aoff + m * 2048), G8_LD16(G8_SA(b, h) + aoff + m * 2048 + 1024), 0, 1, 2, 3, 4, 5, 6, 7); \
    else { _Pragma("unroll") for (int k = 0; k < 2; ++k) dst[m][k] = *(const LAS bf16x8*)(lds + G8_SA(b, h) + aoff + m * 2048 + k * 1024); } } } while (0)
#define G8_LDB(dst, b, h) do { _Pragma("unroll") for (int n = 0; n < 2; ++n) { \
    if constexpr (F8 == 2) dst##8[n] = __builtin_shufflevector(G8_LD16(G8_SB(b, h) + boff + n * 2048), G8_LD16(G8_SB(b, h) + boff + n * 2048 + 1024), 0, 1, 2, 3, 4, 5, 6, 7); \
    else { _Pragma("unroll") for (int k = 0; k < 2; ++k) dst[n][k] = *(const LAS bf16x8*)(lds + G8_SB(b, h) + boff + n * 2048 + k * 1024); } } } while (0)
#define G8_MMA(ai, bj, At, Bt) do { __builtin_amdgcn_s_setprio(1); \
    if constexpr (F8 == 2) {   \
      _Pragma("unroll") for (int m = 0; m < 4; ++m) _Pragma("unroll") for (int n = 0; n < 2; ++n) \
        acc[ai][bj][m][n] = __builtin_amdgcn_mfma_scale_f32_16x16x128_f8f6f4(Bt##8[n], At##8[m], acc[ai][bj][m][n], 0, 0, 0, 0x7f7f7f7f, 0, 0x7f7f7f7f); \
    } else if constexpr (F8 == 1) { \
      _Pragma("unroll") for (int m = 0; m < 4; ++m) _Pragma("unroll") for (int n = 0; n < 2; ++n) { \
        const i32x4 b0_ = __builtin_bit_cast(i32x4, Bt[n][0]), b1_ = __builtin_bit_cast(i32x4, Bt[n][1]), a0_ = __builtin_bit_cast(i32x4, At[m][0]), a1_ = __builtin_bit_cast(i32x4, At[m][1]); \
        acc[ai][bj][m][n] = __builtin_amdgcn_mfma_scale_f32_16x16x128_f8f6f4(__builtin_shufflevector(b0_, b1_, 0, 1, 2, 3, 4, 5, 6, 7), __builtin_shufflevector(a0_, a1_, 0, 1, 2, 3, 4, 5, 6, 7), \
                                                                             acc[ai][bj][m][n], 0, 0, 0, 0x7f7f7f7f, 0, 0x7f7f7f7f); } \
    } else { \
      _Pragma("unroll") for (int m = 0; m < 4; ++m) _Pragma("unroll") for (int n = 0; n < 2; ++n) _Pragma("unroll") for (int k = 0; k < 2; ++k) \
        acc[ai][bj][m][n] = __builtin_amdgcn_mfma_f32_16x16x32_bf16(Bt[n][k], At[m][k], acc[ai][bj][m][n], 0, 0, 0); } \
    __builtin_amdgcn_s_setprio(0); } while (0)
#define G8_WAIT_V(n) asm volatile("s_waitcnt vmcnt(" #n ")" ::: "memory")
#define G8_WAIT_L(n) asm volatile("s_waitcnt lgkmcnt(" #n ")" ::: "memory")
#define G8_BAR __builtin_amdgcn_s_barrier()
#define G8_SCHED __builtin_amdgcn_sched_barrier(0)
  Unit cur, nxt; int ui = 0;
  if (!S.next(0, cur)) return;
  S.offs(cur, R, C, oA);
  f32x4 acc[2][2][4][2];
#pragma unroll
  for (int a = 0; a < 2; ++a)
#pragma unroll
    for (int b = 0; b < 2; ++b)
#pragma unroll
      for (int m = 0; m < 4; ++m)
#pragma unroll
        for (int n = 0; n < 2; ++n) acc[a][b][m][n] = (f32x4){0.f, 0.f, 0.f, 0.f};
  bf16x8 At[4][2], B0[2][2], B1[2][2];
  i32x8 At8[4], B08[2], B18[2];
  const char* cA = cur.A; const char* cB = cur.B;
  G8_STAGE(G8_SB(0, 0), cB, oB); G8_STAGE(G8_SB(0, 1), cB + hB, oB); G8_STAGEA(G8_SA(0, 0), cA, oA[0]); G8_STAGEA(G8_SA(0, 1), cA + hA, oA[GA]);
  if (wr == 1) G8_BAR;
  G8_WAIT_V(2); G8_BAR;
  G8_STAGE(G8_SB(1, 0), cB + kstep, oB); G8_STAGEA(G8_SA(1, 0), cA + kstep, oA[0]); G8_STAGE(G8_SB(1, 1), cB + kstep + hB, oB);
  G8_WAIT_V(6); G8_BAR;
  for (;;) {
    const bool has_next = S.next(ui + 1, nxt);
    if (GA && has_next) {
      unsigned oAn[2][2]; S.offs(nxt, R, C, oAn);
#pragma unroll
      for (int h = 0; h < 2; ++h)
#pragma unroll
        for (int i = 0; i < 2; ++i) onxt[(h * 2 + i) * 512] = oAn[h][i];
    }
    const char* nA = has_next ? nxt.A : cA; const char* nB = has_next ? nxt.B : cB;
#pragma unroll 1
    for (int t = 0; t < nt; t += 2) {
      const bool last = (t == nt - 2);
      const char* a1 = cA + (size_t)(t + 1) * kstep;
      const char* a2 = last ? nA : cA + (size_t)(t + 2) * kstep; const char* b2 = last ? nB : cB + (size_t)(t + 2) * kstep;
      const char* a3 = a2 + kstep; const char* b3 = b2 + kstep;
      G8_LDB(B0, 0, 0); G8_LDB(B1, 0, 1); G8_SCHED; G8_LDA(At, 0, 0); G8_STAGEA(G8_SA(1, 1), a1 + hA, oA[GA]);
      G8_WAIT_V(8); G8_WAIT_L(0); G8_BAR; G8_MMA(0, 0, At, B0); G8_MMA(0, 1, At, B1); G8_BAR; G8_SCHED;
      if (GA && last && has_next) {
#pragma unroll
        for (int h = 0; h < 2; ++h)
#pragma unroll
          for (int i = 0; i < 2; ++i) oA[h][i] = onxt[(h * 2 + i) * 512];
      }
      G8_LDA(At, 0, 1); G8_STAGE(G8_SB(0, 0), b2, oB); G8_STAGE(G8_SB(0, 1), b2 + hB, oB); G8_STAGEA(G8_SA(0, 0), a2, oA[0]);
      G8_WAIT_V(8); G8_WAIT_L(0); G8_BAR; G8_MMA(1, 0, At, B0); G8_MMA(1, 1, At, B1); G8_BAR; G8_SCHED;
      G8_LDB(B0, 1, 0); G8_LDB(B1, 1, 1); G8_SCHED; G8_LDA(At, 1, 0); G8_STAGEA(G8_SA(0, 1), a2 + hA, oA[GA]);
      G8_WAIT_V(8); G8_WAIT_L(0); G8_BAR; G8_MMA(0, 0, At, B0); G8_MMA(0, 1, At, B1); G8_BAR; G8_SCHED;
      G8_LDA(At, 1, 1); G8_STAGE(G8_SB(1, 0), b3, oB); G8_STAGE(G8_SB(1, 1), b3 + hB, oB); G8_STAGEA(G8_SA(1, 0), a3, oA[0]);
      G8_WAIT_V(8); G8_WAIT_L(0); G8_BAR; G8_MMA(1, 0, At, B0); G8_MMA(1, 1, At, B1); G8_BAR; G8_SCHED;
    }
    if (wr == 0) G8_BAR;
    E(acc, cur, wr, wc, fr, fq);
    if (!has_next) break;
#pragma unroll
    for (int a = 0; a < 2; ++a)
#pragma unroll
      for (int b = 0; b < 2; ++b)
#pragma unroll
        for (int m = 0; m < 4; ++m)
#pragma unroll
          for (int n = 0; n < 2; ++n) acc[a][b][m][n] = (f32x4){0.f, 0.f, 0.f, 0.f};
    cur = nxt; cA = nA; cB = nB; ++ui;
    if (wr == 1) G8_BAR;
  }
  G8_WAIT_V(0);
  G8_BAR;
#undef G8_SA
#undef G8_SB
#undef G8_STAGE
#undef G8_STAGEA
#undef G8_STAGE_X
#undef G8_LD16
#undef G8_LDA
#undef G8_LDB
#undef G8_MMA
#undef G8_WAIT_V
#undef G8_WAIT_L
#undef G8_BAR
#undef G8_SCHED
}

struct DenseSched {
  static constexpr bool GATHER = false, A_SC1 = false;
  const char* A; const char* B; int lda, ldb; int nM, nN, nwg, G, c;
  __device__ __forceinline__ void init(const void* A_, int lda_, const void* B_, int ldb_, int M, int N, int G_, int c_) {
    A = (const char*)A_; B = (const char*)B_; lda = lda_; ldb = ldb_; nM = M / BM; nN = N / BM; nwg = nM * nN; G = G_; c = c_; }
  __device__ __forceinline__ bool next(int i, Unit& u) const {
    const long L = (long)i * G + c; if (L >= nwg) return false;
    int wgid = (int)L; { const int q = nwg / NXCD, r = nwg % NXCD, xcd = wgid % NXCD, off = wgid / NXCD; wgid = (xcd < r ? xcd * (q + 1) : r * (q + 1) + (xcd - r) * q) + off; }
    const int nig = WGM * nN, gid = wgid / nig, fm = gid * WGM, gsz = (nM - fm) < WGM ? (nM - fm) : WGM;
    const int pm = fm + ((wgid % nig) % gsz), pn = (wgid % nig) / gsz;
    u.a = pm; u.b = pn; u.c = 0; u.d = 0;
    u.A = A + (size_t)pm * BM * lda * 2; u.B = B + (size_t)pn * BM * ldb * 2; return true;
  }
  __device__ __forceinline__ void offs(const Unit&, const int (&R)[2], const int (&C)[2], unsigned (&o)[2][2]) const {
#pragma unroll
    for (int h = 0; h < 2; ++h)
#pragma unroll
      for (int i = 0; i < 2; ++i) o[h][i] = (unsigned)(R[i] * lda + C[i]) * 2u;
  }
};
}

__device__ __forceinline__ u32x4 pack8(const f32x4& a, const f32x4& b) { u32x4 w; w.x = pk2(a[0], a[1]); w.y = pk2(a[2], a[3]); w.z = pk2(b[0], b[1]); w.w = pk2(b[2], b[3]); return w; }

__device__ __forceinline__ __amdgpu_buffer_rsrc_t mk_rsrc(const void* base) { return __builtin_amdgcn_make_buffer_rsrc((void*)base, 0, 0x7fffffff, 0x00020000); }

__device__ __forceinline__ void rope4(f32x4& a, f32x4& b, const f32x2* cs) {
#pragma unroll
  for (int j = 0; j < 4; ++j) { const float c = cs[j].x, s = cs[j].y, x1 = a[j], x2 = b[j]; a[j] = x1 * c - x2 * s; b[j] = x1 * s + x2 * c; }
}

#define EPI_ROW(ri) (((ri) >> 2) * 128 + wr * 64 + ((ri) & 3) * 16 + fr)
#define EPI_FENCE() asm volatile("" ::: "memory")

struct EpiInproj {
  bf16_t* PROJ; const float* rs1; float* ssqp; const f32x2* CS;
  __device__ __forceinline__ void operator()(const f32x4 (&acc)[2][2][4][2], const g8::Unit& u, int wr, int wc, int fr, int fq) const {
    asm volatile("" : "+v"(fr), "+v"(fq));
    const int pm = u.a, pn = u.b;
    const bool cq0 = (pn == 6 || pn == 7), cq1 = (pn == 6), ckv0 = (pn == 8), ckv1 = (pn == 7);
    float rsv[8];
#pragma unroll
    for (int ri = 0; ri < 8; ++ri) rsv[ri] = rs1[pm * 256 + EPI_ROW(ri)];
#pragma unroll
    for (int ri = 0; ri < 8; ++ri) {
      EPI_FENCE();
      const int ai = ri >> 2, m = ri & 3;
      const int row = pm * 256 + EPI_ROW(ri);
      const float rs = rsv[ri];
      float sq = 0.f, skv = 0.f;
#pragma unroll
      for (int bj = 0; bj < 2; ++bj) {
        const int G = 8 * pn + 4 * bj + wc;
        f32x4 v0 = acc[ai][bj][m][0] * rs, v1 = acc[ai][bj][m][1] * rs;
        if (G == 68) {
          f32x2 cs[4];
#pragma unroll
          for (int j = 0; j < 4; ++j) cs[j] = CS[(size_t)row * 16 + 4 * fq + j];
          rope4(v0, v1, cs);
          u32x2 w0, w1; w0.x = pk2(v0[0], v0[1]); w0.y = pk2(v0[2], v0[3]); w1.x = pk2(v1[0], v1[1]); w1.y = pk2(v1[2], v1[3]);
          *(u32x2*)(PROJ + (size_t)row * NP + KR_OFF + 4 * fq) = w0;
          *(u32x2*)(PROJ + (size_t)row * NP + KR_OFF + 16 + 4 * fq) = w1;
        } else {
          *(u32x4*)(PROJ + (size_t)row * NP + 32 * G + 8 * fq) = pack8(v0, v1);
          const float s = (v0[0] * v0[0] + v0[1] * v0[1]) + (v0[2] * v0[2] + v0[3] * v0[3]) + (v1[0] * v1[0] + v1[1] * v1[1]) + (v1[2] * v1[2] + v1[3] * v1[3]);
          if (bj == 0 ? cq0 : cq1) sq += s;
          if (bj == 0 ? ckv0 : ckv1) skv += s;
        }
      }
      if (cq0) { sq += __shfl_xor(sq, 16); sq += __shfl_xor(sq, 32); if (fq == 0) ssqp[(size_t)row * 16 + (pn - 6) * 4 + wc] = sq; }
      if (ckv0 || ckv1) { skv += __shfl_xor(skv, 16); skv += __shfl_xor(skv, 32); if (fq == 0) ssqp[(size_t)row * 16 + 8 + (pn - 7) * 4 + wc] = skv; }
    }
  }
};

struct EpiUq {
  bf16_t* QB; const float* ssqp; const f32x2* CS; bool dry;
  __device__ __forceinline__ void operator()(const f32x4 (&acc)[2][2][4][2], const g8::Unit& u, int wr, int wc, int fr, int fq) const {
    asm volatile("" : "+v"(fr), "+v"(fq));
    const int pm = u.a, pn = u.b;
    const bool rope0 = ((8 * pn + wc) % 3) == 2, rope1 = ((8 * pn + 4 + wc) % 3) == 2;
    f32x4 na, nb;
    { const f32x4* pp = (const f32x4*)(ssqp + (size_t)(pm * 256 + EPI_ROW(0)) * 16); na = pp[0]; nb = pp[1]; }
#pragma unroll
    for (int ri = 0; ri < 8; ++ri) {
      const int ai = ri >> 2, m = ri & 3;
      const int row = pm * 256 + EPI_ROW(ri);
      const f32x4 a = na, b = nb;
      EPI_FENCE();
      if (ri < 7) { const f32x4* pp = (const f32x4*)(ssqp + (size_t)(pm * 256 + EPI_ROW(ri + 1)) * 16); na = pp[0]; nb = pp[1]; }
      const float ss = ((a[0] + a[1]) + (a[2] + a[3])) + ((b[0] + b[1]) + (b[2] + b[3]));
      const float rs = rsqrtf(ss * (1.f / 384.f) + EPS) * QSCALE;
#pragma unroll
      for (int bj = 0; bj < 2; ++bj) {
        const int G = 8 * pn + 4 * bj + wc;
        f32x4 v0 = acc[ai][bj][m][0] * rs, v1 = acc[ai][bj][m][1] * rs;
        if (bj == 0 ? rope0 : rope1) {
          f32x2 cs[4];
#pragma unroll
          for (int j = 0; j < 4; ++j) cs[j] = CS[(size_t)row * 16 + 4 * fq + j];
          rope4(v0, v1, cs);
          u32x2 w0, w1; w0.x = pk2(v0[0], v0[1]); w0.y = pk2(v0[2], v0[3]); w1.x = pk2(v1[0], v1[1]); w1.y = pk2(v1[2], v1[3]);
          if (!dry || w0.x == 0x12345679u) { *(u32x2*)(QB + (size_t)row * 768 + 32 * G + 4 * fq) = w0;
          *(u32x2*)(QB + (size_t)row * 768 + 32 * G + 16 + 4 * fq) = w1; }
        } else {
          { const u32x4 w_ = pack8(v0, v1); if (!dry || w_.x == 0x12345679u) *(u32x4*)(QB + (size_t)row * 768 + 32 * G + 8 * fq) = w_; }
        }
      }
    }
  }
};

struct EpiUkv {
  bf16_t* KVB; const float* ssqp; bool dry;
  __device__ __forceinline__ void operator()(const f32x4 (&acc)[2][2][4][2], const g8::Unit& u, int wr, int wc, int fr, int fq) const {
    asm volatile("" : "+v"(fr), "+v"(fq));
    const int pm = u.a, pn = u.b;
    float rsv[8];
#pragma unroll
    for (int ri = 0; ri < 8; ++ri) { const f32x4* pp = (const f32x4*)(ssqp + (size_t)(pm * 256 + EPI_ROW(ri)) * 16 + 8); const f32x4 a = pp[0], b = pp[1]; rsv[ri] = ((a[0] + a[1]) + (a[2] + a[3])) + ((b[0] + b[1]) + (b[2] + b[3])); }
#pragma unroll
    for (int ri = 0; ri < 8; ++ri) {
      const int ai = ri >> 2, m = ri & 3;
      const int row = pm * 256 + EPI_ROW(ri);
      const float rs = rsqrtf(rsv[ri] * (1.f / 256.f) + EPS);
#pragma unroll
      for (int bj = 0; bj < 2; ++bj) {
        const int G = 8 * pn + 4 * bj + wc;
        { const u32x4 w_ = pack8(acc[ai][bj][m][0] * rs, acc[ai][bj][m][1] * rs); if (!dry || w_.x == 0x12345679u) *(u32x4*)(KVB + (size_t)row * 1024 + 32 * G + 8 * fq) = w_; }
      }
    }
  }
};

struct EpiWout {
  const float* x; bf16_t* HB; unsigned char* H8;
  __device__ __forceinline__ void operator()(const f32x4 (&acc)[2][2][4][2], const g8::Unit& u, int wr, int wc, int fr, int fq) const {
    asm volatile("" : "+v"(fr), "+v"(fq));
    const int pm = u.a, pn = u.b;
#pragma unroll
    for (int half = 0; half < 2; ++half) {
      EPI_FENCE();
      u32x4 xr[4][2];
#pragma unroll
      for (int q = 0; q < 4; ++q) { const int row = pm * 256 + EPI_ROW(half * 4 + q);
#pragma unroll
        for (int bj = 0; bj < 2; ++bj) xr[q][bj] = *(const u32x4*)(HB + (size_t)row * 1024 + 32 * (8 * pn + 4 * bj + wc) + 8 * fq); }
#pragma unroll
      for (int q = 0; q < 4; ++q) {
        const int ri = half * 4 + q, ai = ri >> 2, m = ri & 3;
        const int row = pm * 256 + EPI_ROW(ri);
#pragma unroll
        for (int bj = 0; bj < 2; ++bj) {
          const size_t off = (size_t)row * 1024 + 32 * (8 * pn + 4 * bj + wc) + 8 * fq;
          const u32x4 xw = xr[q][bj];
          const f32x4 x0 = {bflo(xw.x), bfhi(xw.x), bflo(xw.y), bfhi(xw.y)}, x1 = {bflo(xw.z), bfhi(xw.z), bflo(xw.w), bfhi(xw.w)};
          const f32x4 v0 = acc[ai][bj][m][0] + x0, v1 = acc[ai][bj][m][1] + x1;
          *(u32x4*)(HB + off) = pack8(v0, v1);
#if MOE_FP8
          *(u32x2*)(H8 + off) = pk8_fp8(v0, v1, F8_SH);
#endif
        }
      }
    }
  }
};

template <bool GATHER_>
struct MoeSched {
  static constexpr bool GATHER = GATHER_;
  static constexpr bool A_SC1 = !GATHER_;
  const char* A; const char* B; int lda, ldb; int ncol, total, G, c;
  const LAS int* tb; const LAS int* cn; const int* ltok; size_t bstride;
  int n1, r; const int* flg;
  __device__ __forceinline__ bool next(int i, g8::Unit& u) const {
    long L = (long)i * G + c;
    if (!GATHER_ && i >= n1) { if (c < r) return false; L = (long)n1 * G + (long)(i - n1) * (G - r) + (c - r); }
    if (L >= total) return false;
    const int rt = (int)(L / ncol), pn = (int)(L % ncol);
    if (!GATHER_) { unsigned sp_ = 0; while (__hip_atomic_load(flg + rt, __ATOMIC_RELAXED, __HIP_MEMORY_SCOPE_AGENT) < 16) { __builtin_amdgcn_s_sleep(2); if (++sp_ > (1u << 22)) break; } }
    int e = 0;
#pragma unroll 1
    for (int k = 1; k < NEXP; ++k) if (tb[k] <= rt) e = k;
    e = __builtin_amdgcn_readfirstlane(e);
    const int mt = rt - tb[e];
    u.a = e; u.b = mt; u.c = pn; u.d = rt;
    u.B = B + (size_t)e * bstride + (size_t)pn * 256 * ldb * 2;
    u.A = GATHER_ ? A : A + (size_t)rt * 256 * lda * 2;
    return true;
  }
  __device__ __forceinline__ void offs(const g8::Unit& u, const int (&R)[2], const int (&C)[2], unsigned (&o)[2][2]) const {
    if (GATHER_) {
      const int cnt = cn[u.a];
#pragma unroll
      for (int h = 0; h < 2; ++h)
#pragma unroll
        for (int i = 0; i < 2; ++i) { int pos = u.b * 256 + h * 128 + R[i]; pos = pos < cnt ? pos : cnt - 1; const int tok = ltok[u.a * ECAP + pos] >> 1;
          o[h][i] = (unsigned)(tok * lda + C[i]) * 2u; }
    } else {
#pragma unroll
      for (int h = 0; h < 2; ++h)
#pragma unroll
        for (int i = 0; i < 2; ++i) o[h][i] = (unsigned)(R[i] * lda + C[i]) * 2u;
    }
  }
};

struct EpiGU {
  bf16_t* HID; const float* rs2; const int* ltok; const LAS int* cn; bool dry; int* flg;
  __device__ __forceinline__ void operator()(const f32x4 (&acc)[2][2][4][2], const g8::Unit& u, int wr, int wc, int fr, int fq) const {
    asm volatile("" : "+v"(fr), "+v"(fq));
    const int e = u.a, mt = u.b, pn = u.c, rt = u.d; const int cnt = cn[e];
    const __amdgpu_buffer_rsrc_t rsrc = mk_rsrc(HID);
    float rsa[8];
#pragma unroll
    for (int ri = 0; ri < 8; ++ri) { int pos = mt * 256 + EPI_ROW(ri); pos = pos < cnt ? pos : cnt - 1; rsa[ri] = rs2[e * ECAP + pos]; }
#pragma unroll
    for (int half = 0; half < 2; ++half) {
      EPI_FENCE();
#pragma unroll
      for (int q = 0; q < 4; ++q) {
        const int ri = half * 4 + q, ai = ri >> 2, m = ri & 3;
        const int r = EPI_ROW(ri), pos = mt * 256 + r;
        if (pos < cnt) {
          const float rs = rsa[ri] * (MOE_FP8 ? 1.f / (F8_SH * F8_SWGU) : 1.f);
          f32x4 h0, h1;
#pragma unroll
          for (int j = 0; j < 4; ++j) {
            const float g0 = acc[ai][0][m][0][j] * rs, u0 = acc[ai][1][m][0][j] * rs, g1 = acc[ai][0][m][1][j] * rs, u1 = acc[ai][1][m][1][j] * rs;
            h0[j] = g0 / (1.f + __expf(-g0)) * u0; h1[j] = g1 / (1.f + __expf(-g1)) * u1;
          }
#if MOE_FP8
          __builtin_amdgcn_raw_buffer_store_b64(pk8_fp8(h0, h1, F8_SHID), rsrc, (int)((unsigned)((rt * 256 + r) * 256 + pn * 128 + wc * 32 + 8 * fq)), 0, 16);
#else
          { const u32x4 w_ = pack8(h0, h1); if (!dry || w_.x == 0x12345679u) __builtin_amdgcn_raw_buffer_store_b128(w_, rsrc, (int)((unsigned)(((rt * 256 + r) * 256 + pn * 128 + wc * 32 + 8 * fq) * 2)), 0, 16); }
#endif
        }
      }
    }
    asm volatile("s_waitcnt vmcnt(0)" ::: "memory");
    if (fr == 0 && fq == 0) __hip_atomic_fetch_add(flg + rt, 1, __ATOMIC_RELAXED, __HIP_MEMORY_SCOPE_AGENT);
  }
};

struct EpiDown {
  bf16_t* Y2; const int* ltok; const float* lgate; const LAS int* cn; bool dry;
  __device__ __forceinline__ void operator()(const f32x4 (&acc)[2][2][4][2], const g8::Unit& u, int wr, int wc, int fr, int fq) const {
    asm volatile("" : "+v"(fr), "+v"(fq));
    const int e = u.a, mt = u.b, pn = u.c; const int cnt = cn[e];
    int ds[8]; float gv[8];
#pragma unroll
    for (int ri = 0; ri < 8; ++ri) { int pos = mt * 256 + EPI_ROW(ri); pos = pos < cnt ? pos : cnt - 1; ds[ri] = ltok[e * ECAP + pos]; gv[ri] = lgate[e * ECAP + pos]; }
#pragma unroll
    for (int ri = 0; ri < 8; ++ri) {
      const int ai = ri >> 2, m = ri & 3;
      const int pos = mt * 256 + EPI_ROW(ri);
      if (pos < cnt) {
        const float g = gv[ri] * (MOE_FP8 ? 1.f / (F8_SHID * F8_SWD) : 1.f);
#pragma unroll
        for (int bj = 0; bj < 2; ++bj)
          { const u32x4 w_ = pack8(acc[ai][bj][m][0] * g, acc[ai][bj][m][1] * g); if (!dry || w_.x == 0x12345679u) *(u32x4*)(Y2 + (size_t)ds[ri] * 1024 + pn * 256 + wc * 64 + bj * 32 + 8 * fq) = w_; }
      }
    }
  }
};

__device__ __forceinline__ int inproj_src_col(int L) {
  if (L < 1024) return L;
  if (L < 1536) return 1040 + (L - 1024);
  if (L < 1920) return 1552 + (L - 1536);
  if (L < 2176) return 1936 + (L - 1920);
  if (L < 2208) return 2192 + (L - 2176);
  if (L < 2224) return 1024 + (L - 2208);
  return -1;
}
__device__ __forceinline__ void tr_item(const float* src, int ld, int cbase, int nvalid, bool permute, const float* kscale, int k0, bf16_t* dst, int K, LAS float* scr, int lane) {
  if (nvalid > 0) {
    f32x4 v[8];
#pragma unroll
    for (int i = 0; i < 8; ++i) v[i] = *(const f32x4*)(src + (size_t)(k0 + i * 8 + (lane >> 3)) * ld + cbase + (lane & 7) * 4);
#pragma unroll
    for (int i = 0; i < 8; ++i) { const int kk = i * 8 + (lane >> 3); const float sc = kscale ? kscale[k0 + kk] : 1.f; LAS float* w = scr + kk * 33 + (lane & 7) * 4;
      w[0] = v[i].x * sc; w[1] = v[i].y * sc; w[2] = v[i].z * sc; w[3] = v[i].w * sc; }
  }
  LDS_WAIT();
  const int c = lane & 7;
#pragma unroll
  for (int j = 0; j < 4; ++j) { const int n = (lane >> 3) + 8 * j; const int sc_ = permute ? perm32(n) : n; const LAS float* s = scr + (8 * c) * 33 + sc_;
    u32x4 o = {0u, 0u, 0u, 0u};
    if (sc_ < nvalid) { o.x = pk2(s[0 * 33], s[1 * 33]); o.y = pk2(s[2 * 33], s[3 * 33]); o.z = pk2(s[4 * 33], s[5 * 33]); o.w = pk2(s[6 * 33], s[7 * 33]); }
    *(u32x4*)(dst + (size_t)n * K + 8 * c) = o; }
  LDS_WAIT();
}
__device__ __forceinline__ void tr_item8(const float* src, int ld, int cbase, const float* kscale, float gscale, int k0, unsigned char* dst, int K8, LAS float* scr, int lane) {
  f32x4 v[8];
#pragma unroll
  for (int i = 0; i < 8; ++i) v[i] = *(const f32x4*)(src + (size_t)(k0 + i * 8 + (lane >> 3)) * ld + cbase + (lane & 7) * 4);
#pragma unroll
  for (int i = 0; i < 8; ++i) { const int kk = i * 8 + (lane >> 3); const float sc = kscale ? kscale[k0 + kk] : 1.f; LAS float* w = scr + kk * 33 + (lane & 7) * 4;
    w[0] = v[i].x * sc; w[1] = v[i].y * sc; w[2] = v[i].z * sc; w[3] = v[i].w * sc; }
  LDS_WAIT();
  const int c = lane & 7;
#pragma unroll
  for (int j = 0; j < 4; ++j) { const int n = (lane >> 3) + 8 * j; const LAS float* s = scr + (8 * c) * 33 + perm32(n);
    const f32x4 a = {s[0 * 33], s[1 * 33], s[2 * 33], s[3 * 33]}, b = {s[4 * 33], s[5 * 33], s[6 * 33], s[7 * 33]};
    *(u32x2*)(dst + (size_t)n * K8 + 8 * c) = pk8_fp8(a, b, gscale); }
  LDS_WAIT();
}
__device__ __forceinline__ void tr_item_s(const float* src, int ld, int col, const float* kscale, int k0, bf16_t* dst, int K, LAS float* scr, int lane) {
#pragma unroll 8
  for (int i = 0; i < 32; ++i) { const int kk = 2 * i + (lane >> 5); float v = 0.f;
    if (col >= 0) { v = src[(size_t)(k0 + kk) * ld + col]; if (kscale) v *= kscale[k0 + kk]; }
    scr[kk * 33 + (lane & 31)] = v; }
  LDS_WAIT();
  const int c = lane & 7;
#pragma unroll
  for (int j = 0; j < 4; ++j) { const int n = (lane >> 3) + 8 * j; const LAS float* s = scr + (8 * c) * 33 + n;
    u32x4 o; o.x = pk2(s[0 * 33], s[1 * 33]); o.y = pk2(s[2 * 33], s[3 * 33]); o.z = pk2(s[4 * 33], s[5 * 33]); o.w = pk2(s[6 * 33], s[7 * 33]);
    *(u32x4*)(dst + (size_t)n * K + 8 * c) = o; }
  LDS_WAIT();
}

__device__ __forceinline__ void conv_gu_item(const Params& p, int r, LAS float* scr, int lane) {
  const int e = r / 256, kb = (r % 256) / 16, nb = r % 16;
  const int pn = nb >> 3, bj = (nb >> 2) & 1;
  const float* src = (bj ? p.in[18] : p.in[17]) + (size_t)e * 1024 * 256;
#if MOE_FP8
  tr_item8(src, 256, 128 * pn + 32 * (nb & 3), p.in[12], F8_SWGU, kb * 64, p.ws + WS_WGU + ((size_t)e * 512 + nb * 32) * 1024 + kb * 64, 1024, scr, lane);
#else
  tr_item(src, 256, 128 * pn + 32 * (nb & 3), 32, true, p.in[12], kb * 64, (bf16_t*)(p.ws + WS_WGU) + ((size_t)e * 512 + nb * 32) * 1024 + kb * 64, 1024, scr, lane);
#endif
}
__device__ __forceinline__ int glog8(int nb) { return (nb & ~7) + 2 * (nb & 3) + ((nb >> 2) & 1); }
__device__ __forceinline__ void conv_d_item(const Params& p, int r, LAS float* scr, int lane) {
  const int e = r / 128, kb = (r % 128) / 32, nb = r % 32;
#if MOE_FP8
  tr_item8(p.in[19] + (size_t)e * 256 * 1024, 1024, 32 * glog8(nb), nullptr, F8_SWD, kb * 64, p.ws + WS_WD + ((size_t)e * 1024 + nb * 32) * 256 + kb * 64, 256, scr, lane);
#else
  tr_item(p.in[19] + (size_t)e * 256 * 1024, 1024, 32 * glog8(nb), 32, true, nullptr, kb * 64, (bf16_t*)(p.ws + WS_WD) + ((size_t)e * 1024 + nb * 32) * 256 + kb * 64, 256, scr, lane);
#endif
}
constexpr int CONV_GU_P0 = 2048, CONV_GU_P1 = 4096, CONV_GU_P2 = 2048;
constexpr int CONV_D_P1 = 4096;

__device__ __forceinline__ void p0_prologue(const Params& p, LAS unsigned char* lds, int G, int vb) {
  const int tid = threadIdx.x, lane = tid & 63, wave = tid >> 6;
  LAS float* scr = (LAS float*)(lds + wave * 8704);
  const int gw = vb * 8 + wave, NGW = G * 8;
  unsigned char* ws = p.ws;
  const float* attn_nw = p.in[2]; const float* w_in = p.in[3];
  const float* qnw = p.in[7]; const float* w_uq = p.in[8]; const float* kvnw = p.in[9]; const float* w_ukv = p.in[10];
  const float* w_out = p.in[11]; const float* fnw = p.in[12]; const float* rgw = p.in[13]; const float* rew = p.in[15];
  const float* ewg = p.in[17]; const float* ewu = p.in[18]; const float* ewd = p.in[19];
  constexpr int I_IN = 16 * 72, I_UQ = 6 * 24, I_UKV = 4 * 32, I_OUT = 16 * 32, I_R = 16 * 2, I_GU = 32 * 16 * 16, I_D = 32 * 4 * 32;
  const int n = lane & 31;
  const int NITEMS = I_IN + I_UQ + I_UKV + I_OUT + I_R + ((G == 256) ? CONV_GU_P0 : I_GU + I_D);
  auto xconv = [&]() {
    const float* x = p.in[0]; bf16_t* XB = (bf16_t*)(ws + WS_XB); float* rs1 = (float*)(ws + WS_RS1);
    f32x4 v[4], w[4];
    { const int m = gw, m2 = m + NGW;
      const f32x4* xr = (const f32x4*)(x + (size_t)(m < NTOK ? m : 0) * DM) + lane; const f32x4* xr2 = (const f32x4*)(x + (size_t)(m2 < NTOK ? m2 : 0) * DM) + lane;
#pragma unroll
      for (int j = 0; j < 4; ++j) { v[j] = xr[64 * j]; w[j] = xr2[64 * j]; } }
#pragma unroll 1
    for (int m = gw; m < NTOK; m += 2 * NGW) {
      const int m2 = m + NGW; const bool has2 = m2 < NTOK;
      const int mn = m + 2 * NGW, mn2 = mn + NGW;
      f32x4 nv[4], nw[4];
      { const f32x4* xr = (const f32x4*)(x + (size_t)(mn < NTOK ? mn : m) * DM) + lane; const f32x4* xr2 = (const f32x4*)(x + (size_t)(mn2 < NTOK ? mn2 : m) * DM) + lane;
#pragma unroll
        for (int j = 0; j < 4; ++j) { nv[j] = xr[64 * j]; nw[j] = xr2[64 * j]; } }
      float s = 0.f, s2 = 0.f;
#pragma unroll
      for (int j = 0; j < 4; ++j) { s += (v[j].x * v[j].x + v[j].y * v[j].y) + (v[j].z * v[j].z + v[j].w * v[j].w); s2 += (w[j].x * w[j].x + w[j].y * w[j].y) + (w[j].z * w[j].z + w[j].w * w[j].w); }
      s = wave_sum(s); s2 = wave_sum(s2);
      if (lane == 0) { rs1[m] = rsqrtf(s * (1.f / DM) + EPS); if (has2) rs1[m2] = rsqrtf(s2 * (1.f / DM) + EPS); }
      u32x2* o8 = (u32x2*)(XB + (size_t)m * DM) + lane; u32x2* o82 = (u32x2*)(XB + (size_t)m2 * DM) + lane;
#pragma unroll
      for (int j = 0; j < 4; ++j) { u32x2 q; q.x = pk2(v[j].x, v[j].y); q.y = pk2(v[j].z, v[j].w); o8[64 * j] = q; }
      if (has2) {
#pragma unroll
        for (int j = 0; j < 4; ++j) { u32x2 q; q.x = pk2(w[j].x, w[j].y); q.y = pk2(w[j].z, w[j].w); o82[64 * j] = q; }
      }
#pragma unroll
      for (int j = 0; j < 4; ++j) { v[j] = nv[j]; w[j] = nw[j]; }
    }
  };
  auto wconv = [&]() {
  for (int it = gw; it < NITEMS; it += NGW) {
    int r = it;
    if (r < I_IN) { const int kb = r / 72, nb = r % 72; const int c0 = inproj_src_col(32 * nb); const int nv = (nb < 69) ? 32 : (nb == 69 ? 16 : 0);
      tr_item(w_in, 2224, c0 < 0 ? 0 : c0, nv, nb != 68, attn_nw, kb * 64, (bf16_t*)(ws + WS_WIN) + (size_t)(nb * 32) * 1024 + kb * 64, 1024, scr, lane); continue; }
    r -= I_IN;
    if (r < I_UQ) { const int kb = r / 24, nb = r % 24;
      tr_item(w_uq, 768, 32 * nb, 32, (nb % 3) != 2, qnw, kb * 64, (bf16_t*)(ws + WS_WUQ) + (size_t)(nb * 32) * 384 + kb * 64, 384, scr, lane); continue; }
    r -= I_UQ;
    if (r < I_UKV) { const int kb = r / 32, nb = r % 32;
      tr_item(w_ukv, 1024, 32 * nb, 32, true, kvnw, kb * 64, (bf16_t*)(ws + WS_WUKV) + (size_t)(nb * 32) * 256 + kb * 64, 256, scr, lane); continue; }
    r -= I_UKV;
    if (r < I_OUT) { const int kb = r / 32, nb = r % 32;
      tr_item(w_out, 1024, 32 * nb, 32, true, nullptr, kb * 64, (bf16_t*)(ws + WS_WOUT) + (size_t)(nb * 32) * 1024 + kb * 64, 1024, scr, lane); continue; }
    r -= I_OUT;
    if (r < I_R) { const int kb = r / 2, nb = r % 2; const int Rr = nb * 32 + n;
      const float* src = (Rr < 4) ? rgw : rew; const int ld = (Rr < 4) ? 4 : 32; const int col = (Rr < 4) ? Rr : (Rr < 36 ? Rr - 4 : -1);
      tr_item_s(src, ld, col, fnw, kb * 64, (bf16_t*)(ws + WS_WR) + (size_t)(nb * 32) * 1024 + kb * 64, 1024, scr, lane); continue; }
    r -= I_R;
    if (r < I_GU) { conv_gu_item(p, r, scr, lane); continue; }
    r -= I_GU;
    conv_d_item(p, r, scr, lane);
  }
  };
  if (wave & 1) { xconv(); wconv(); } else { wconv(); xconv(); }
  const int gt = vb * 512 + tid, NGT = G * 512;
  const int* pos = (const int*)p.in[1]; f32x2* CS = (f32x2*)(ws + WS_CS);
  for (int i = gt; i < NTOK * 16; i += NGT) {
    const int row = i >> 4, f = i & 15;
    const float inv = powf(10000.0f, -(float)f / 16.0f);
    const float ang = (float)pos[row] * inv;
    CS[i] = (f32x2){(float)cos((double)ang), (float)sin((double)ang)};
  }
  if (gt < NEXP) ((int*)(ws + WS_CNT))[gt] = 0;
  if (gt < 512) ((int*)(ws + WS_FLG))[gt] = 0;
  if (gt < 4096) { const int dd = gt >> 4, rr = gt & 15; ((bf16_t*)(ws + WS_GUT))[gt] = (bf16_t)(pk2(p.in[4][rr * 256 + dd], 0.f) & 0xffffu); }
#if !ENABLE_GLA || !ENABLE_MLA
  { u32x4* Y = (u32x4*)(ws + WS_Y); for (int i = gt; i < NTOK * 1024 / 8; i += NGT) Y[i] = (u32x4){0u, 0u, 0u, 0u}; }
#endif
}

constexpr int AT_KSTR = 208;
constexpr int AT_KBUF = 64 * AT_KSTR, AT_VBUF = 8192;
constexpr int AT_KOFF = 0, AT_VOFF = 2 * AT_KBUF;
typedef short v4i16_t __attribute__((ext_vector_type(4)));
__device__ __forceinline__ s16x4 vtr(const LAS unsigned char* p) { return __builtin_bit_cast(s16x4, __builtin_amdgcn_ds_read_tr16_b64_v4i16((LAS v4i16_t*)p)); }

template <bool DO_NEXT>
__device__ __forceinline__ void attn_step(const LAS unsigned char* Kn, const LAS unsigned char* Vc, const bf16x8 (&qf)[6], f32x16& pc0, f32x16& pc1, f32x16& pn0, f32x16& pn1,
                                          f32x16& o0, f32x16& o1, float& mrun, float& lrun, const bool first, const bool diag, const int kb, const int qabs, const int r32, const int hi, const int voffl) {
  const LAS unsigned char* Kb = Kn + r32 * AT_KSTR + hi * 16;
  bf16x8 kf[6];
#pragma unroll
  for (int d0 = 0; d0 < 3; ++d0) { kf[2 * d0] = *(const LAS bf16x8*)(Kb + d0 * 32); kf[2 * d0 + 1] = *(const LAS bf16x8*)(Kb + 32 * AT_KSTR + d0 * 32); }
  __builtin_amdgcn_sched_barrier(0);
  if (diag) {
#pragma unroll
    for (int r = 0; r < 16; ++r) { const int kv = kb + 4 * hi + (r & 3) + 8 * (r >> 2); if (kv > qabs) pc0[r] = -INFINITY; if (kv + 32 > qabs) pc1[r] = -INFINITY; }
  }
  float ma = fmaxf(fmaxf(pc0[0], pc0[1]), pc1[0]), mb = fmaxf(fmaxf(pc0[2], pc0[3]), pc1[1]);
  ma = fmaxf(fmaxf(ma, pc1[2]), pc1[3]);
#pragma unroll
  for (int r = 4; r < 16; r += 4) { ma = fmaxf(fmaxf(ma, pc0[r]), pc0[r + 1]); mb = fmaxf(fmaxf(mb, pc0[r + 2]), pc0[r + 3]); ma = fmaxf(fmaxf(ma, pc1[r]), pc1[r + 1]); mb = fmaxf(fmaxf(mb, pc1[r + 2]), pc1[r + 3]); }
  float mt = fmaxf(ma, mb);
  { auto rr = __builtin_amdgcn_permlane32_swap(__float_as_uint(mt), __float_as_uint(mt), false, false); mt = fmaxf(__uint_as_float(rr[0]), __uint_as_float(rr[1])); }
  if (first || __any(mt > 8.0f)) {
    const float dl = first ? mt : fmaxf(mt, 0.f);
    mrun += dl;
    const float alpha = __builtin_amdgcn_exp2f(-dl);
    lrun *= alpha;
#pragma unroll
    for (int r = 0; r < 16; ++r) { pc0[r] -= dl; pc1[r] -= dl; o0[r] *= alpha; o1[r] *= alpha; }
  }
  const LAS unsigned char* Vb = Vc + voffl;
  f32x16 negm;
#pragma unroll
  for (int r = 0; r < 16; ++r) negm[r] = -mrun;
  if (DO_NEXT) {
#pragma unroll
    for (int d0 = 0; d0 < 3; ++d0) {
      pn0 = __builtin_amdgcn_mfma_f32_32x32x16_bf16(kf[2 * d0], qf[d0], d0 ? pn0 : negm, 0, 0, 0);
      pn1 = __builtin_amdgcn_mfma_f32_32x32x16_bf16(kf[2 * d0 + 1], qf[d0], d0 ? pn1 : negm, 0, 0, 0);
    }
  }
  __builtin_amdgcn_sched_barrier(0);
#pragma unroll
  for (int d0 = 3; d0 < 6; ++d0) { kf[2 * (d0 - 3)] = *(const LAS bf16x8*)(Kb + d0 * 32); kf[2 * (d0 - 3) + 1] = *(const LAS bf16x8*)(Kb + 32 * AT_KSTR + d0 * 32); }
  s16x4 vl[4], vh[4];
#pragma unroll
  for (int ks = 0; ks < 2; ++ks) { vl[2 * ks] = vtr(Vb + ks * 1024); vh[2 * ks] = vtr(Vb + ks * 1024 + 512); vl[2 * ks + 1] = vtr(Vb + 4096 + ks * 1024); vh[2 * ks + 1] = vtr(Vb + 4096 + ks * 1024 + 512); }
  __builtin_amdgcn_sched_barrier(0);
#pragma unroll
  for (int r = 0; r < 16; ++r) { pc0[r] = __builtin_amdgcn_exp2f(pc0[r]); pc1[r] = __builtin_amdgcn_exp2f(pc1[r]); }
  if (DO_NEXT) {
#pragma unroll
    for (int d0 = 3; d0 < 6; ++d0) {
      pn0 = __builtin_amdgcn_mfma_f32_32x32x16_bf16(kf[2 * (d0 - 3)], qf[d0], pn0, 0, 0, 0);
      pn1 = __builtin_amdgcn_mfma_f32_32x32x16_bf16(kf[2 * (d0 - 3) + 1], qf[d0], pn1, 0, 0, 0);
    }
  }
  float sacc = pc0[0] + pc1[0];
#pragma unroll
  for (int r = 1; r < 16; ++r) { sacc += pc0[r]; sacc += pc1[r]; if ((r & 1) == 1) asm volatile("" : "+v"(sacc)); }
  lrun += sacc;
  u32x4 pw[4];
#pragma unroll
  for (int s = 0; s < 2; ++s) {
    pw[s] = (u32x4){pk2(pc0[8 * s + 0], pc0[8 * s + 1]), pk2(pc0[8 * s + 2], pc0[8 * s + 3]), pk2(pc0[8 * s + 4], pc0[8 * s + 5]), pk2(pc0[8 * s + 6], pc0[8 * s + 7])};
    pw[2 + s] = (u32x4){pk2(pc1[8 * s + 0], pc1[8 * s + 1]), pk2(pc1[8 * s + 2], pc1[8 * s + 3]), pk2(pc1[8 * s + 4], pc1[8 * s + 5]), pk2(pc1[8 * s + 6], pc1[8 * s + 7])};
  }
  s16x4 wl[4], wh[4];
#pragma unroll
  for (int ks = 2; ks < 4; ++ks) { wl[2 * (ks - 2)] = vtr(Vb + ks * 1024); wh[2 * (ks - 2)] = vtr(Vb + ks * 1024 + 512); wl[2 * (ks - 2) + 1] = vtr(Vb + 4096 + ks * 1024); wh[2 * (ks - 2) + 1] = vtr(Vb + 4096 + ks * 1024 + 512); }
  __builtin_amdgcn_sched_barrier(0);
#pragma unroll
  for (int ks = 0; ks < 2; ++ks) {
    const bf16x8 vf0 = {vl[2 * ks][0], vl[2 * ks][1], vl[2 * ks][2], vl[2 * ks][3], vh[2 * ks][0], vh[2 * ks][1], vh[2 * ks][2], vh[2 * ks][3]};
    const bf16x8 vf1 = {vl[2 * ks + 1][0], vl[2 * ks + 1][1], vl[2 * ks + 1][2], vl[2 * ks + 1][3], vh[2 * ks + 1][0], vh[2 * ks + 1][1], vh[2 * ks + 1][2], vh[2 * ks + 1][3]};
    const bf16x8 pf = __builtin_bit_cast(bf16x8, pw[ks]);
    o0 = __builtin_amdgcn_mfma_f32_32x32x16_bf16(vf0, pf, o0, 0, 0, 0);
    o1 = __builtin_amdgcn_mfma_f32_32x32x16_bf16(vf1, pf, o1, 0, 0, 0);
  }
#pragma unroll
  for (int ks = 2; ks < 4; ++ks) { const int q = 2 * (ks - 2);
    const bf16x8 vf0 = {wl[q][0], wl[q][1], wl[q][2], wl[q][3], wh[q][0], wh[q][1], wh[q][2], wh[q][3]};
    const bf16x8 vf1 = {wl[q + 1][0], wl[q + 1][1], wl[q + 1][2], wl[q + 1][3], wh[q + 1][0], wh[q + 1][1], wh[q + 1][2], wh[q + 1][3]};
    const bf16x8 pf = __builtin_bit_cast(bf16x8, pw[ks]);
    o0 = __builtin_amdgcn_mfma_f32_32x32x16_bf16(vf0, pf, o0, 0, 0, 0);
    o1 = __builtin_amdgcn_mfma_f32_32x32x16_bf16(vf1, pf, o1, 0, 0, 0);
  }
}
__device__ __forceinline__ void attn_qk0(const LAS unsigned char* Kt, const bf16x8 (&qf)[6], f32x16& p0, f32x16& p1, const int r32, const int hi) {
  const LAS unsigned char* Kb = Kt + r32 * AT_KSTR + hi * 16;
  const f32x16 z = {};
#pragma unroll
  for (int d0 = 0; d0 < 6; ++d0) {
    const bf16x8 a0 = *(const LAS bf16x8*)(Kb + d0 * 32), a1 = *(const LAS bf16x8*)(Kb + 32 * AT_KSTR + d0 * 32);
    p0 = __builtin_amdgcn_mfma_f32_32x32x16_bf16(a0, qf[d0], d0 ? p0 : z, 0, 0, 0);
    p1 = __builtin_amdgcn_mfma_f32_32x32x16_bf16(a1, qf[d0], d0 ? p1 : z, 0, 0, 0);
  }
}

template <int MODE>
__device__ __forceinline__ void attn_unit(const Params& p, LAS unsigned char* lds, int b, int h, int qb) {
  int tid_ = threadIdx.x; asm volatile("" : "+v"(tid_));
  const int tid = tid_, lane = tid & 63, r32 = lane & 31, hi = lane >> 5; const int wid = __builtin_amdgcn_readfirstlane(tid >> 6);
  const bf16_t* QB = (const bf16_t*)(p.ws + WS_QB); const bf16_t* KVB = (const bf16_t*)(p.ws + WS_KVB); const bf16_t* PROJ = (const bf16_t*)(p.ws + WS_PROJ);
  bf16_t* Y = (bf16_t*)(p.ws + WS_Y);
  const size_t rowbase = (size_t)b * SEQ; const int q0 = qb * 256;
  bf16x8 qf[6];
  { const bf16_t* qrow = QB + (rowbase + q0 + wid * 32 + r32) * 768 + h * 96 + hi * 8;
#pragma unroll
    for (int d0 = 0; d0 < 6; ++d0) qf[d0] = *(const bf16x8*)(qrow + d0 * 16); }
  f32x16 o0 = {}, o1 = {}; float mrun = 0.f, lrun = 0.f;
  const int NT = 4 * (qb + 1);
  const int id0 = tid, id1 = (tid < 256) ? tid + 512 : tid;
  const int kv0 = id0 / 12, c0 = id0 % 12, kv1 = id1 / 12, c1 = id1 % 12;
  const bf16_t* ks0 = (c0 < 8) ? KVB + (rowbase + kv0) * 1024 + h * 128 + c0 * 8 : PROJ + (rowbase + kv0) * NP + KR_OFF + (c0 - 8) * 8;
  const size_t kstr0 = (c0 < 8) ? (size_t)64 * 1024 : (size_t)64 * NP;
  const bf16_t* ks1 = (c1 < 8) ? KVB + (rowbase + kv1) * 1024 + h * 128 + c1 * 8 : PROJ + (rowbase + kv1) * NP + KR_OFF + (c1 - 8) * 8;
  const size_t kstr1 = (c1 < 8) ? (size_t)64 * 1024 : (size_t)64 * NP;
  const int kd0 = kv0 * AT_KSTR + c0 * 16, kd1 = kv1 * AT_KSTR + c1 * 16;
  const int vkv = tid >> 3, vc = tid & 7;
  const bf16_t* vs = KVB + (rowbase + vkv) * 1024 + h * 128 + 64 + vc * 8;
  const int vd = (vc >> 2) * 4096 + vkv * 64 + (vc & 3) * 16;
  u32x4 kA0 = {}, kA1 = {}, vA = {}, kB0 = {}, kB1 = {}, vB = {};
#define AT_LOADK(K0, K1, u) do { if (MODE == 2) break; const int u_ = (MODE == 1) ? 0 : ((u) < NT ? (u) : NT - 1); K0 = *(const u32x4*)(ks0 + (size_t)u_ * kstr0); K1 = *(const u32x4*)(ks1 + (size_t)u_ * kstr1); } while (0)
#define AT_LOADV(V, u) do { if (MODE == 2) break; const int u_ = (MODE == 1) ? 0 : ((u) < NT ? (u) : NT - 1); V = *(const u32x4*)(vs + (size_t)u_ * 64 * 1024); } while (0)
#define AT_STOREK(K0, K1, buf) do { *(LAS u32x4*)(lds + AT_KOFF + (buf) * AT_KBUF + kd0) = K0; *(LAS u32x4*)(lds + AT_KOFF + (buf) * AT_KBUF + kd1) = K1; } while (0)
#define AT_STOREV(V, buf) do { *(LAS u32x4*)(lds + AT_VOFF + (buf) * AT_VBUF + vd) = V; } while (0)
  AT_LOADK(kA0, kA1, 0); AT_LOADV(vA, 0); AT_LOADK(kB0, kB1, 1);
  AT_STOREK(kA0, kA1, 0); AT_STOREV(vA, 0); AT_STOREK(kB0, kB1, 1);
  AT_LOADK(kA0, kA1, 2); AT_LOADV(vB, 1); AT_LOADK(kB0, kB1, 3); AT_LOADV(vA, 2);
  LBAR();
  const int qabs = q0 + wid * 32 + r32;
  const int voffl = ((lane >> 4) & 1) * 32 + (lane & 3) * 8 + (4 * hi + ((lane & 15) >> 2)) * 64;
  const int wlast = q0 + wid * 32 + 31;
  f32x16 pa0, pa1, pb0, pb1;
  if (wid >= 4) __builtin_amdgcn_s_setprio(1);
  attn_qk0(lds + AT_KOFF, qf, pa0, pa1, r32, hi);
  LBAR();
#pragma unroll 1
  for (int t = 0; t < NT; t += 2) {
    if (MODE != 3 && t * 64 <= wlast) {
      attn_step<true>(lds + AT_KOFF + AT_KBUF, lds + AT_VOFF, qf, pa0, pa1, pb0, pb1, o0, o1, mrun, lrun, t == 0, t >= NT - 4, t * 64, qabs, r32, hi, voffl);
    }
    AT_STOREK(kA0, kA1, 0); AT_STOREV(vB, 1);
    AT_LOADK(kA0, kA1, t + 4); AT_LOADV(vB, t + 3);
    LBAR();
    if (MODE != 3 && (t + 1) * 64 <= wlast) {
      attn_step<true>(lds + AT_KOFF, lds + AT_VOFF + AT_VBUF, qf, pb0, pb1, pa0, pa1, o0, o1, mrun, lrun, false, t + 1 >= NT - 4, (t + 1) * 64, qabs, r32, hi, voffl);
    }
    AT_STOREK(kB0, kB1, 1); AT_STOREV(vA, 0);
    AT_LOADK(kB0, kB1, t + 5); AT_LOADV(vA, t + 4);
    LBAR();
  }
#undef AT_LOADK
#undef AT_LOADV
#undef AT_STOREK
#undef AT_STOREV
  __builtin_amdgcn_s_setprio(0);
  lrun += __shfl_xor(lrun, 32);
  const float inv = 1.f / lrun;
  bf16_t* dst = Y + (rowbase + q0 + wid * 32 + r32) * 1024 + 512 + h * 64 + 4 * hi;
#pragma unroll
  for (int g = 0; g < 4; ++g) {
    u32x2 w0, w1; w0.x = pk2(o0[4 * g] * inv, o0[4 * g + 1] * inv); w0.y = pk2(o0[4 * g + 2] * inv, o0[4 * g + 3] * inv);
    w1.x = pk2(o1[4 * g] * inv, o1[4 * g + 1] * inv); w1.y = pk2(o1[4 * g + 2] * inv, o1[4 * g + 3] * inv);
    if (MODE == 0 || w0.x == 0x12345679u) { *(u32x2*)(dst + 8 * g) = w0; *(u32x2*)(dst + 32 + 8 * g) = w1; }
  }
}

template <int MODE>
__device__ __forceinline__ void attn_phase(const Params& p, LAS unsigned char* lds, int G, int vb) {
  if (G == 256) {
    const int bh = vb >> 2, s = vb & 3;
#pragma unroll 1
    for (int i = 0; i < 4; ++i) { const int qb = (i == 0) ? 15 - s : (i == 1) ? 8 + s : (i == 2) ? 7 - s : s; attn_unit<MODE>(p, lds, bh >> 3, bh & 7, qb); }
  } else {
#pragma unroll 1
    for (int u = vb; u < 1024; u += G) { const int qb = 15 - (u >> 6), bh = u & 63; attn_unit<MODE>(p, lds, bh >> 3, bh & 7, qb); }
  }
}

constexpr int GL_BC = 0;
constexpr int GL_QE = 17408;
constexpr int GL_KE = 26624;
constexpr int GL_KD = 35840;
constexpr int GL_V = 44032;
constexpr int GL_ST = 60416;
constexpr int GL_RED = 78848;
constexpr int GL_TOT = 80896;
__device__ __forceinline__ int crow(int r, int hi) { return (r & 3) + 8 * (r >> 2) + 4 * hi; }

__device__ __forceinline__ void gla_gates_mfma(const bf16x8 lrA, const bf16x8 guB, const float bias_d, LAS float* bc, LAS float* tot0, int dt, int jt, int r32, int hi) {
  const f32x16 zero = {};
  const f32x16 z = __builtin_amdgcn_mfma_f32_32x32x16_bf16(lrA, guB, zero, 0, 0, 0);
  float la[16];
#pragma unroll
  for (int r = 0; r < 16; ++r) { const float zz = z[r] + bias_d; la[r] = (fminf(zz, 0.f) - __logf(1.f + __expf(-fabsf(zz)))) * (1.f / 16.f); }
  float s[4], o[4];
#pragma unroll
  for (int g = 0; g < 4; ++g) { la[4 * g + 1] += la[4 * g]; la[4 * g + 2] += la[4 * g + 1]; la[4 * g + 3] += la[4 * g + 2]; s[g] = la[4 * g + 3]; }
#pragma unroll
  for (int g = 0; g < 4; ++g) { auto rr = __builtin_amdgcn_permlane32_swap(__float_as_uint(s[g]), __float_as_uint(s[g]), false, false); o[g] = __uint_as_float(hi ? rr[0] : rr[1]); }
  float off = 0.f;
#pragma unroll
  for (int g = 0; g < 4; ++g) { const float add = off + (hi ? o[g] : 0.f);
#pragma unroll
    for (int q = 0; q < 4; ++q) la[4 * g + q] += add;
    off += s[g] + o[g]; }
#pragma unroll
  for (int r = 0; r < 16; ++r) bc[(32 * jt + crow(r, hi)) * 68 + 32 * dt + r32] = la[r];
  if (jt == 0 && hi == 0) tot0[32 * dt + r32] = off;
}

__device__ __forceinline__ bf16x8 trfrag(const LAS unsigned char* p, int off_lo, int off_hi) {
  const s16x4 l = vtr(p + off_lo), h = vtr(p + off_hi);
  return (bf16x8){l[0], l[1], l[2], l[3], h[0], h[1], h[2], h[3]};
}

__device__ __forceinline__ void gla_a_phase(const Params& p, LAS unsigned char* lds, int G, int vb) {
  const int tid = threadIdx.x, lane = tid & 63, r32 = lane & 31, hi = lane >> 5; const int wid = __builtin_amdgcn_readfirstlane(tid >> 6);
  const bf16_t* PROJ = (const bf16_t*)(p.ws + WS_PROJ); const bf16_t* GUT = (const bf16_t*)(p.ws + WS_GUT);
  bf16_t* UPD = (bf16_t*)(p.ws + WS_Y); float* DEC = (float*)(p.ws + WS_DEC); const float* gbias = p.in[5];
  LAS float* bc = (LAS float*)(lds + GL_BC);
  const int j = tid >> 3, c = tid & 7;
  u32x4 kq, v0, v1, lr0 = {}, gub = {}; float gbs = 0.f;
  LAS float* tot0 = (LAS float*)(lds + GL_TOT);
#define GLA_A_LOAD(item_) do { const int n_ = (item_) & 63, bh_ = (item_) >> 6, h_ = bh_ & 3, b_ = bh_ >> 2; const size_t r0_ = (size_t)b_ * SEQ + n_ * 64; \
    if (wid < 4) { lr0 = *(const u32x4*)(PROJ + (r0_ + 32 * (wid >> 1) + r32) * NP + LR_OFF + 8 * hi); \
      gub = *(const u32x4*)(GUT + (h_ * 64 + 32 * (wid & 1) + r32) * 16 + 8 * hi); gbs = gbias[h_ * 64 + 32 * (wid & 1) + r32]; } \
    kq = *(const u32x4*)(PROJ + (r0_ + j) * NP + K_OFF + h_ * 64 + c * 8); \
    v0 = *(const u32x4*)(PROJ + (r0_ + (tid >> 4)) * NP + V_OFF + h_ * 128 + (tid & 15) * 8); \
    v1 = *(const u32x4*)(PROJ + (r0_ + 32 + (tid >> 4)) * NP + V_OFF + h_ * 128 + (tid & 15) * 8); } while (0)
  int item = vb;
  if (item < 2048) GLA_A_LOAD(item);
#pragma unroll 1
  for (; item < 2048; item += G) {
    if (wid < 4) gla_gates_mfma(__builtin_bit_cast(bf16x8, lr0), __builtin_bit_cast(bf16x8, gub), gbs, bc, tot0, wid & 1, wid >> 1, r32, hi);
    LBAR();
    {
      const unsigned kk[4] = {kq.x, kq.y, kq.z, kq.w}; float kd[8];
#pragma unroll
      for (int i = 0; i < 8; ++i) { const int d = c * 8 + i; const float kv = (i & 1) ? bfhi(kk[i >> 1]) : bflo(kk[i >> 1]); const float t0 = tot0[d];
        kd[i] = kv * __expf((bc[63 * 68 + d] + t0) - (bc[j * 68 + d] + (j >= 32 ? t0 : 0.f))); }
      *(LAS u32x4*)(lds + GL_KD + (c >> 2) * 4096 + j * 64 + (c & 3) * 16) = (u32x4){pk2(kd[0], kd[1]), pk2(kd[2], kd[3]), pk2(kd[4], kd[5]), pk2(kd[6], kd[7])};
      const int jj = tid >> 4, cc = tid & 15;
      *(LAS u32x4*)(lds + GL_V + (cc >> 2) * 4096 + jj * 64 + (cc & 3) * 16) = v0;
      *(LAS u32x4*)(lds + GL_V + (cc >> 2) * 4096 + (32 + jj) * 64 + (cc & 3) * 16) = v1;
      if (tid < 64) DEC[(size_t)item * 64 + tid] = __expf(bc[63 * 68 + tid] + tot0[tid]);
    }
    if (item + G < 2048) GLA_A_LOAD(item + G);
    LBAR();
    { const int vt = wid >> 1, dt = wid & 1; f32x16 acc = {};
      const int lo = ((lane >> 4) & 1) * 32 + (lane & 3) * 8 + (8 * hi + ((lane & 15) >> 2)) * 64;
#pragma unroll
      for (int ks = 0; ks < 4; ++ks) {
        const bf16x8 a = trfrag(lds + GL_V + vt * 4096, lo + ks * 1024, lo + ks * 1024 + 256);
        const bf16x8 bb = trfrag(lds + GL_KD + dt * 4096, lo + ks * 1024, lo + ks * 1024 + 256);
        acc = __builtin_amdgcn_mfma_f32_32x32x16_bf16(a, bb, acc, 0, 0, 0);
      }
      bf16_t* dst = UPD + (size_t)item * 8192 + 32 * dt + r32;
#pragma unroll
      for (int r = 0; r < 16; ++r) dst[(size_t)(32 * vt + crow(r, hi)) * 64] = (bf16_t)(pk2(acc[r], 0.f) & 0xffffu);
    }
  }
  LBAR();
#undef GLA_A_LOAD
}

__device__ __forceinline__ void gla_scan(const Params& p, int G, int vb) {
  const bf16_t* UPD = (const bf16_t*)(p.ws + WS_Y); const float* DEC = (const float*)(p.ws + WS_DEC); bf16_t* SPT = (bf16_t*)(p.ws + WS_SPT);
  for (int idx = vb * 512 + threadIdx.x; idx < 32 * 4096; idx += G * 512) {
    const int bh = idx >> 12, vd = (idx & 4095) * 2, d = vd & 63;
    float S0 = 0.f, S1 = 0.f;
#pragma unroll 16
    for (int n = 0; n < 64; ++n) { const size_t item = (size_t)bh * 64 + n;
      const unsigned uw = *(const unsigned*)(UPD + item * 8192 + vd); const f32x2 dc = *(const f32x2*)(DEC + item * 64 + d);
      *(unsigned*)(SPT + item * 8192 + vd) = pk2(S0, S1); S0 = dc.x * S0 + bflo(uw); S1 = dc.y * S1 + bfhi(uw); }
  }
}

__device__ __forceinline__ void gla_scan_block(const Params& p, LAS unsigned char* lds, int bh) {
  const bf16_t* UPD = (const bf16_t*)(p.ws + WS_Y); const float* DEC = (const float*)(p.ws + WS_DEC); bf16_t* SPT = (bf16_t*)(p.ws + WS_SPT);
  const int tid = threadIdx.x, d8 = tid & 7;
  LAS float* dl = (LAS float*)lds;
  for (int i = tid; i < 1024; i += 512) *(LAS f32x4*)(dl + 4 * i) = *(const f32x4*)(DEC + (size_t)bh * 4096 + 4 * i);
  __syncthreads();
  const size_t base = (size_t)bh * 64 * 8192 + (size_t)tid * 8;
  f32x4 S[4] = {};
#pragma unroll 1
  for (int n0 = 0; n0 < 64; n0 += 8) {
    u32x4 u[8][2];
#pragma unroll
    for (int k = 0; k < 8; ++k) { u[k][0] = *(const u32x4*)(UPD + base + (size_t)(n0 + k) * 8192); u[k][1] = *(const u32x4*)(UPD + base + (size_t)(n0 + k) * 8192 + 4096); }
#pragma unroll
    for (int k = 0; k < 8; ++k) {
      const f32x4 da = *(LAS f32x4*)(dl + (n0 + k) * 64 + d8 * 8), db = *(LAS f32x4*)(dl + (n0 + k) * 64 + d8 * 8 + 4);
      *(u32x4*)(SPT + base + (size_t)(n0 + k) * 8192) = pack8(S[0], S[1]);
      *(u32x4*)(SPT + base + (size_t)(n0 + k) * 8192 + 4096) = pack8(S[2], S[3]);
#pragma unroll
      for (int r = 0; r < 2; ++r) { const u32x4 w = u[k][r];
        S[2 * r][0] = da[0] * S[2 * r][0] + bflo(w.x); S[2 * r][1] = da[1] * S[2 * r][1] + bfhi(w.x);
        S[2 * r][2] = da[2] * S[2 * r][2] + bflo(w.y); S[2 * r][3] = da[3] * S[2 * r][3] + bfhi(w.y);
        S[2 * r + 1][0] = db[0] * S[2 * r + 1][0] + bflo(w.z); S[2 * r + 1][1] = db[1] * S[2 * r + 1][1] + bfhi(w.z);
        S[2 * r + 1][2] = db[2] * S[2 * r + 1][2] + bflo(w.w); S[2 * r + 1][3] = db[3] * S[2 * r + 1][3] + bfhi(w.w); }
    }
  }
  __syncthreads();
}

template <int MODE>
__device__ __forceinline__ void gla_c_phase(const Params& p, LAS unsigned char* lds, int G, int vb, int k0, int k1) {
  int tid_ = threadIdx.x; asm volatile("" : "+v"(tid_));
  const int tid = tid_, lane = tid & 63, r32 = lane & 31, hi = lane >> 5; const int wid = __builtin_amdgcn_readfirstlane(tid >> 6);
  const bf16_t* PROJ = (const bf16_t*)(p.ws + WS_PROJ); const bf16_t* GUT = (const bf16_t*)(p.ws + WS_GUT); const bf16_t* SPT = (const bf16_t*)(p.ws + WS_SPT);
  bf16_t* Y = (bf16_t*)(p.ws + WS_Y); const float* gbias = p.in[5]; const float* gnw = p.in[6];
  LAS float* bc = (LAS float*)(lds + GL_BC); LAS bf16_t* QE = (LAS bf16_t*)(lds + GL_QE); LAS bf16_t* KE = (LAS bf16_t*)(lds + GL_KE); LAS bf16_t* ST = (LAS bf16_t*)(lds + GL_ST);
  LAS float* red = (LAS float*)(lds + GL_RED);
  const int j = tid >> 3, c = tid & 7;
  const int it = wid & 1, vt = wid >> 1;
  u32x4 qq, kq, v0, v1, s0, s1, lr0 = {}, gub = {}; float gbs = 0.f; u32x2 og[4];
  LAS float* tot0 = (LAS float*)(lds + GL_TOT);
#define GLA_C_LOAD(item_) do { const int n_ = (item_) & 63, bh_ = (item_) >> 6, h_ = bh_ & 3, b_ = bh_ >> 2; const size_t r0_ = (size_t)b_ * SEQ + n_ * 64; \
    if (wid < 4) { lr0 = *(const u32x4*)(PROJ + (r0_ + 32 * (wid >> 1) + r32) * NP + LR_OFF + 8 * hi); \
      gub = *(const u32x4*)(GUT + (h_ * 64 + 32 * (wid & 1) + r32) * 16 + 8 * hi); gbs = gbias[h_ * 64 + 32 * (wid & 1) + r32]; } \
    qq = *(const u32x4*)(PROJ + (r0_ + j) * NP + Q_OFF + h_ * 64 + c * 8); \
    kq = *(const u32x4*)(PROJ + (r0_ + j) * NP + K_OFF + h_ * 64 + c * 8); \
    v0 = *(const u32x4*)(PROJ + (r0_ + (tid >> 4)) * NP + V_OFF + h_ * 128 + (tid & 15) * 8); \
    v1 = *(const u32x4*)(PROJ + (r0_ + 32 + (tid >> 4)) * NP + V_OFF + h_ * 128 + (tid & 15) * 8); \
    s0 = *(const u32x4*)(SPT + (size_t)(item_) * 8192 + (size_t)tid * 8); s1 = *(const u32x4*)(SPT + (size_t)(item_) * 8192 + 4096 + (size_t)tid * 8); \
    _Pragma("unroll") for (int g_ = 0; g_ < 4; ++g_) og[g_] = *(const u32x2*)(PROJ + (r0_ + 32 * it + r32) * NP + OG_OFF + h_ * 128 + 32 * vt + 8 * g_ + 4 * hi); } while (0)
  f32x4 nwr[4];
  { const float* gnw_l = gnw; asm volatile("" : "+v"(gnw_l));
#pragma unroll
  for (int g = 0; g < 4; ++g) nwr[g] = *(const f32x4*)(gnw_l + 32 * vt + 8 * g + 4 * hi); }
  int item = vb + k0 * G; const int iend = vb + (k1 < 64 ? k1 : 64) * G;
  if (item < iend && item < 2048) GLA_C_LOAD(item);
#define GLA_C_LOAD_NEXT(it_) do { if (MODE != 2) GLA_C_LOAD(it_); } while (0)
#pragma unroll 1
  for (; item < iend && item < 2048; item += G) {
    const int n = item & 63, bh = item >> 6, h = bh & 3, b = bh >> 2; const size_t r0 = (size_t)b * SEQ + n * 64;
    if (wid < 4) gla_gates_mfma(__builtin_bit_cast(bf16x8, lr0), __builtin_bit_cast(bf16x8, gub), gbs, bc, tot0, wid & 1, wid >> 1, r32, hi);
    LBAR();
    {
      const unsigned q4[4] = {qq.x, qq.y, qq.z, qq.w}, k4[4] = {kq.x, kq.y, kq.z, kq.w}; float qv[8], kv[8];
#pragma unroll
      for (int i = 0; i < 8; ++i) { const float bb = bc[j * 68 + c * 8 + i] + (j >= 32 ? tot0[c * 8 + i] : 0.f);
        qv[i] = ((i & 1) ? bfhi(q4[i >> 1]) : bflo(q4[i >> 1])) * 0.125f * __expf(bb);
        kv[i] = ((i & 1) ? bfhi(k4[i >> 1]) : bflo(k4[i >> 1])) * __expf(-bb); }
      *(LAS u32x4*)(QE + j * 72 + c * 8) = (u32x4){pk2(qv[0], qv[1]), pk2(qv[2], qv[3]), pk2(qv[4], qv[5]), pk2(qv[6], qv[7])};
      *(LAS u32x4*)(KE + j * 72 + c * 8) = (u32x4){pk2(kv[0], kv[1]), pk2(kv[2], kv[3]), pk2(kv[4], kv[5]), pk2(kv[6], kv[7])};
      const int jj = tid >> 4, cc = tid & 15;
      *(LAS u32x4*)(lds + GL_V + (cc >> 2) * 4096 + jj * 64 + (cc & 3) * 16) = v0;
      *(LAS u32x4*)(lds + GL_V + (cc >> 2) * 4096 + (32 + jj) * 64 + (cc & 3) * 16) = v1;
      *(LAS u32x4*)(ST + (tid >> 3) * 72 + (tid & 7) * 8) = s0;
      *(LAS u32x4*)(ST + (64 + (tid >> 3)) * 72 + (tid & 7) * 8) = s1;
    }
    u32x2 ogc[4];
#pragma unroll
    for (int g = 0; g < 4; ++g) ogc[g] = og[g];
    if (item + G < iend && item + G < 2048) GLA_C_LOAD_NEXT(item + G);
    LBAR();
    f32x16 acc = {};
    {
      bf16x8 qf[4];
#pragma unroll
      for (int ks = 0; ks < 4; ++ks) qf[ks] = *(const LAS bf16x8*)(QE + (32 * it + r32) * 72 + 16 * ks + 8 * hi);
      const int i_abs = 32 * it + r32;
      const int lo = ((lane >> 4) & 1) * 32 + (lane & 3) * 8 + (4 * hi + ((lane & 15) >> 2)) * 64;
#pragma unroll
      for (int jt = 0; jt < 2; ++jt) {
        if (jt <= it) {
          f32x16 at = {};
#pragma unroll
          for (int ks = 0; ks < 4; ++ks) {
            const bf16x8 a = *(const LAS bf16x8*)(KE + (32 * jt + r32) * 72 + 16 * ks + 8 * hi);
            at = __builtin_amdgcn_mfma_f32_32x32x16_bf16(a, qf[ks], at, 0, 0, 0);
          }
#pragma unroll
          for (int r = 0; r < 16; ++r) if (32 * jt + crow(r, hi) > i_abs) at[r] = 0.f;
#pragma unroll
          for (int s = 0; s < 2; ++s) {
            const u32x4 pw = (u32x4){pk2(at[8 * s + 0], at[8 * s + 1]), pk2(at[8 * s + 2], at[8 * s + 3]), pk2(at[8 * s + 4], at[8 * s + 5]), pk2(at[8 * s + 6], at[8 * s + 7])};
            const int ks = 2 * jt + s;
            const bf16x8 vf = trfrag(lds + GL_V + vt * 4096, lo + ks * 1024, lo + ks * 1024 + 512);
            acc = __builtin_amdgcn_mfma_f32_32x32x16_bf16(vf, __builtin_bit_cast(bf16x8, pw), acc, 0, 0, 0);
          }
        }
      }
#pragma unroll
      for (int ks = 0; ks < 4; ++ks) {
        const bf16x8 a = *(const LAS bf16x8*)(ST + (32 * vt + r32) * 72 + 16 * ks + 8 * hi);
        acc = __builtin_amdgcn_mfma_f32_32x32x16_bf16(a, qf[ks], acc, 0, 0, 0);
      }
    }
    float sq = 0.f;
#pragma unroll
    for (int r = 0; r < 16; ++r) sq += acc[r] * acc[r];
    red[(32 * it + r32) * 8 + vt * 2 + hi] = sq;
    LBAR();
    {
      const LAS f32x4* rr = (const LAS f32x4*)(red + (32 * it + r32) * 8);
      const f32x4 ra = rr[0], rb = rr[1];
      const float tot = ((ra[0] + ra[1]) + (ra[2] + ra[3])) + ((rb[0] + rb[1]) + (rb[2] + rb[3]));
      const float rinv = rsqrtf(tot * (1.f / 128.f) + EPS);
      bf16_t* dst = Y + (r0 + 32 * it + r32) * 1024 + h * 128 + 32 * vt + 4 * hi;
#pragma unroll
      for (int g = 0; g < 4; ++g) {
        const f32x4 nw = nwr[g];
        const float o0 = bflo(ogc[g].x), o1 = bfhi(ogc[g].x), o2 = bflo(ogc[g].y), o3 = bfhi(ogc[g].y);
        const float y0 = acc[4 * g + 0] * rinv * nw[0] * (o0 / (1.f + __expf(-o0)));
        const float y1 = acc[4 * g + 1] * rinv * nw[1] * (o1 / (1.f + __expf(-o1)));
        const float y2 = acc[4 * g + 2] * rinv * nw[2] * (o2 / (1.f + __expf(-o2)));
        const float y3 = acc[4 * g + 3] * rinv * nw[3] * (o3 / (1.f + __expf(-o3)));
        u32x2 w; w.x = pk2(y0, y1); w.y = pk2(y2, y3);
        if (MODE == 0 || w.x == 0x12345679u) *(u32x2*)(dst + 8 * g) = w;
      }
    }
  }
  LBAR();
#undef GLA_C_LOAD
}

constexpr int RT_LG = 0;
constexpr int RT_HIST = 8 * 16 * 49 * 4;
constexpr int RT_BASE = RT_HIST + 128;
__device__ __forceinline__ void router_phase(const Params& p, LAS unsigned char* lds, int G, int vb) {
  const int tid = threadIdx.x, lane = tid & 63, wave = tid >> 6;
  const bf16_t* HB = (const bf16_t*)(p.ws + WS_XB); const bf16_t* WrT = (const bf16_t*)(p.ws + WS_WR);
  float* RS2 = (float*)(p.ws + WS_RS2); int* cnt = (int*)(p.ws + WS_CNT); int* LTOK = (int*)(p.ws + WS_LTOK); float* LGATE = (float*)(p.ws + WS_LGATE);
  const float* gbias = p.in[14]; const float* ebias = p.in[16];
  LAS float* lg = (LAS float*)(lds + RT_LG) + wave * 16 * 49; LAS int* hist = (LAS int*)(lds + RT_HIST); LAS int* basee = (LAS int*)(lds + RT_BASE);
  for (int base = vb * 8; base < NTOK / 16; base += G * 8) {
    if (tid < 32) hist[tid] = 0;
    const int r0 = (base + wave) * 16;
    f32x4 acc[3] = {{0.f, 0.f, 0.f, 0.f}, {0.f, 0.f, 0.f, 0.f}, {0.f, 0.f, 0.f, 0.f}};
    const bf16_t* arow = HB + (size_t)(r0 + (lane & 15)) * 1024 + (lane >> 4) * 8;
    const bf16_t* brow = WrT + (size_t)(lane & 15) * 1024 + (lane >> 4) * 8;
    float hsq = 0.f;
#pragma unroll 4
    for (int kk = 0; kk < 32; ++kk) {
      const bf16x8 a = *(const bf16x8*)(arow + kk * 32);
      { const u32x4 aw = __builtin_bit_cast(u32x4, a); const float e0 = bflo(aw.x), e1 = bfhi(aw.x), e2 = bflo(aw.y), e3 = bfhi(aw.y), e4 = bflo(aw.z), e5 = bfhi(aw.z), e6 = bflo(aw.w), e7 = bfhi(aw.w);
        hsq += ((e0 * e0 + e1 * e1) + (e2 * e2 + e3 * e3)) + ((e4 * e4 + e5 * e5) + (e6 * e6 + e7 * e7)); }
#pragma unroll
      for (int n = 0; n < 3; ++n) { const bf16x8 bb = *(const bf16x8*)(brow + (size_t)n * 16 * 1024 + kk * 32); acc[n] = __builtin_amdgcn_mfma_f32_16x16x32_bf16(a, bb, acc[n], 0, 0, 0); }
    }
    hsq += __shfl_xor(hsq, 16); hsq += __shfl_xor(hsq, 32);
#pragma unroll
    for (int n = 0; n < 3; ++n)
#pragma unroll
      for (int r = 0; r < 4; ++r) lg[((lane >> 4) * 4 + r) * 49 + 16 * n + (lane & 15)] = acc[n][r];
    __syncthreads();
    int e1 = 0, e2 = 0, lp1 = 0, lp2 = 0; float g1 = 0.f, g2 = 0.f, rsk = 0.f; const int tok = r0 + lane;
    if (lane < 16) {
      const float rs = rsqrtf(hsq * (1.f / 1024.f) + EPS);
      RS2[tok] = rs; rsk = rs;
      float gl[4]; int gs = 0;
#pragma unroll
      for (int i = 0; i < 4; ++i) gl[i] = lg[lane * 49 + i] * rs + gbias[i];
#pragma unroll
      for (int i = 1; i < 4; ++i) if (gl[i] > gl[gs]) gs = i;
      float den = 0.f;
#pragma unroll
      for (int i = 0; i < 4; ++i) den += __expf(gl[i] - gl[gs]);
      const float pg = 1.f / den;
      float el[8];
#pragma unroll
      for (int i = 0; i < 8; ++i) el[i] = lg[lane * 49 + 4 + gs * 8 + i] * rs + ebias[gs * 8 + i];
      int i1 = 0;
#pragma unroll
      for (int i = 1; i < 8; ++i) if (el[i] > el[i1]) i1 = i;
      int i2 = (i1 == 0) ? 1 : 0;
#pragma unroll
      for (int i = 0; i < 8; ++i) if (i != i1 && el[i] > el[i2]) i2 = i;
      const float t = __expf(el[i2] - el[i1]);
      g1 = pg / (1.f + t); g2 = pg * t / (1.f + t);
      e1 = gs * 8 + i1; e2 = gs * 8 + i2;
      lp1 = atomicAdd((int*)(hist + e1), 1); lp2 = atomicAdd((int*)(hist + e2), 1);
    }
    __syncthreads();
    if (tid < 32) { const int hc = hist[tid]; basee[tid] = hc ? atomicAdd(cnt + tid, hc) : 0; }
    __syncthreads();
    if (lane < 16) {
      const int p1 = e1 * ECAP + basee[e1] + lp1, p2 = e2 * ECAP + basee[e2] + lp2;
      LTOK[p1] = tok * 2; LGATE[p1] = g1; LTOK[p2] = tok * 2 + 1; LGATE[p2] = g2;
      float* LRS2 = (float*)(p.ws + WS_LRS2); LRS2[p1] = rsk; LRS2[p2] = rsk;
    }
    __syncthreads();
  }
}

__device__ __forceinline__ void final_phase(const Params& p, int G, int vb, float pc1, float pc2) {
  const int lane = threadIdx.x & 63, wave = threadIdx.x >> 6;
  const float* fw = p.in[20]; const bf16_t* Y2 = (const bf16_t*)(p.ws + WS_PROJ); const bf16_t* HB = (const bf16_t*)(p.ws + WS_XB);
  for (int m = vb * 8 + wave; m < NTOK; m += G * 8) {
    f32x4* orow = (f32x4*)(p.out + (size_t)m * DM) + lane;
    f32x4 v[4]; float s = 0.f;
#pragma unroll
    for (int j = 0; j < 4; ++j) {
      const u32x2 hh = *((const u32x2*)(HB + (size_t)m * 1024) + lane + 64 * j);
      v[j] = (f32x4){bflo(hh.x), bfhi(hh.x), bflo(hh.y), bfhi(hh.y)};
#if ENABLE_MOE
      const u32x2 a = *((const u32x2*)(Y2 + (size_t)(2 * m) * 1024) + lane + 64 * j), b = *((const u32x2*)(Y2 + (size_t)(2 * m + 1) * 1024) + lane + 64 * j);
      v[j].x += bflo(a.x) + bflo(b.x); v[j].y += bfhi(a.x) + bfhi(b.x); v[j].z += bflo(a.y) + bflo(b.y); v[j].w += bfhi(a.y) + bfhi(b.y);
#endif
      s += (v[j].x * v[j].x + v[j].y * v[j].y) + (v[j].z * v[j].z + v[j].w * v[j].w);
    }
    s = wave_sum(s);
    const float rs = rsqrtf(s * (1.f / DM) + EPS);
#pragma unroll
    for (int j = 0; j < 4; ++j) { const f32x4 w = *((const f32x4*)fw + lane + 64 * j); f32x4 o = v[j] * rs * w;
#ifdef PROBE_T1
      o = o + pc1;
#endif
      orow[64 * j] = o; }
  }
}


#define XB_TMO      128
#define XB_XCNT(j)  (256  + 64 * (j))
#define XB_XSUB(j)  (1280 + 64 * (j))
#define XB_XGEN(j)  (2304 + 64 * (j))
#define XB_TOP      3328
#define XB_TOPGEN   3392
#define XB_SPIN_CAP (1u << 22)
__device__ __forceinline__ unsigned xb_ld(unsigned* p)              { return __hip_atomic_load(p, __ATOMIC_RELAXED, __HIP_MEMORY_SCOPE_AGENT); }
__device__ __forceinline__ unsigned xb_add(unsigned* p, unsigned v) { return __hip_atomic_fetch_add(p, v, __ATOMIC_RELAXED, __HIP_MEMORY_SCOPE_AGENT); }
__device__ __forceinline__ unsigned xb_xcc_id() { return (unsigned)__builtin_amdgcn_s_getreg((3 << 11) | 20) & 0xFu; }
#define XB_SPIN(cond, bar) do { unsigned _sp = 0; while (cond) { __builtin_amdgcn_s_sleep(1); \
    if ((++_sp & 255u) == 0u) { if (xb_ld(&(bar)[XB_TMO])) break; if (_sp > XB_SPIN_CAP) { atomicAdd(&(bar)[XB_TMO], 1u); break; } } } } while (0)
struct XcdBarrier { unsigned* bar; unsigned x; volatile LAS unsigned* st; };
__device__ __forceinline__ XcdBarrier xcd_barrier_post(unsigned* bar, volatile LAS unsigned* st) {
  XcdBarrier b; b.bar = bar; b.x = xb_xcc_id(); b.st = st;
  if (threadIdx.x == 0) st[2] = xb_add(&bar[XB_XCNT(b.x)], 1u);
  return b;
}
__device__ __forceinline__ void xcd_barrier_complete(unsigned* bar, unsigned x, unsigned& nloc, unsigned& nx) {
  const unsigned G = gridDim.x * gridDim.y * gridDim.z;
  unsigned sum, cnt, mine, sp = 0u;
  for (;;) {
    sum = 0u; cnt = 0u; mine = 0u;
#pragma unroll
    for (unsigned j = 0; j < 16; ++j) { const unsigned c = xb_ld(&bar[XB_XCNT(j)]); sum += c; cnt += (c > 0u) ? 1u : 0u; mine = (j == x) ? c : mine; }
    if (sum == G) break;
    __builtin_amdgcn_s_sleep(1);
    if ((++sp & 255u) == 0u) { if (xb_ld(&bar[XB_TMO])) break; if (sp > XB_SPIN_CAP) { atomicAdd(&bar[XB_TMO], 1u); break; } }
  }
  nloc = mine > 0u ? mine : 1u; nx = cnt > 0u ? cnt : 1u;
}
__device__ __forceinline__ void xcd_barrier(const XcdBarrier& b) {
  asm volatile("s_waitcnt vmcnt(0)" ::: "memory");
  __syncthreads();
  if (threadIdx.x == 0) {
    unsigned* bar = b.bar;
    __builtin_amdgcn_s_waitcnt(0);
    unsigned nloc = b.st[0], nx = b.st[1];
    if (nloc == 0u) { xcd_barrier_complete(bar, b.x, nloc, nx); b.st[0] = nloc; b.st[1] = nx; }
    const unsigned old = xb_add(&bar[XB_XSUB(b.x)], 1u);
    const unsigned gen = old / nloc;
    if (old + 1u == (gen + 1u) * nloc) {
      __builtin_amdgcn_fence(__ATOMIC_RELEASE, "agent");
      asm volatile("s_waitcnt vmcnt(0)" ::: "memory");
      const unsigned og = xb_add(&bar[XB_TOP], 1u);
      const unsigned tg = og / nx;
      if (og + 1u == (tg + 1u) * nx) xb_add(&bar[XB_TOPGEN], 1u);
      else XB_SPIN(xb_ld(&bar[XB_TOPGEN]) == tg, bar);
      xb_add(&bar[XB_XGEN(b.x)], 1u);
      __builtin_amdgcn_fence(__ATOMIC_ACQUIRE, "agent");
      asm volatile("s_waitcnt vmcnt(0)" ::: "memory");
    } else {
      XB_SPIN(xb_ld(&bar[XB_XGEN(b.x)]) == gen, bar);
      __builtin_amdgcn_fence(__ATOMIC_ACQUIRE, "agent");
      asm volatile("s_waitcnt vmcnt(0)" ::: "memory");
    }
  }
  __syncthreads();
}

constexpr int LDS_CTL = 131072;
constexpr int LDS_BYTES = 131072 + 1024 + 8192;

__global__ void __launch_bounds__(512) fwd(Params p, int ph_lo, int ph_hi) {
  extern __shared__ __attribute__((aligned(16))) unsigned char lds_raw[];
  LAS unsigned char* lds = (LAS unsigned char*)lds_raw;
  cg::grid_group grid = cg::this_grid();
  const int G = gridDim.x, bx = blockIdx.x;
  int vb = bx;
  int crr = bx;
  unsigned char* ws = p.ws;
#ifndef PHMASK
#define PHMASK 0x3ff
#endif
#define PH(k) (((PHMASK >> (k)) & 1) && ph_lo <= (k) && (k) < ph_hi)
#ifdef PROBE_T1
  LAS unsigned long long* tsx = (LAS unsigned long long*)(lds + LDS_CTL + 512);
  if (threadIdx.x == 0) tsx[0] = __builtin_amdgcn_s_memrealtime();
#define SEAM(k) do { if (PH(k) && PH((k) + 1)) grid.sync(); if (threadIdx.x == 0) tsx[(k) + 1] = __builtin_amdgcn_s_memrealtime(); } while (0)
#else
#define SEAM(k) do { if (PH(k) && PH((k) + 1)) xcd_barrier(xbar); } while (0)
#endif
  volatile LAS unsigned* xst = (volatile LAS unsigned*)(lds + LDS_CTL + 768);
  if (threadIdx.x == 0) { xst[0] = 0u; xst[1] = 0u; }
  if (blockIdx.x == 0) for (int i = threadIdx.x; i < XCD_BAR_WORDS; i += 512) ((unsigned*)(ws + WS_BAR))[i] = 0u;
  grid.sync();
  XcdBarrier xbar = xcd_barrier_post((unsigned*)(ws + WS_BAR), xst);
  if (PH(0)) for (int rep = 0; rep < ((REPEAT_PHASE == 0) ? 2 : 1); ++rep) { if (rep) grid.sync(); p0_prologue(p, lds, G, vb); }
  SEAM(0);
  {
    volatile LAS unsigned* xs = xst;
    if (threadIdx.x == 0) { unsigned pre = 0u; for (unsigned j = 0; j < xbar.x; ++j) pre += xb_ld(&xbar.bar[XB_XCNT(j)]); xs[3] = pre + xs[2]; }
    __syncthreads();
    if (G % 8 == 0) { vb = (int)xs[3]; if (vb >= G) vb = bx; const int per = G / 8; crr = (vb % per) * 8 + vb / per; }
  }
  if (PH(1)) for (int rep = 0; rep < NREP(1); ++rep) {
    if (rep) grid.sync();
    g8::DenseSched S; S.init(ws + WS_XB, 1024, ws + WS_WIN, 1024, NTOK, NP, G, crr);
    EpiInproj E{(bf16_t*)(ws + WS_PROJ), (const float*)(ws + WS_RS1), (float*)(ws + WS_SSQP), (const f32x2*)(ws + WS_CS)};
    g8::gemm_phase(lds, 1024, S, E);
    if (G == 256 && crr >= 128 && rep == 0) {
      LAS float* scr = (LAS float*)(lds + (threadIdx.x >> 6) * 8704);
      for (int r = (crr - 128) * 8 + (threadIdx.x >> 6); r < CONV_GU_P1; r += 1024) conv_gu_item(p, CONV_GU_P0 + r, scr, threadIdx.x & 63);
      for (int r = (crr - 128) * 8 + (threadIdx.x >> 6); r < CONV_D_P1; r += 1024) conv_d_item(p, r, scr, threadIdx.x & 63);
      __syncthreads();
    }
  }
  SEAM(1);
  const bool split23 = (G == 256);
  const int Gg = split23 ? 224 : G;
#define P2_GEMMS(DRY) do { \
    { g8::DenseSched S; S.init((const bf16_t*)(ws + WS_PROJ) + CQ_OFF, NP, ws + WS_WUQ, 384, NTOK, 768, Gg, crr); \
      EpiUq E{(bf16_t*)(ws + WS_QB), (const float*)(ws + WS_SSQP), (const f32x2*)(ws + WS_CS), DRY}; \
      g8::gemm_phase(lds, 384, S, E); } \
    { g8::DenseSched S; S.init((const bf16_t*)(ws + WS_PROJ) + CKV_OFF, NP, ws + WS_WUKV, 256, NTOK, 1024, Gg, split23 ? (crr + 64) % 224 : crr);     \
      EpiUkv E{(bf16_t*)(ws + WS_KVB), (const float*)(ws + WS_SSQP), DRY}; \
      g8::gemm_phase(lds, 256, S, E); } } while (0)
#define P2_GLA() gla_a_phase(p, lds, G, vb)
#define P4_GLA() gla_c_phase<0>(p, lds, G, vb, 0, 1 << 20)
  if (PH(2)) {
#if ENABLE_GLA
    P2_GLA();
#endif
#if REPEAT_PHASE == 2
    grid.sync();
    P2_GLA();
#endif
  }
  SEAM(2);
  if (PH(3)) {
#if ENABLE_MLA
    if (!split23 || crr < 224) P2_GEMMS(false);
#endif
#if ENABLE_GLA
    if (!split23) gla_scan(p, G, vb);
    else if (crr >= 224) {
      gla_scan_block(p, lds, crr - 224);
      LAS float* scr_ = (LAS float*)(lds + (threadIdx.x >> 6) * 8704);
      for (int r_ = (crr - 224) * 8 + (threadIdx.x >> 6); r_ < CONV_GU_P2; r_ += 256) conv_gu_item(p, CONV_GU_P0 + CONV_GU_P1 + r_, scr_, threadIdx.x & 63);
      for (int r_ = CONV_D_P1 + (crr - 224) * 8 + (threadIdx.x >> 6); r_ < 4096; r_ += 256) conv_d_item(p, r_, scr_, threadIdx.x & 63);
      __syncthreads();
    }
#endif
#if REPEAT_PHASE == 3
    grid.sync();
    if ((REPEAT_SUB & 1) && (!split23 || crr < 224)) P2_GEMMS(true);
    if ((REPEAT_SUB & 2) && split23 && crr >= 224) {
      gla_scan_block(p, lds, crr - 224);
      if (REPEAT_SUB & 4) { LAS float* scr_ = (LAS float*)(lds + (threadIdx.x >> 6) * 8704);
      for (int r_ = (crr - 224) * 8 + (threadIdx.x >> 6); r_ < CONV_GU_P2; r_ += 256) conv_gu_item(p, CONV_GU_P0 + CONV_GU_P1 + r_, scr_, threadIdx.x & 63);
      for (int r_ = CONV_D_P1 + (crr - 224) * 8 + (threadIdx.x >> 6); r_ < 4096; r_ += 256) conv_d_item(p, r_, scr_, threadIdx.x & 63);
      __syncthreads(); }
    }
#endif
  }
  SEAM(3);
  if (PH(4)) {
#if ENABLE_MLA && ENABLE_GLA
    if (G == 256) {
      const int bh = vb >> 2, s4 = vb & 3;
      const int odd = vb & 1;
#pragma unroll 1
      for (int k = 0; k < 8; ++k) { const int i = k >> 1;
        if (((k + odd) & 1) == 0) { const int qb = (i == 0) ? 15 - s4 : (i == 1) ? 8 + s4 : (i == 2) ? 7 - s4 : s4; attn_unit<0>(p, lds, bh >> 3, bh & 7, qb); }
        else gla_c_phase<0>(p, lds, G, vb, 2 * i, 2 * i + 2); }
    } else { attn_phase<0>(p, lds, G, vb); P4_GLA(); }
#elif ENABLE_MLA
    attn_phase<0>(p, lds, G, vb);
#else
    { u32x4* Yz = (u32x4*)(ws + WS_Y); for (int i = vb * 512 + threadIdx.x; i < NTOK * 64; i += G * 512) Yz[(size_t)(i >> 6) * 128 + 64 + (i & 63)] = (u32x4){0u, 0u, 0u, 0u}; }
#endif
#if ENABLE_GLA && !ENABLE_MLA
    P4_GLA();
#endif
#if REPEAT_PHASE == 4
    grid.sync();
#ifndef ATTN_PROBE_MODE
#define ATTN_PROBE_MODE 0
#endif
    if (REPEAT_SUB & 1) attn_phase<ATTN_PROBE_MODE>(p, lds, G, vb);
#ifndef GLA_PROBE_MODE
#define GLA_PROBE_MODE 0
#endif
    if (REPEAT_SUB & 2) gla_c_phase<GLA_PROBE_MODE>(p, lds, G, vb, 0, 1 << 20);
#endif
  }
  SEAM(4);
  if (PH(5)) for (int rep = 0; rep < NREP(5); ++rep) {
    if (rep) grid.sync();
    g8::DenseSched S; S.init(ws + WS_Y, 1024, ws + WS_WOUT, 1024, NTOK, 1024, G, crr);
    EpiWout E{p.in[0], (bf16_t*)(ws + WS_XB), ws + WS_H8};
    g8::gemm_phase(lds, 1024, S, E);
  }
  SEAM(5);
#if ENABLE_MOE
  if (PH(6)) router_phase(p, lds, G, vb);
  SEAM(6);
  if (PH(7) || PH(8)) {
    LAS int* tb = (LAS int*)(lds + LDS_CTL); LAS int* cn = (LAS int*)(lds + LDS_CTL + 256);
    if (threadIdx.x == 0) { const int* cnt = (const int*)(ws + WS_CNT); int acc = 0;
      for (int e = 0; e < NEXP; ++e) { const int c = cnt[e]; cn[e] = c; tb[e] = acc; acc += (c + 255) >> 8; }
      tb[NEXP] = acc; }
    __syncthreads();
    const int T = tb[NEXP];
    if (PH(7)) for (int rep = 0; rep < NREP(7); ++rep) {
      if (rep) grid.sync();
#if MOE_FP8
      MoeSched<true> S; S.A = (const char*)(ws + WS_H8); S.B = (const char*)(ws + WS_WGU); S.lda = 512; S.ldb = 512; S.ncol = 2; S.total = T * 2; S.G = G; S.c = vb;
      S.tb = tb; S.cn = cn; S.ltok = (const int*)(ws + WS_LTOK); S.bstride = (size_t)512 * 1024; S.n1 = 0; S.r = 0; S.flg = nullptr;
#else
      MoeSched<true> S; S.A = (const char*)(ws + WS_XB); S.B = (const char*)(ws + WS_WGU); S.lda = 1024; S.ldb = 1024; S.ncol = 2; S.total = T * 2; S.G = G; S.c = vb;
      S.tb = tb; S.cn = cn; S.ltok = (const int*)(ws + WS_LTOK); S.bstride = (size_t)512 * 1024 * 2; S.n1 = 0; S.r = 0; S.flg = nullptr;
#endif
      EpiGU E{(bf16_t*)(ws + WS_QB), (const float*)(ws + WS_LRS2), (const int*)(ws + WS_LTOK), cn, rep > 0 && P8_DRY, (int*)(ws + WS_FLG)};
      g8::gemm_phase<MOE_FP8 ? 2 : 0>(lds, MOE_FP8 ? 512 : 1024, S, E);
    }
    if (PH(8)) for (int rep = 0; rep < NREP(8); ++rep) {
      if (rep) grid.sync();
#if MOE_FP8
      MoeSched<false> S; S.A = (const char*)(ws + WS_QB); S.B = (const char*)(ws + WS_WD); S.lda = 128; S.ldb = 128; S.ncol = 4; S.total = T * 4; S.G = G; S.c = vb;
      S.tb = tb; S.cn = cn; S.ltok = (const int*)(ws + WS_LTOK); S.bstride = (size_t)1024 * 256;
#else
      MoeSched<false> S; S.A = (const char*)(ws + WS_QB); S.B = (const char*)(ws + WS_WD); S.lda = 256; S.ldb = 256; S.ncol = 4; S.total = T * 4; S.G = G; S.c = vb;
      S.tb = tb; S.cn = cn; S.ltok = (const int*)(ws + WS_LTOK); S.bstride = (size_t)1024 * 256 * 2;
#endif
      { const int rr_ = (T * 2) % G, n0_ = (T * 4 + 2 * rr_ + G - 1) / G; S.r = rr_; S.n1 = n0_ > 2 ? n0_ - 2 : 0; S.flg = (const int*)(ws + WS_FLG); }
      EpiDown E{(bf16_t*)(ws + WS_PROJ), (const int*)(ws + WS_LTOK), (const float*)(ws + WS_LGATE), cn, rep > 0 && P8_DRY};
      g8::gemm_phase<MOE_FP8 ? 1 : 0>(lds, MOE_FP8 ? 128 : 256, S, E);
    }
  }
  SEAM(8);
#endif
#ifdef PROBE_T1
  __syncthreads();
  const float probe_c1 = 0.1f * log2f((float)(tsx[PROBE_T1 + 1] - tsx[PROBE_T1]) * 0.01f), probe_c2 = 0.f;
  if (PH(9)) final_phase(p, G, vb, probe_c1, probe_c2);
#else
#ifdef EXTRA_SYNCS
  for (int i = 0; i < EXTRA_SYNCS; ++i) grid.sync();
#endif
  if (PH(9)) final_phase(p, G, vb, 0.f, 0.f);
#endif
#undef PH
#undef SEAM
}

extern "C" void kernel_launch(void* const* d_in, const int* in_sizes, int n_in, void* d_out, int out_size,
                              void* d_ws, size_t ws_size, hipStream_t stream) {
  static int grid_blocks = 0;
  if (grid_blocks == 0) {
    if (n_in != 21 || ws_size < WS_END) { fprintf(stderr, "kernel_launch: unexpected n_in %d or ws_size %zu (< %zu)\n", n_in, ws_size, (size_t)WS_END); grid_blocks = -1; return; }
    int dev = 0, cus = 0, per_cu = 0;
    hipGetDevice(&dev);
    hipDeviceGetAttribute(&cus, hipDeviceAttributeMultiprocessorCount, dev);
    hipFuncSetAttribute((const void*)fwd, hipFuncAttributeMaxDynamicSharedMemorySize, LDS_BYTES);
    hipOccupancyMaxActiveBlocksPerMultiprocessor(&per_cu, (const void*)fwd, 512, LDS_BYTES);
    if (per_cu < 1) { fprintf(stderr, "kernel_launch: occupancy query says %d blocks/CU\n", per_cu); per_cu = 1; }
    grid_blocks = cus;
  }
  if (grid_blocks < 0) return;
  Params p{};
  for (int i = 0; i < 21; ++i) p.in[i] = (const float*)d_in[i];
  p.out = (float*)d_out; p.ws = (unsigned char*)d_ws;
  int lo = 0, hi = 10;
  void* args[] = {&p, &lo, &hi};
  hipError_t e = hipLaunchCooperativeKernel((void*)fwd, dim3(grid_blocks), dim3(512), args, LDS_BYTES, stream);
  if (e != hipSuccess) fprintf(stderr, "cooperative launch failed: %s (grid %d)\n", hipGetErrorString(e), grid_blocks);
}
```

```cpp
#include <hip/hip_runtime.h>
#include <hip/hip_cooperative_groups.h>
#include <cstdio>
#include <cstdint>
#include <cmath>
namespace cg = cooperative_groups;

#ifndef MOE_FP8
#define MOE_FP8 1
#endif
#ifndef ENABLE_GLA
#define ENABLE_GLA 1
#endif
#ifndef ENABLE_MLA
#define ENABLE_MLA 1
#endif
#ifndef ENABLE_MOE
#define ENABLE_MOE 1
#endif

#ifndef P8_DRY
#define P8_DRY false
#endif
#ifndef REPEAT_PHASE
#define REPEAT_PHASE -1
#endif
#ifndef REPEAT_SUB
#define REPEAT_SUB 3
#endif
#define NREP(k) ((REPEAT_PHASE == (k)) ? 2 : 1)
#define LAS __attribute__((address_space(3)))
typedef unsigned short bf16_t;
typedef short bf16x8 __attribute__((ext_vector_type(8)));
typedef short s16x4 __attribute__((ext_vector_type(4)));
typedef float f32x4 __attribute__((ext_vector_type(4)));
typedef float f32x2 __attribute__((ext_vector_type(2)));
typedef float f32x16 __attribute__((ext_vector_type(16)));
typedef unsigned u32x4 __attribute__((ext_vector_type(4)));
typedef unsigned u32x2 __attribute__((ext_vector_type(2)));
typedef int i32x4 __attribute__((ext_vector_type(4)));
typedef int i32x8 __attribute__((ext_vector_type(8)));
typedef __bf16 bf16x2_t __attribute__((ext_vector_type(2)));

constexpr int NTOK = 32768, DM = 1024, SEQ = 4096, NBATCH = 8;
constexpr int NP = 2304;
constexpr int Q_OFF = 0, K_OFF = 256, V_OFF = 512, OG_OFF = 1024, CQ_OFF = 1536, CKV_OFF = 1920, KR_OFF = 2176, LR_OFF = 2208;
constexpr int NEXP = 32, ECAP = 32768;
constexpr float EPS = 1e-6f;
constexpr float F8_SH = 4.f, F8_SWGU = 32.f, F8_SHID = 4.f, F8_SWD = 16.f;
constexpr float QSCALE = 0.10206207261596575f * 1.4426950408889634f;

constexpr size_t MiB = 1u << 20;
constexpr size_t WS_CNT = 0;
constexpr size_t WS_FLG = 4096;
constexpr size_t WS_BAR = 128 * 1024;
constexpr size_t WS_GUT = 64 * 1024;
constexpr size_t WS_RS1 = 1 * MiB;
constexpr size_t WS_RS2 = 1 * MiB + 512 * 1024;
constexpr size_t WS_SSQP = 2 * MiB;
constexpr size_t WS_CS = 4 * MiB;
constexpr size_t WS_LTOK = 8 * MiB;
constexpr size_t WS_LGATE = 12 * MiB;
constexpr size_t WS_WIN = 16 * MiB;
constexpr size_t WS_WUQ = 21 * MiB;
constexpr size_t WS_WUKV = 22 * MiB;
constexpr size_t WS_WOUT = 23 * MiB;
constexpr size_t WS_WR = 25 * MiB;
constexpr size_t WS_WGU = 26 * MiB;
constexpr size_t WS_WD = 58 * MiB;
constexpr size_t WS_DEC = 74 * MiB;
constexpr size_t WS_XB = 80 * MiB;
constexpr size_t WS_PROJ = 144 * MiB;
constexpr size_t WS_QB = 288 * MiB;
constexpr size_t WS_KVB = 336 * MiB;
constexpr size_t WS_Y = 400 * MiB;
constexpr size_t WS_SPT = 464 * MiB;
constexpr size_t WS_H8 = WS_KVB;
constexpr size_t WS_LRS2 = 496 * MiB;
constexpr size_t WS_END = 500 * MiB;

struct Params {
  const float* in[21];
  float* out;
  unsigned char* ws;
};

__device__ __forceinline__ unsigned pk2(float lo, float hi) { f32x2 v = {lo, hi}; bf16x2_t b = __builtin_convertvector(v, bf16x2_t); return __builtin_bit_cast(unsigned, b); }
__device__ __forceinline__ float bf2f(unsigned short h) { return __uint_as_float(((unsigned)h) << 16); }
__device__ __forceinline__ float bflo(unsigned w) { return __uint_as_float(w << 16); }
__device__ __forceinline__ float bfhi(unsigned w) { return __uint_as_float(w & 0xffff0000u); }
__device__ __forceinline__ u32x2 pk8_fp8(const f32x4& a, const f32x4& b, float sc) {
  float t[8] = {a[0] * sc, a[1] * sc, a[2] * sc, a[3] * sc, b[0] * sc, b[1] * sc, b[2] * sc, b[3] * sc};
#pragma unroll
  for (int i = 0; i < 8; ++i) t[i] = fminf(fmaxf(t[i], -448.f), 448.f);
  int lo = __builtin_amdgcn_cvt_pk_fp8_f32(t[0], t[1], 0, false); lo = __builtin_amdgcn_cvt_pk_fp8_f32(t[2], t[3], lo, true);
  int hi = __builtin_amdgcn_cvt_pk_fp8_f32(t[4], t[5], 0, false); hi = __builtin_amdgcn_cvt_pk_fp8_f32(t[6], t[7], hi, true);
  u32x2 r; r.x = (unsigned)lo; r.y = (unsigned)hi; return r;
}
__device__ __forceinline__ int perm32(int rho) { const int n = rho >> 4, i = rho & 15; return 8 * (i >> 2) + 4 * n + (i & 3); }
__device__ __forceinline__ float wave_sum(float v) {
#pragma unroll
  for (int o = 1; o < 64; o <<= 1) v += __shfl_xor(v, o);
  return v;
}
#define XCD_BAR_WORDS 3456
#define LDS_WAIT() asm volatile("s_waitcnt lgkmcnt(0)" ::: "memory")
#define LBAR() asm volatile("s_waitcnt lgkmcnt(0)\n\ts_barrier" ::: "memory")

namespace g8 {
constexpr int BM = 256, BK = 64, HALF = 128, HTB = HALF * BK * 2, STAGE_BYTES = 8 * HTB, NXCD = 8, WGM = 8;
__device__ __forceinline__ int lds_byte(int r, int c) { const int st = (r >> 4) * 2 + (c >> 5), rr = r & 15, cc = c & 31, ob = rr * 64 + cc * 2; return st * 1024 + (ob ^ (((ob >> 9) & 1) << 5)); }
__device__ __forceinline__ void stage_rc(int b, int& R, int& C) { const int st = b / 1024, sb = b % 1024, swz = sb ^ (((sb >> 9) & 1) << 5); R = (st >> 1) * 16 + swz / 64; C = (st & 1) * 32 + (swz % 64) / 2; }

struct Unit { const char* A; const char* B; int a, b, c, d; };

template <int F8 = 0  , class Epi, class Sched>
__device__ __forceinline__ void gemm_phase(LAS unsigned char* lds, const int K, const Sched& S, const Epi& E) {
  const int tid = threadIdx.x, wid = __builtin_amdgcn_readfirstlane(tid >> 6), lane = tid & 63, wr = wid >> 2, wc = wid & 3, fr = lane & 15, fq = lane >> 4;
  const int nt = K / BK;
  int R[2], C[2];
#pragma unroll
  for (int i = 0; i < 2; ++i) stage_rc(tid * 16 + i * 8192, R[i], C[i]);
  constexpr bool GA = Sched::GATHER;
  unsigned oB[2], oA[2][2];
  LAS unsigned* onxt = (LAS unsigned*)(lds + STAGE_BYTES + 1024) + tid;
#pragma unroll
  for (int i = 0; i < 2; ++i) oB[i] = (unsigned)(R[i] * S.ldb + C[i]) * 2u;
  const size_t hB = (size_t)HALF * S.ldb * 2, hA = GA ? (size_t)0 : (size_t)HALF * S.lda * 2;
  const size_t kstep = (size_t)(BK * 2);
  const unsigned ldsw = (unsigned)wid * 1024u;
  const int aoff = lds_byte(wr * 64 + fr, fq * 8), boff = lds_byte(wc * 32 + fr, fq * 8);
#define G8_SA(b, h) (((b) * 2 + (h)) * HTB)
#define G8_SB(b, h) ((4 + (b) * 2 + (h)) * HTB)
#define G8_STAGE_X(bufoff, gbase, off2, AUX) do { _Pragma("unroll") for (int _i = 0; _i < 2; ++_i) \
    __builtin_amdgcn_global_load_lds((const unsigned*)((const char*)(gbase) + (off2)[_i]), (LAS unsigned*)(lds + (bufoff) + ldsw + _i * 8192), 16, 0, AUX); } while (0)
#define G8_STAGE(bufoff, gbase, off2) G8_STAGE_X(bufoff, gbase, off2, 0)
#define G8_STAGEA(bufoff, gbase, off2) G8_STAGE_X(bufoff, gbase, off2, (Sched::A_SC1 ? 16 : 0))
#define G8_LD16(off_) (*(const LAS i32x4*)(lds + (off_)))
#define G8_LDA(dst, b, h) do { _Pragma("unroll") for (int m = 0; m < 4; ++m) { \
    if constexpr (F8 == 2) dst##8[m] = __builtin_shufflevector(G8_LD16(G8_SA(b, h) + aoff + m * 2048), G8_LD16(G8_SA(b, h) + aoff + m * 2048 + 1024), 0, 1, 2, 3, 4, 5, 6, 7); \
    else { _Pragma("unroll") for (int k = 0; k < 2; ++k) dst[m][k] = *(const LAS bf16x8*)(lds + G8_SA(b, h) + aoff + m * 2048 + k * 1024); } } } while (0)
#define G8_LDB(dst, b, h) do { _Pragma("unroll") for (int n = 0; n < 2; ++n) { \
    if constexpr (F8 == 2) dst##8[n] = __builtin_shufflevector(G8_LD16(G8_SB(b, h) + boff + n * 2048), G8_LD16(G8_SB(b, h) + boff + n * 2048 + 1024), 0, 1, 2, 3, 4, 5, 6, 7); \
    else { _Pragma("unroll") for (int k = 0; k < 2; ++k) dst[n][k] = *(const LAS bf16x8*)(lds + G8_SB(b, h) + boff + n * 2048 + k * 1024); } } } while (0)
#define G8_MMA(ai, bj, At, Bt) do { __builtin_amdgcn_s_setprio(1); \
    if constexpr (F8 == 2) {   \
      _Pragma("unroll") for (int m = 0; m < 4; ++m) _Pragma("unroll") for (int n = 0; n < 2; ++n) \
        acc[ai][bj][m][n] = __builtin_amdgcn_mfma_scale_f32_16x16x128_f8f6f4(Bt##8[n], At##8[m], acc[ai][bj][m][n], 0, 0, 0, 0x7f7f7f7f, 0, 0x7f7f7f7f); \
    } else if constexpr (F8 == 1) { \
      _Pragma("unroll") for (int m = 0; m < 4; ++m) _Pragma("unroll") for (int n = 0; n < 2; ++n) { \
        const i32x4 b0_ = __builtin_bit_cast(i32x4, Bt[n][0]), b1_ = __builtin_bit_cast(i32x4, Bt[n][1]), a0_ = __builtin_bit_cast(i32x4, At[m][0]), a1_ = __builtin_bit_cast(i32x4, At[m][1]); \
        acc[ai][bj][m][n] = __builtin_amdgcn_mfma_scale_f32_16x16x128_f8f6f4(__builtin_shufflevector(b0_, b1_, 0, 1, 2, 3, 4, 5, 6, 7), __builtin_shufflevector(a0_, a1_, 0, 1, 2, 3, 4, 5, 6, 7), \
                                                                             acc[ai][bj][m][n], 0, 0, 0, 0x7f7f7f7f, 0, 0x7f7f7f7f); } \
    } else { \
      _Pragma("unroll") for (int m = 0; m < 4; ++m) _Pragma("unroll") for (int n = 0; n < 2; ++n) _Pragma("unroll") for (int k = 0; k < 2; ++k) \
        acc[ai][bj][m][n] = __builtin_amdgcn_mfma_f32_16x16x32_bf16(Bt[n][k], At[m][k], acc[ai][bj][m][n], 0, 0, 0); } \
    __builtin_amdgcn_s_setprio(0); } while (0)
#define G8_WAIT_V(n) asm volatile("s_waitcnt vmcnt(" #n ")" ::: "memory")
#define G8_WAIT_L(n) asm volatile("s_waitcnt lgkmcnt(" #n ")" ::: "memory")
#define G8_BAR __builtin_amdgcn_s_barrier()
#define G8_SCHED __builtin_amdgcn_sched_barrier(0)
  Unit cur, nxt; int ui = 0;
  if (!S.next(0, cur)) return;
  S.offs(cur, R, C, oA);
  f32x4 acc[2][2][4][2];
#pragma unroll
  for (int a = 0; a < 2; ++a)
#pragma unroll
    for (int b = 0; b < 2; ++b)
#pragma unroll
      for (int m = 0; m < 4; ++m)
#pragma unroll
        for (int n = 0; n < 2; ++n) acc[a][b][m][n] = (f32x4){0.f, 0.f, 0.f, 0.f};
  bf16x8 At[4][2], B0[2][2], B1[2][2];
  i32x8 At8[4], B08[2], B18[2];
  const char* cA = cur.A; const char* cB = cur.B;
  G8_STAGE(G8_SB(0, 0), cB, oB); G8_STAGE(G8_SB(0, 1), cB + hB, oB); G8_STAGEA(G8_SA(0, 0), cA, oA[0]); G8_STAGEA(G8_SA(0, 1), cA + hA, oA[GA]);
  if (wr == 1) G8_BAR;
  G8_WAIT_V(2); G8_BAR;
  G8_STAGE(G8_SB(1, 0), cB + kstep, oB); G8_STAGEA(G8_SA(1, 0), cA + kstep, oA[0]); G8_STAGE(G8_SB(1, 1), cB + kstep + hB, oB);
  G8_WAIT_V(6); G8_BAR;
  for (;;) {
    const bool has_next = S.next(ui + 1, nxt);
    if (GA && has_next) {
      unsigned oAn[2][2]; S.offs(nxt, R, C, oAn);
#pragma unroll
      for (int h = 0; h < 2; ++h)
#pragma unroll
        for (int i = 0; i < 2; ++i) onxt[(h * 2 + i) * 512] = oAn[h][i];
    }
    const char* nA = has_next ? nxt.A : cA; const char* nB = has_next ? nxt.B : cB;
#pragma unroll 1
    for (int t = 0; t < nt; t += 2) {
      const bool last = (t == nt - 2);
      const char* a1 = cA + (size_t)(t + 1) * kstep;
      const char* a2 = last ? nA : cA + (size_t)(t + 2) * kstep; const char* b2 = last ? nB : cB + (size_t)(t + 2) * kstep;
      const char* a3 = a2 + kstep; const char* b3 = b2 + kstep;
      G8_LDB(B0, 0, 0); G8_LDB(B1, 0, 1); G8_SCHED; G8_LDA(At, 0, 0); G8_STAGEA(G8_SA(1, 1), a1 + hA, oA[GA]);
      G8_WAIT_V(8); G8_WAIT_L(0); G8_BAR; G8_MMA(0, 0, At, B0); G8_MMA(0, 1, At, B1); G8_BAR; G8_SCHED;
      if (GA && last && has_next) {
#pragma unroll
        for (int h = 0; h < 2; ++h)
#pragma unroll
          for (int i = 0; i < 2; ++i) oA[h][i] = onxt[(h * 2 + i) * 512];
      }
      G8_LDA(At, 0, 1); G8_STAGE(G8_SB(0, 0), b2, oB); G8_STAGE(G8_SB(0, 1), b2 + hB, oB); G8_STAGEA(G8_SA(0, 0), a2, oA[0]);
      G8_WAIT_V(8); G8_WAIT_L(0); G8_BAR; G8_MMA(1, 0, At, B0); G8_MMA(1, 1, At, B1); G8_BAR; G8_SCHED;
      G8_LDB(B0, 1, 0); G8_LDB(B1, 1, 1); G8_SCHED; G8_LDA(At, 1, 0); G8_STAGEA(G8_SA(0, 1), a2 + hA, oA[GA]);
      G8_WAIT_V(8); G8_WAIT_L(0); G8_BAR; G8_MMA(0, 0, At, B0); G8_MMA(0, 1, At, B1); G8_BAR; G8_SCHED;
      G8_LDA(At, 1, 1); G8_STAGE(G8_SB(1, 0), b3, oB); G8_STAGE(G8_SB(1, 1), b3 + hB, oB); G8_STAGEA(G8_SA(1, 0), a3, oA[0]);
      G8_WAIT_V(8); G8_WAIT_L(0); G8_BAR; G8_MMA(1, 0, At, B0); G8_MMA(1, 1, At, B1); G8_BAR; G8_SCHED;
    }
    if (wr == 0) G8_BAR;
    E(acc, cur, wr, wc, fr, fq);
    if (!has_next) break;
#pragma unroll
    for (int a = 0; a < 2; ++a)
#pragma unroll
      for (int b = 0; b < 2; ++b)
#pragma unroll
        for (int m = 0; m < 4; ++m)
#pragma unroll
          for (int n = 0; n < 2; ++n) acc[a][b][m][n] = (f32x4){0.f, 0.f, 0.f, 0.f};
    cur = nxt; cA = nA; cB = nB; ++ui;
    if (wr == 1) G8_BAR;
  }
  G8_WAIT_V(0);
  G8_BAR;
#undef G8_SA
#undef G8_SB
#undef G8_STAGE
#undef G8_STAGEA
#undef G8_STAGE_X
#undef G8_LD16
#undef G8_LDA
#undef G8_LDB
#undef G8_MMA
#undef G8_WAIT_V
#undef G8_WAIT_L
#undef G8_BAR
#undef G8_SCHED
}

struct DenseSched {
  static constexpr bool GATHER = false, A_SC1 = false;
  const char* A; const char* B; int lda, ldb; int nM, nN, nwg, G, c;
  __device__ __forceinline__ void init(const void* A_, int lda_, const void* B_, int ldb_, int M, int N, int G_, int c_) {
    A = (const char*)A_; B = (const char*)B_; lda = lda_; ldb = ldb_; nM = M / BM; nN = N / BM; nwg = nM * nN; G = G_; c = c_; }
  __device__ __forceinline__ bool next(int i, Unit& u) const {
    const long L = (long)i * G + c; if (L >= nwg) return false;
    int wgid = (int)L; { const int q = nwg / NXCD, r = nwg % NXCD, xcd = wgid % NXCD, off = wgid / NXCD; wgid = (xcd < r ? xcd * (q + 1) : r * (q + 1) + (xcd - r) * q) + off; }
    const int nig = WGM * nN, gid = wgid / nig, fm = gid * WGM, gsz = (nM - fm) < WGM ? (nM - fm) : WGM;
    const int pm = fm + ((wgid % nig) % gsz), pn = (wgid % nig) / gsz;
    u.a = pm; u.b = pn; u.c = 0; u.d = 0;
    u.A = A + (size_t)pm * BM * lda * 2; u.B = B + (size_t)pn * BM * ldb * 2; return true;
  }
  __device__ __forceinline__ void offs(const Unit&, const int (&R)[2], const int (&C)[2], unsigned (&o)[2][2]) const {
#pragma unroll
    for (int h = 0; h < 2; ++h)
#pragma unroll
      for (int i = 0; i < 2; ++i) o[h][i] = (unsigned)(R[i] * lda + C[i]) * 2u;
  }
};
}

__device__ __forceinline__ u32x4 pack8(const f32x4& a, const f32x4& b) { u32x4 w; w.x = pk2(a[0], a[1]); w.y = pk2(a[2], a[3]); w.z = pk2(b[0], b[1]); w.w = pk2(b[2], b[3]); return w; }

__device__ __forceinline__ __amdgpu_buffer_rsrc_t mk_rsrc(const void* base) { return __builtin_amdgcn_make_buffer_rsrc((void*)base, 0, 0x7fffffff, 0x00020000); }

__device__ __forceinline__ void rope4(f32x4& a, f32x4& b, const f32x2* cs) {
#pragma unroll
  for (int j = 0; j < 4; ++j) { const float c = cs[j].x, s = cs[j].y, x1 = a[j], x2 = b[j]; a[j] = x1 * c - x2 * s; b[j] = x1 * s + x2 * c; }
}

#define EPI_ROW(ri) (((ri) >> 2) * 128 + wr * 64 + ((ri) & 3) * 16 + fr)
#define EPI_FENCE() asm volatile("" ::: "memory")

struct EpiInproj {
  bf16_t* PROJ; const float* rs1; float* ssqp; const f32x2* CS;
  __device__ __forceinline__ void operator()(const f32x4 (&acc)[2][2][4][2], const g8::Unit& u, int wr, int wc, int fr, int fq) const {
    asm volatile("" : "+v"(fr), "+v"(fq));
    const int pm = u.a, pn = u.b;
    const bool cq0 = (pn == 6 || pn == 7), cq1 = (pn == 6), ckv0 = (pn == 8), ckv1 = (pn == 7);
    float rsv[8];
#pragma unroll
    for (int ri = 0; ri < 8; ++ri) rsv[ri] = rs1[pm * 256 + EPI_ROW(ri)];
#pragma unroll
    for (int ri = 0; ri < 8; ++ri) {
      EPI_FENCE();
      const int ai = ri >> 2, m = ri & 3;
      const int row = pm * 256 + EPI_ROW(ri);
      const float rs = rsv[ri];
      float sq = 0.f, skv = 0.f;
#pragma unroll
      for (int bj = 0; bj < 2; ++bj) {
        const int G = 8 * pn + 4 * bj + wc;
        f32x4 v0 = acc[ai][bj][m][0] * rs, v1 = acc[ai][bj][m][1] * rs;
        if (G == 68) {
          f32x2 cs[4];
#pragma unroll
          for (int j = 0; j < 4; ++j) cs[j] = CS[(size_t)row * 16 + 4 * fq + j];
          rope4(v0, v1, cs);
          u32x2 w0, w1; w0.x = pk2(v0[0], v0[1]); w0.y = pk2(v0[2], v0[3]); w1.x = pk2(v1[0], v1[1]); w1.y = pk2(v1[2], v1[3]);
          *(u32x2*)(PROJ + (size_t)row * NP + KR_OFF + 4 * fq) = w0;
          *(u32x2*)(PROJ + (size_t)row * NP + KR_OFF + 16 + 4 * fq) = w1;
        } else {
          *(u32x4*)(PROJ + (size_t)row * NP + 32 * G + 8 * fq) = pack8(v0, v1);
          const float s = (v0[0] * v0[0] + v0[1] * v0[1]) + (v0[2] * v0[2] + v0[3] * v0[3]) + (v1[0] * v1[0] + v1[1] * v1[1]) + (v1[2] * v1[2] + v1[3] * v1[3]);
          if (bj == 0 ? cq0 : cq1) sq += s;
          if (bj == 0 ? ckv0 : ckv1) skv += s;
        }
      }
      if (cq0) { sq += __shfl_xor(sq, 16); sq += __shfl_xor(sq, 32); if (fq == 0) ssqp[(size_t)row * 16 + (pn - 6) * 4 + wc] = sq; }
      if (ckv0 || ckv1) { skv += __shfl_xor(skv, 16); skv += __shfl_xor(skv, 32); if (fq == 0) ssqp[(size_t)row * 16 + 8 + (pn - 7) * 4 + wc] = skv; }
    }
  }
};

struct EpiUq {
  bf16_t* QB; const float* ssqp; const f32x2* CS; bool dry;
  __device__ __forceinline__ void operator()(const f32x4 (&acc)[2][2][4][2], const g8::Unit& u, int wr, int wc, int fr, int fq) const {
    asm volatile("" : "+v"(fr), "+v"(fq));
    const int pm = u.a, pn = u.b;
    const bool rope0 = ((8 * pn + wc) % 3) == 2, rope1 = ((8 * pn + 4 + wc) % 3) == 2;
    f32x4 na, nb;
    { const f32x4* pp = (const f32x4*)(ssqp + (size_t)(pm * 256 + EPI_ROW(0)) * 16); na = pp[0]; nb = pp[1]; }
#pragma unroll
    for (int ri = 0; ri < 8; ++ri) {
      const int ai = ri >> 2, m = ri & 3;
      const int row = pm * 256 + EPI_ROW(ri);
      const f32x4 a = na, b = nb;
      EPI_FENCE();
      if (ri < 7) { const f32x4* pp = (const f32x4*)(ssqp + (size_t)(pm * 256 + EPI_ROW(ri + 1)) * 16); na = pp[0]; nb = pp[1]; }
      const float ss = ((a[0] + a[1]) + (a[2] + a[3])) + ((b[0] + b[1]) + (b[2] + b[3]));
      const float rs = rsqrtf(ss * (1.f / 384.f) + EPS) * QSCALE;
#pragma unroll
      for (int bj = 0; bj < 2; ++bj) {
        const int G = 8 * pn + 4 * bj + wc;
        f32x4 v0 = acc[ai][bj][m][0] * rs, v1 = acc[ai][bj][m][1] * rs;
        if (bj == 0 ? rope0 : rope1) {
          f32x2 cs[4];
#pragma unroll
          for (int j = 0; j < 4; ++j) cs[j] = CS[(size_t)row * 16 + 4 * fq + j];
          rope4(v0, v1, cs);
          u32x2 w0, w1; w0.x = pk2(v0[0], v0[1]); w0.y = pk2(v0[2], v0[3]); w1.x = pk2(v1[0], v1[1]); w1.y = pk2(v1[2], v1[3]);
          if (!dry || w0.x == 0x12345679u) { *(u32x2*)(QB + (size_t)row * 768 + 32 * G + 4 * fq) = w0;
          *(u32x2*)(QB + (size_t)row * 768 + 32 * G + 16 + 4 * fq) = w1; }
        } else {
          { const u32x4 w_ = pack8(v0, v1); if (!dry || w_.x == 0x12345679u) *(u32x4*)(QB + (size_t)row * 768 + 32 * G + 8 * fq) = w_; }
        }
      }
    }
  }
};

struct EpiUkv {
  bf16_t* KVB; const float* ssqp; bool dry;
  __device__ __forceinline__ void operator()(const f32x4 (&acc)[2][2][4][2], const g8::Unit& u, int wr, int wc, int fr, int fq) const {
    asm volatile("" : "+v"(fr), "+v"(fq));
    const int pm = u.a, pn = u.b;
    float rsv[8];
#pragma unroll
    for (int ri = 0; ri < 8; ++ri) { const f32x4* pp = (const f32x4*)(ssqp + (size_t)(pm * 256 + EPI_ROW(ri)) * 16 + 8); const f32x4 a = pp[0], b = pp[1]; rsv[ri] = ((a[0] + a[1]) + (a[2] + a[3])) + ((b[0] + b[1]) + (b[2] + b[3])); }
#pragma unroll
    for (int ri = 0; ri < 8; ++ri) {
      const int ai = ri >> 2, m = ri & 3;
      const int row = pm * 256 + EPI_ROW(ri);
      const float rs = rsqrtf(rsv[ri] * (1.f / 256.f) + EPS);
#pragma unroll
      for (int bj = 0; bj < 2; ++bj) {
        const int G = 8 * pn + 4 * bj + wc;
        { const u32x4 w_ = pack8(acc[ai][bj][m][0] * rs, acc[ai][bj][m][1] * rs); if (!dry || w_.x == 0x12345679u) *(u32x4*)(KVB + (size_t)row * 1024 + 32 * G + 8 * fq) = w_; }
      }
    }
  }
};

struct EpiWout {
  const float* x; bf16_t* HB; unsigned char* H8;
  __device__ __forceinline__ void operator()(const f32x4 (&acc)[2][2][4][2], const g8::Unit& u, int wr, int wc, int fr, int fq) const {
    asm volatile("" : "+v"(fr), "+v"(fq));
    const int pm = u.a, pn = u.b;
#pragma unroll
    for (int half = 0; half < 2; ++half) {
      EPI_FENCE();
      u32x4 xr[4][2];
#pragma unroll
      for (int q = 0; q < 4; ++q) { const int row = pm * 256 + EPI_ROW(half * 4 + q);
#pragma unroll
        for (int bj = 0; bj < 2; ++bj) xr[q][bj] = *(const u32x4*)(HB + (size_t)row * 1024 + 32 * (8 * pn + 4 * bj + wc) + 8 * fq); }
#pragma unroll
      for (int q = 0; q < 4; ++q) {
        const int ri = half * 4 + q, ai = ri >> 2, m = ri & 3;
        const int row = pm * 256 + EPI_ROW(ri);
#pragma unroll
        for (int bj = 0; bj < 2; ++bj) {
          const size_t off = (size_t)row * 1024 + 32 * (8 * pn + 4 * bj + wc) + 8 * fq;
          const u32x4 xw = xr[q][bj];
          const f32x4 x0 = {bflo(xw.x), bfhi(xw.x), bflo(xw.y), bfhi(xw.y)}, x1 = {bflo(xw.z), bfhi(xw.z), bflo(xw.w), bfhi(xw.w)};
          const f32x4 v0 = acc[ai][bj][m][0] + x0, v1 = acc[ai][bj][m][1] + x1;
          *(u32x4*)(HB + off) = pack8(v0, v1);
#if MOE_FP8
          *(u32x2*)(H8 + off) = pk8_fp8(v0, v1, F8_SH);
#endif
        }
      }
    }
  }
};

template <bool GATHER_>
struct MoeSched {
  static constexpr bool GATHER = GATHER_;
  static constexpr bool A_SC1 = !GATHER_;
  const char* A; const char* B; int lda, ldb; int ncol, total, G, c;
  const LAS int* tb; const LAS int* cn; const int* ltok; size_t bstride;
  int n1, r; const int* flg;
  __device__ __forceinline__ bool next(int i, g8::Unit& u) const {
    long L = (long)i * G + c;
    if (!GATHER_ && i >= n1) { if (c < r) return false; L = (long)n1 * G + (long)(i - n1) * (G - r) + (c - r); }
    if (L >= total) return false;
    const int rt = (int)(L / ncol), pn = (int)(L % ncol);
    if (!GATHER_) { unsigned sp_ = 0; while (__hip_atomic_load(flg + rt, __ATOMIC_RELAXED, __HIP_MEMORY_SCOPE_AGENT) < 16) { __builtin_amdgcn_s_sleep(2); if (++sp_ > (1u << 22)) break; } }
    int e = 0;
#pragma unroll 1
    for (int k = 1; k < NEXP; ++k) if (tb[k] <= rt) e = k;
    e = __builtin_amdgcn_readfirstlane(e);
    const int mt = rt - tb[e];
    u.a = e; u.b = mt; u.c = pn; u.d = rt;
    u.B = B + (size_t)e * bstride + (size_t)pn * 256 * ldb * 2;
    u.A = GATHER_ ? A : A + (size_t)rt * 256 * lda * 2;
    return true;
  }
  __device__ __forceinline__ void offs(const g8::Unit& u, const int (&R)[2], const int (&C)[2], unsigned (&o)[2][2]) const {
    if (GATHER_) {
      const int cnt = cn[u.a];
#pragma unroll
      for (int h = 0; h < 2; ++h)
#pragma unroll
        for (int i = 0; i < 2; ++i) { int pos = u.b * 256 + h * 128 + R[i]; pos = pos < cnt ? pos : cnt - 1; const int tok = ltok[u.a * ECAP + pos] >> 1;
          o[h][i] = (unsigned)(tok * lda + C[i]) * 2u; }
    } else {
#pragma unroll
      for (int h = 0; h < 2; ++h)
#pragma unroll
        for (int i = 0; i < 2; ++i) o[h][i] = (unsigned)(R[i] * lda + C[i]) * 2u;
    }
  }
};

struct EpiGU {
  bf16_t* HID; const float* rs2; const int* ltok; const LAS int* cn; bool dry; int* flg;
  __device__ __forceinline__ void operator()(const f32x4 (&acc)[2][2][4][2], const g8::Unit& u, int wr, int wc, int fr, int fq) const {
    asm volatile("" : "+v"(fr), "+v"(fq));
    const int e = u.a, mt = u.b, pn = u.c, rt = u.d; const int cnt = cn[e];
    const __amdgpu_buffer_rsrc_t rsrc = mk_rsrc(HID);
    float rsa[8];
#pragma unroll
    for (int ri = 0; ri < 8; ++ri) { int pos = mt * 256 + EPI_ROW(ri); pos = pos < cnt ? pos : cnt - 1; rsa[ri] = rs2[e * ECAP + pos]; }
#pragma unroll
    for (int half = 0; half < 2; ++half) {
      EPI_FENCE();
#pragma unroll
      for (int q = 0; q < 4; ++q) {
        const int ri = half * 4 + q, ai = ri >> 2, m = ri & 3;
        const int r = EPI_ROW(ri), pos = mt * 256 + r;
        if (pos < cnt) {
          const float rs = rsa[ri] * (MOE_FP8 ? 1.f / (F8_SH * F8_SWGU) : 1.f);
          f32x4 h0, h1;
#pragma unroll
          for (int j = 0; j < 4; ++j) {
            const float g0 = acc[ai][0][m][0][j] * rs, u0 = acc[ai][1][m][0][j] * rs, g1 = acc[ai][0][m][1][j] * rs, u1 = acc[ai][1][m][1][j] * rs;
            h0[j] = g0 * __builtin_amdgcn_rcpf(1.f + __expf(-g0)) * u0; h1[j] = g1 * __builtin_amdgcn_rcpf(1.f + __expf(-g1)) * u1;
          }
#if MOE_FP8
          __builtin_amdgcn_raw_buffer_store_b64(pk8_fp8(h0, h1, F8_SHID), rsrc, (int)((unsigned)((rt * 256 + r) * 256 + pn * 128 + wc * 32 + 8 * fq)), 0, 16);
#else
          { const u32x4 w_ = pack8(h0, h1); if (!dry || w_.x == 0x12345679u) __builtin_amdgcn_raw_buffer_store_b128(w_, rsrc, (int)((unsigned)(((rt * 256 + r) * 256 + pn * 128 + wc * 32 + 8 * fq) * 2)), 0, 16); }
#endif
        }
      }
    }
    asm volatile("s_waitcnt vmcnt(0)" ::: "memory");
    if (fr == 0 && fq == 0) __hip_atomic_fetch_add(flg + rt, 1, __ATOMIC_RELAXED, __HIP_MEMORY_SCOPE_AGENT);
  }
};

struct EpiDown {
  bf16_t* Y2; const int* ltok; const float* lgate; const LAS int* cn; bool dry;
  __device__ __forceinline__ void operator()(const f32x4 (&acc)[2][2][4][2], const g8::Unit& u, int wr, int wc, int fr, int fq) const {
    asm volatile("" : "+v"(fr), "+v"(fq));
    const int e = u.a, mt = u.b, pn = u.c; const int cnt = cn[e];
    int ds[8]; float gv[8];
#pragma unroll
    for (int ri = 0; ri < 8; ++ri) { int pos = mt * 256 + EPI_ROW(ri); pos = pos < cnt ? pos : cnt - 1; ds[ri] = ltok[e * ECAP + pos]; gv[ri] = lgate[e * ECAP + pos]; }
#pragma unroll
    for (int ri = 0; ri < 8; ++ri) {
      const int ai = ri >> 2, m = ri & 3;
      const int pos = mt * 256 + EPI_ROW(ri);
      if (pos < cnt) {
        const float g = gv[ri] * (MOE_FP8 ? 1.f / (F8_SHID * F8_SWD) : 1.f);
#pragma unroll
        for (int bj = 0; bj < 2; ++bj)
          { const u32x4 w_ = pack8(acc[ai][bj][m][0] * g, acc[ai][bj][m][1] * g); if (!dry || w_.x == 0x12345679u) *(u32x4*)(Y2 + (size_t)ds[ri] * 1024 + pn * 256 + wc * 64 + bj * 32 + 8 * fq) = w_; }
      }
    }
  }
};

__device__ __forceinline__ int inproj_src_col(int L) {
  if (L < 1024) return L;
  if (L < 1536) return 1040 + (L - 1024);
  if (L < 1920) return 1552 + (L - 1536);
  if (L < 2176) return 1936 + (L - 1920);
  if (L < 2208) return 2192 + (L - 2176);
  if (L < 2224) return 1024 + (L - 2208);
  return -1;
}
__device__ __forceinline__ void tr_item(const float* src, int ld, int cbase, int nvalid, bool permute, const float* kscale, int k0, bf16_t* dst, int K, LAS float* scr, int lane) {
  if (nvalid > 0) {
    f32x4 v[8];
#pragma unroll
    for (int i = 0; i < 8; ++i) v[i] = *(const f32x4*)(src + (size_t)(k0 + i * 8 + (lane >> 3)) * ld + cbase + (lane & 7) * 4);
#pragma unroll
    for (int i = 0; i < 8; ++i) { const int kk = i * 8 + (lane >> 3); const float sc = kscale ? kscale[k0 + kk] : 1.f; LAS float* w = scr + kk * 33 + (lane & 7) * 4;
      w[0] = v[i].x * sc; w[1] = v[i].y * sc; w[2] = v[i].z * sc; w[3] = v[i].w * sc; }
  }
  LDS_WAIT();
  const int c = lane & 7;
#pragma unroll
  for (int j = 0; j < 4; ++j) { const int n = (lane >> 3) + 8 * j; const int sc_ = permute ? perm32(n) : n; const LAS float* s = scr + (8 * c) * 33 + sc_;
    u32x4 o = {0u, 0u, 0u, 0u};
    if (sc_ < nvalid) { o.x = pk2(s[0 * 33], s[1 * 33]); o.y = pk2(s[2 * 33], s[3 * 33]); o.z = pk2(s[4 * 33], s[5 * 33]); o.w = pk2(s[6 * 33], s[7 * 33]); }
    *(u32x4*)(dst + (size_t)n * K + 8 * c) = o; }
  LDS_WAIT();
}
__device__ __forceinline__ void tr_item8(const float* src, int ld, int cbase, const float* kscale, float gscale, int k0, unsigned char* dst, int K8, LAS float* scr, int lane) {
  f32x4 v[8];
#pragma unroll
  for (int i = 0; i < 8; ++i) v[i] = *(const f32x4*)(src + (size_t)(k0 + i * 8 + (lane >> 3)) * ld + cbase + (lane & 7) * 4);
#pragma unroll
  for (int i = 0; i < 8; ++i) { const int kk = i * 8 + (lane >> 3); const float sc = kscale ? kscale[k0 + kk] : 1.f; LAS float* w = scr + kk * 33 + (lane & 7) * 4;
    w[0] = v[i].x * sc; w[1] = v[i].y * sc; w[2] = v[i].z * sc; w[3] = v[i].w * sc; }
  LDS_WAIT();
  const int c = lane & 7;
#pragma unroll
  for (int j = 0; j < 4; ++j) { const int n = (lane >> 3) + 8 * j; const LAS float* s = scr + (8 * c) * 33 + perm32(n);
    const f32x4 a = {s[0 * 33], s[1 * 33], s[2 * 33], s[3 * 33]}, b = {s[4 * 33], s[5 * 33], s[6 * 33], s[7 * 33]};
    *(u32x2*)(dst + (size_t)n * K8 + 8 * c) = pk8_fp8(a, b, gscale); }
  LDS_WAIT();
}
__device__ __forceinline__ void tr_item_s(const float* src, int ld, int col, const float* kscale, int k0, bf16_t* dst, int K, LAS float* scr, int lane) {
#pragma unroll 8
  for (int i = 0; i < 32; ++i) { const int kk = 2 * i + (lane >> 5); float v = 0.f;
    if (col >= 0) { v = src[(size_t)(k0 + kk) * ld + col]; if (kscale) v *= kscale[k0 + kk]; }
    scr[kk * 33 + (lane & 31)] = v; }
  LDS_WAIT();
  const int c = lane & 7;
#pragma unroll
  for (int j = 0; j < 4; ++j) { const int n = (lane >> 3) + 8 * j; const LAS float* s = scr + (8 * c) * 33 + n;
    u32x4 o; o.x = pk2(s[0 * 33], s[1 * 33]); o.y = pk2(s[2 * 33], s[3 * 33]); o.z = pk2(s[4 * 33], s[5 * 33]); o.w = pk2(s[6 * 33], s[7 * 33]);
    *(u32x4*)(dst + (size_t)n * K + 8 * c) = o; }
  LDS_WAIT();
}

__device__ __forceinline__ void conv_gu_item(const Params& p, int r, LAS float* scr, int lane) {
  const int e = r / 256, kb = (r % 256) / 16, nb = r % 16;
  const int pn = nb >> 3, bj = (nb >> 2) & 1;
  const float* src = (bj ? p.in[18] : p.in[17]) + (size_t)e * 1024 * 256;
#if MOE_FP8
  tr_item8(src, 256, 128 * pn + 32 * (nb & 3), p.in[12], F8_SWGU, kb * 64, p.ws + WS_WGU + ((size_t)e * 512 + nb * 32) * 1024 + kb * 64, 1024, scr, lane);
#else
  tr_item(src, 256, 128 * pn + 32 * (nb & 3), 32, true, p.in[12], kb * 64, (bf16_t*)(p.ws + WS_WGU) + ((size_t)e * 512 + nb * 32) * 1024 + kb * 64, 1024, scr, lane);
#endif
}
__device__ __forceinline__ int glog8(int nb) { return (nb & ~7) + 2 * (nb & 3) + ((nb >> 2) & 1); }
__device__ __forceinline__ void conv_d_item(const Params& p, int r, LAS float* scr, int lane) {
  const int e = r / 128, kb = (r % 128) / 32, nb = r % 32;
#if MOE_FP8
  tr_item8(p.in[19] + (size_t)e * 256 * 1024, 1024, 32 * glog8(nb), nullptr, F8_SWD, kb * 64, p.ws + WS_WD + ((size_t)e * 1024 + nb * 32) * 256 + kb * 64, 256, scr, lane);
#else
  tr_item(p.in[19] + (size_t)e * 256 * 1024, 1024, 32 * glog8(nb), 32, true, nullptr, kb * 64, (bf16_t*)(p.ws + WS_WD) + ((size_t)e * 1024 + nb * 32) * 256 + kb * 64, 256, scr, lane);
#endif
}
constexpr int CONV_GU_P0 = 2048, CONV_GU_P1 = 4096, CONV_GU_P2 = 2048;
constexpr int CONV_D_P1 = 4096;

__device__ __forceinline__ void p0_prologue(const Params& p, LAS unsigned char* lds, int G, int vb) {
  const int tid = threadIdx.x, lane = tid & 63, wave = tid >> 6;
  LAS float* scr = (LAS float*)(lds + wave * 8704);
  const int gw = vb * 8 + wave, NGW = G * 8;
  unsigned char* ws = p.ws;
  const float* attn_nw = p.in[2]; const float* w_in = p.in[3];
  const float* qnw = p.in[7]; const float* w_uq = p.in[8]; const float* kvnw = p.in[9]; const float* w_ukv = p.in[10];
  const float* w_out = p.in[11]; const float* fnw = p.in[12]; const float* rgw = p.in[13]; const float* rew = p.in[15];
  const float* ewg = p.in[17]; const float* ewu = p.in[18]; const float* ewd = p.in[19];
  constexpr int I_IN = 16 * 72, I_UQ = 6 * 24, I_UKV = 4 * 32, I_OUT = 16 * 32, I_R = 16 * 2, I_GU = 32 * 16 * 16, I_D = 32 * 4 * 32;
  const int n = lane & 31;
  const int NITEMS = I_IN + I_UQ + I_UKV + I_OUT + I_R + ((G == 256) ? CONV_GU_P0 : I_GU + I_D);
  auto xconv = [&]() {
    const float* x = p.in[0]; bf16_t* XB = (bf16_t*)(ws + WS_XB); float* rs1 = (float*)(ws + WS_RS1);
    f32x4 v[4], w[4];
    { const int m = gw, m2 = m + NGW;
      const f32x4* xr = (const f32x4*)(x + (size_t)(m < NTOK ? m : 0) * DM) + lane; const f32x4* xr2 = (const f32x4*)(x + (size_t)(m2 < NTOK ? m2 : 0) * DM) + lane;
#pragma unroll
      for (int j = 0; j < 4; ++j) { v[j] = xr[64 * j]; w[j] = xr2[64 * j]; } }
#pragma unroll 1
    for (int m = gw; m < NTOK; m += 2 * NGW) {
      const int m2 = m + NGW; const bool has2 = m2 < NTOK;
      const int mn = m + 2 * NGW, mn2 = mn + NGW;
      f32x4 nv[4], nw[4];
      { const f32x4* xr = (const f32x4*)(x + (size_t)(mn < NTOK ? mn : m) * DM) + lane; const f32x4* xr2 = (const f32x4*)(x + (size_t)(mn2 < NTOK ? mn2 : m) * DM) + lane;
#pragma unroll
        for (int j = 0; j < 4; ++j) { nv[j] = xr[64 * j]; nw[j] = xr2[64 * j]; } }
      float s = 0.f, s2 = 0.f;
#pragma unroll
      for (int j = 0; j < 4; ++j) { s += (v[j].x * v[j].x + v[j].y * v[j].y) + (v[j].z * v[j].z + v[j].w * v[j].w); s2 += (w[j].x * w[j].x + w[j].y * w[j].y) + (w[j].z * w[j].z + w[j].w * w[j].w); }
      s = wave_sum(s); s2 = wave_sum(s2);
      if (lane == 0) { rs1[m] = rsqrtf(s * (1.f / DM) + EPS); if (has2) rs1[m2] = rsqrtf(s2 * (1.f / DM) + EPS); }
      u32x2* o8 = (u32x2*)(XB + (size_t)m * DM) + lane; u32x2* o82 = (u32x2*)(XB + (size_t)m2 * DM) + lane;
#pragma unroll
      for (int j = 0; j < 4; ++j) { u32x2 q; q.x = pk2(v[j].x, v[j].y); q.y = pk2(v[j].z, v[j].w); o8[64 * j] = q; }
      if (has2) {
#pragma unroll
        for (int j = 0; j < 4; ++j) { u32x2 q; q.x = pk2(w[j].x, w[j].y); q.y = pk2(w[j].z, w[j].w); o82[64 * j] = q; }
      }
#pragma unroll
      for (int j = 0; j < 4; ++j) { v[j] = nv[j]; w[j] = nw[j]; }
    }
  };
  auto wconv = [&]() {
  for (int it = gw; it < NITEMS; it += NGW) {
    int r = it;
    if (r < I_IN) { const int kb = r / 72, nb = r % 72; const int c0 = inproj_src_col(32 * nb); const int nv = (nb < 69) ? 32 : (nb == 69 ? 16 : 0);
      tr_item(w_in, 2224, c0 < 0 ? 0 : c0, nv, nb != 68, attn_nw, kb * 64, (bf16_t*)(ws + WS_WIN) + (size_t)(nb * 32) * 1024 + kb * 64, 1024, scr, lane); continue; }
    r -= I_IN;
    if (r < I_UQ) { const int kb = r / 24, nb = r % 24;
      tr_item(w_uq, 768, 32 * nb, 32, (nb % 3) != 2, qnw, kb * 64, (bf16_t*)(ws + WS_WUQ) + (size_t)(nb * 32) * 384 + kb * 64, 384, scr, lane); continue; }
    r -= I_UQ;
    if (r < I_UKV) { const int kb = r / 32, nb = r % 32;
      tr_item(w_ukv, 1024, 32 * nb, 32, true, kvnw, kb * 64, (bf16_t*)(ws + WS_WUKV) + (size_t)(nb * 32) * 256 + kb * 64, 256, scr, lane); continue; }
    r -= I_UKV;
    if (r < I_OUT) { const int kb = r / 32, nb = r % 32;
      tr_item(w_out, 1024, 32 * nb, 32, true, nullptr, kb * 64, (bf16_t*)(ws + WS_WOUT) + (size_t)(nb * 32) * 1024 + kb * 64, 1024, scr, lane); continue; }
    r -= I_OUT;
    if (r < I_R) { const int kb = r / 2, nb = r % 2; const int Rr = nb * 32 + n;
      const float* src = (Rr < 4) ? rgw : rew; const int ld = (Rr < 4) ? 4 : 32; const int col = (Rr < 4) ? Rr : (Rr < 36 ? Rr - 4 : -1);
      tr_item_s(src, ld, col, fnw, kb * 64, (bf16_t*)(ws + WS_WR) + (size_t)(nb * 32) * 1024 + kb * 64, 1024, scr, lane); continue; }
    r -= I_R;
    if (r < I_GU) { conv_gu_item(p, r, scr, lane); continue; }
    r -= I_GU;
    conv_d_item(p, r, scr, lane);
  }
  };
  if (wave & 1) { xconv(); wconv(); } else { wconv(); xconv(); }
  const int gt = vb * 512 + tid, NGT = G * 512;
  const int* pos = (const int*)p.in[1]; f32x2* CS = (f32x2*)(ws + WS_CS);
  const float inv = powf(10000.0f, -(float)(gt & 15) / 16.0f);
  for (int i = gt; i < NTOK * 16; i += NGT) {
    const int row = i >> 4;
    const float ang = (float)pos[row] * inv;
    const double rev = (double)ang * 0.15915494309189535; const float frc = (float)(rev - floor(rev));
    CS[i] = (f32x2){__builtin_amdgcn_cosf(frc), __builtin_amdgcn_sinf(frc)};
  }
  if (gt < NEXP) ((int*)(ws + WS_CNT))[gt] = 0;
  if (gt < 512) ((int*)(ws + WS_FLG))[gt] = 0;
  if (gt < 4096) { const int dd = gt >> 4, rr = gt & 15; ((bf16_t*)(ws + WS_GUT))[gt] = (bf16_t)(pk2(p.in[4][rr * 256 + dd], 0.f) & 0xffffu); }
#if !ENABLE_GLA || !ENABLE_MLA
  { u32x4* Y = (u32x4*)(ws + WS_Y); for (int i = gt; i < NTOK * 1024 / 8; i += NGT) Y[i] = (u32x4){0u, 0u, 0u, 0u}; }
#endif
}

constexpr int AT_KSTR = 208;
constexpr int AT_KBUF = 64 * AT_KSTR, AT_VBUF = 8192;
constexpr int AT_KOFF = 0, AT_VOFF = 2 * AT_KBUF;
typedef short v4i16_t __attribute__((ext_vector_type(4)));
__device__ __forceinline__ s16x4 vtr(const LAS unsigned char* p) { return __builtin_bit_cast(s16x4, __builtin_amdgcn_ds_read_tr16_b64_v4i16((LAS v4i16_t*)p)); }

template <bool DO_NEXT>
__device__ __forceinline__ void attn_step(const LAS unsigned char* Kn, const LAS unsigned char* Vc, const bf16x8 (&qf)[6], f32x16& pc0, f32x16& pc1, f32x16& pn0, f32x16& pn1,
                                          f32x16& o0, f32x16& o1, float& mrun, float& lrun, const bool first, const bool diag, const int kb, const int qabs, const int r32, const int hi, const int voffl) {
  const LAS unsigned char* Kb = Kn + r32 * AT_KSTR + hi * 16;
  bf16x8 kf[6];
#pragma unroll
  for (int d0 = 0; d0 < 3; ++d0) { kf[2 * d0] = *(const LAS bf16x8*)(Kb + d0 * 32); kf[2 * d0 + 1] = *(const LAS bf16x8*)(Kb + 32 * AT_KSTR + d0 * 32); }
  __builtin_amdgcn_sched_barrier(0);
  if (diag) {
#pragma unroll
    for (int r = 0; r < 16; ++r) { const int kv = kb + 4 * hi + (r & 3) + 8 * (r >> 2); if (kv > qabs) pc0[r] = -INFINITY; if (kv + 32 > qabs) pc1[r] = -INFINITY; }
  }
  float ma = fmaxf(fmaxf(pc0[0], pc0[1]), pc1[0]), mb = fmaxf(fmaxf(pc0[2], pc0[3]), pc1[1]);
  ma = fmaxf(fmaxf(ma, pc1[2]), pc1[3]);
#pragma unroll
  for (int r = 4; r < 16; r += 4) { ma = fmaxf(fmaxf(ma, pc0[r]), pc0[r + 1]); mb = fmaxf(fmaxf(mb, pc0[r + 2]), pc0[r + 3]); ma = fmaxf(fmaxf(ma, pc1[r]), pc1[r + 1]); mb = fmaxf(fmaxf(mb, pc1[r + 2]), pc1[r + 3]); }
  float mt = fmaxf(ma, mb);
  { auto rr = __builtin_amdgcn_permlane32_swap(__float_as_uint(mt), __float_as_uint(mt), false, false); mt = fmaxf(__uint_as_float(rr[0]), __uint_as_float(rr[1])); }
  if (first || __any(mt > 8.0f)) {
    const float dl = first ? mt : fmaxf(mt, 0.f);
    mrun += dl;
    const float alpha = __builtin_amdgcn_exp2f(-dl);
    lrun *= alpha;
#pragma unroll
    for (int r = 0; r < 16; ++r) { pc0[r] -= dl; pc1[r] -= dl; o0[r] *= alpha; o1[r] *= alpha; }
  }
  const LAS unsigned char* Vb = Vc + voffl;
  f32x16 negm;
#pragma unroll
  for (int r = 0; r < 16; ++r) negm[r] = -mrun;
  if (DO_NEXT) {
#pragma unroll
    for (int d0 = 0; d0 < 3; ++d0) {
      pn0 = __builtin_amdgcn_mfma_f32_32x32x16_bf16(kf[2 * d0], qf[d0], d0 ? pn0 : negm, 0, 0, 0);
      pn1 = __builtin_amdgcn_mfma_f32_32x32x16_bf16(kf[2 * d0 + 1], qf[d0], d0 ? pn1 : negm, 0, 0, 0);
    }
  }
  __builtin_amdgcn_sched_barrier(0);
#pragma unroll
  for (int d0 = 3; d0 < 6; ++d0) { kf[2 * (d0 - 3)] = *(const LAS bf16x8*)(Kb + d0 * 32); kf[2 * (d0 - 3) + 1] = *(const LAS bf16x8*)(Kb + 32 * AT_KSTR + d0 * 32); }
  s16x4 vl[4], vh[4];
#pragma unroll
  for (int ks = 0; ks < 2; ++ks) { vl[2 * ks] = vtr(Vb + ks * 1024); vh[2 * ks] = vtr(Vb + ks * 1024 + 512); vl[2 * ks + 1] = vtr(Vb + 4096 + ks * 1024); vh[2 * ks + 1] = vtr(Vb + 4096 + ks * 1024 + 512); }
  __builtin_amdgcn_sched_barrier(0);
#pragma unroll
  for (int r = 0; r < 16; ++r) { pc0[r] = __builtin_amdgcn_exp2f(pc0[r]); pc1[r] = __builtin_amdgcn_exp2f(pc1[r]); }
  if (DO_NEXT) {
#pragma unroll
    for (int d0 = 3; d0 < 6; ++d0) {
      pn0 = __builtin_amdgcn_mfma_f32_32x32x16_bf16(kf[2 * (d0 - 3)], qf[d0], pn0, 0, 0, 0);
      pn1 = __builtin_amdgcn_mfma_f32_32x32x16_bf16(kf[2 * (d0 - 3) + 1], qf[d0], pn1, 0, 0, 0);
    }
  }
  float sacc = pc0[0] + pc1[0];
#pragma unroll
  for (int r = 1; r < 16; ++r) { sacc += pc0[r]; sacc += pc1[r]; if ((r & 1) == 1) asm volatile("" : "+v"(sacc)); }
  lrun += sacc;
  u32x4 pw[4];
#pragma unroll
  for (int s = 0; s < 2; ++s) {
    pw[s] = (u32x4){pk2(pc0[8 * s + 0], pc0[8 * s + 1]), pk2(pc0[8 * s + 2], pc0[8 * s + 3]), pk2(pc0[8 * s + 4], pc0[8 * s + 5]), pk2(pc0[8 * s + 6], pc0[8 * s + 7])};
    pw[2 + s] = (u32x4){pk2(pc1[8 * s + 0], pc1[8 * s + 1]), pk2(pc1[8 * s + 2], pc1[8 * s + 3]), pk2(pc1[8 * s + 4], pc1[8 * s + 5]), pk2(pc1[8 * s + 6], pc1[8 * s + 7])};
  }
  s16x4 wl[4], wh[4];
#pragma unroll
  for (int ks = 2; ks < 4; ++ks) { wl[2 * (ks - 2)] = vtr(Vb + ks * 1024); wh[2 * (ks - 2)] = vtr(Vb + ks * 1024 + 512); wl[2 * (ks - 2) + 1] = vtr(Vb + 4096 + ks * 1024); wh[2 * (ks - 2) + 1] = vtr(Vb + 4096 + ks * 1024 + 512); }
  __builtin_amdgcn_sched_barrier(0);
#pragma unroll
  for (int ks = 0; ks < 2; ++ks) {
    const bf16x8 vf0 = {vl[2 * ks][0], vl[2 * ks][1], vl[2 * ks][2], vl[2 * ks][3], vh[2 * ks][0], vh[2 * ks][1], vh[2 * ks][2], vh[2 * ks][3]};
    const bf16x8 vf1 = {vl[2 * ks + 1][0], vl[2 * ks + 1][1], vl[2 * ks + 1][2], vl[2 * ks + 1][3], vh[2 * ks + 1][0], vh[2 * ks + 1][1], vh[2 * ks + 1][2], vh[2 * ks + 1][3]};
    const bf16x8 pf = __builtin_bit_cast(bf16x8, pw[ks]);
    o0 = __builtin_amdgcn_mfma_f32_32x32x16_bf16(vf0, pf, o0, 0, 0, 0);
    o1 = __builtin_amdgcn_mfma_f32_32x32x16_bf16(vf1, pf, o1, 0, 0, 0);
  }
#pragma unroll
  for (int ks = 2; ks < 4; ++ks) { const int q = 2 * (ks - 2);
    const bf16x8 vf0 = {wl[q][0], wl[q][1], wl[q][2], wl[q][3], wh[q][0], wh[q][1], wh[q][2], wh[q][3]};
    const bf16x8 vf1 = {wl[q + 1][0], wl[q + 1][1], wl[q + 1][2], wl[q + 1][3], wh[q + 1][0], wh[q + 1][1], wh[q + 1][2], wh[q + 1][3]};
    const bf16x8 pf = __builtin_bit_cast(bf16x8, pw[ks]);
    o0 = __builtin_amdgcn_mfma_f32_32x32x16_bf16(vf0, pf, o0, 0, 0, 0);
    o1 = __builtin_amdgcn_mfma_f32_32x32x16_bf16(vf1, pf, o1, 0, 0, 0);
  }
}
__device__ __forceinline__ void attn_qk0(const LAS unsigned char* Kt, const bf16x8 (&qf)[6], f32x16& p0, f32x16& p1, const int r32, const int hi) {
  const LAS unsigned char* Kb = Kt + r32 * AT_KSTR + hi * 16;
  const f32x16 z = {};
#pragma unroll
  for (int d0 = 0; d0 < 6; ++d0) {
    const bf16x8 a0 = *(const LAS bf16x8*)(Kb + d0 * 32), a1 = *(const LAS bf16x8*)(Kb + 32 * AT_KSTR + d0 * 32);
    p0 = __builtin_amdgcn_mfma_f32_32x32x16_bf16(a0, qf[d0], d0 ? p0 : z, 0, 0, 0);
    p1 = __builtin_amdgcn_mfma_f32_32x32x16_bf16(a1, qf[d0], d0 ? p1 : z, 0, 0, 0);
  }
}

template <int MODE>
__device__ __forceinline__ void attn_unit(const Params& p, LAS unsigned char* lds, int b, int h, int qb) {
  int tid_ = threadIdx.x; asm volatile("" : "+v"(tid_));
  const int tid = tid_, lane = tid & 63, r32 = lane & 31, hi = lane >> 5; const int wid = __builtin_amdgcn_readfirstlane(tid >> 6);
  const bf16_t* QB = (const bf16_t*)(p.ws + WS_QB); const bf16_t* KVB = (const bf16_t*)(p.ws + WS_KVB); const bf16_t* PROJ = (const bf16_t*)(p.ws + WS_PROJ);
  bf16_t* Y = (bf16_t*)(p.ws + WS_Y);
  const size_t rowbase = (size_t)b * SEQ; const int q0 = qb * 256;
  bf16x8 qf[6];
  { const bf16_t* qrow = QB + (rowbase + q0 + wid * 32 + r32) * 768 + h * 96 + hi * 8;
#pragma unroll
    for (int d0 = 0; d0 < 6; ++d0) qf[d0] = *(const bf16x8*)(qrow + d0 * 16); }
  f32x16 o0 = {}, o1 = {}; float mrun = 0.f, lrun = 0.f;
  const int NT = 4 * (qb + 1);
  const int id0 = tid, id1 = (tid < 256) ? tid + 512 : tid;
  const int kv0 = id0 / 12, c0 = id0 % 12, kv1 = id1 / 12, c1 = id1 % 12;
  const bf16_t* ks0 = (c0 < 8) ? KVB + (rowbase + kv0) * 1024 + h * 128 + c0 * 8 : PROJ + (rowbase + kv0) * NP + KR_OFF + (c0 - 8) * 8;
  const size_t kstr0 = (c0 < 8) ? (size_t)64 * 1024 : (size_t)64 * NP;
  const bf16_t* ks1 = (c1 < 8) ? KVB + (rowbase + kv1) * 1024 + h * 128 + c1 * 8 : PROJ + (rowbase + kv1) * NP + KR_OFF + (c1 - 8) * 8;
  const size_t kstr1 = (c1 < 8) ? (size_t)64 * 1024 : (size_t)64 * NP;
  const int kd0 = kv0 * AT_KSTR + c0 * 16, kd1 = kv1 * AT_KSTR + c1 * 16;
  const int vkv = tid >> 3, vc = tid & 7;
  const bf16_t* vs = KVB + (rowbase + vkv) * 1024 + h * 128 + 64 + vc * 8;
  const int vd = (vc >> 2) * 4096 + vkv * 64 + (vc & 3) * 16;
  u32x4 kA0 = {}, kA1 = {}, vA = {}, kB0 = {}, kB1 = {}, vB = {};
#define AT_LOADK(K0, K1, u) do { if (MODE == 2) break; const int u_ = (MODE == 1) ? 0 : ((u) < NT ? (u) : NT - 1); K0 = *(const u32x4*)(ks0 + (size_t)u_ * kstr0); K1 = *(const u32x4*)(ks1 + (size_t)u_ * kstr1); } while (0)
#define AT_LOADV(V, u) do { if (MODE == 2) break; const int u_ = (MODE == 1) ? 0 : ((u) < NT ? (u) : NT - 1); V = *(const u32x4*)(vs + (size_t)u_ * 64 * 1024); } while (0)
#define AT_STOREK(K0, K1, buf) do { *(LAS u32x4*)(lds + AT_KOFF + (buf) * AT_KBUF + kd0) = K0; *(LAS u32x4*)(lds + AT_KOFF + (buf) * AT_KBUF + kd1) = K1; } while (0)
#define AT_STOREV(V, buf) do { *(LAS u32x4*)(lds + AT_VOFF + (buf) * AT_VBUF + vd) = V; } while (0)
  AT_LOADK(kA0, kA1, 0); AT_LOADV(vA, 0); AT_LOADK(kB0, kB1, 1);
  AT_STOREK(kA0, kA1, 0); AT_STOREV(vA, 0); AT_STOREK(kB0, kB1, 1);
  AT_LOADK(kA0, kA1, 2); AT_LOADV(vB, 1); AT_LOADK(kB0, kB1, 3); AT_LOADV(vA, 2);
  LBAR();
  const int qabs = q0 + wid * 32 + r32;
  const int voffl = ((lane >> 4) & 1) * 32 + (lane & 3) * 8 + (4 * hi + ((lane & 15) >> 2)) * 64;
  const int wlast = q0 + wid * 32 + 31;
  f32x16 pa0, pa1, pb0, pb1;
  if (wid >= 4) __builtin_amdgcn_s_setprio(1);
  attn_qk0(lds + AT_KOFF, qf, pa0, pa1, r32, hi);
  LBAR();
#pragma unroll 1
  for (int t = 0; t < NT; t += 2) {
    if (MODE != 3 && t * 64 <= wlast) {
      attn_step<true>(lds + AT_KOFF + AT_KBUF, lds + AT_VOFF, qf, pa0, pa1, pb0, pb1, o0, o1, mrun, lrun, t == 0, t >= NT - 4, t * 64, qabs, r32, hi, voffl);
    }
    AT_STOREK(kA0, kA1, 0); AT_STOREV(vB, 1);
    AT_LOADK(kA0, kA1, t + 4); AT_LOADV(vB, t + 3);
    LBAR();
    if (MODE != 3 && (t + 1) * 64 <= wlast) {
      attn_step<true>(lds + AT_KOFF, lds + AT_VOFF + AT_VBUF, qf, pb0, pb1, pa0, pa1, o0, o1, mrun, lrun, false, t + 1 >= NT - 4, (t + 1) * 64, qabs, r32, hi, voffl);
    }
    AT_STOREK(kB0, kB1, 1); AT_STOREV(vA, 0);
    AT_LOADK(kB0, kB1, t + 5); AT_LOADV(vA, t + 4);
    LBAR();
  }
#undef AT_LOADK
#undef AT_LOADV
#undef AT_STOREK
#undef AT_STOREV
  __builtin_amdgcn_s_setprio(0);
  lrun += __shfl_xor(lrun, 32);
  const float inv = __builtin_amdgcn_rcpf(lrun);
  bf16_t* dst = Y + (rowbase + q0 + wid * 32 + r32) * 1024 + 512 + h * 64 + 4 * hi;
#pragma unroll
  for (int g = 0; g < 4; ++g) {
    u32x2 w0, w1; w0.x = pk2(o0[4 * g] * inv, o0[4 * g + 1] * inv); w0.y = pk2(o0[4 * g + 2] * inv, o0[4 * g + 3] * inv);
    w1.x = pk2(o1[4 * g] * inv, o1[4 * g + 1] * inv); w1.y = pk2(o1[4 * g + 2] * inv, o1[4 * g + 3] * inv);
    if (MODE == 0 || w0.x == 0x12345679u) { *(u32x2*)(dst + 8 * g) = w0; *(u32x2*)(dst + 32 + 8 * g) = w1; }
  }
}

template <int MODE>
__device__ __forceinline__ void attn_phase(const Params& p, LAS unsigned char* lds, int G, int vb) {
  if (G == 256) {
    const int bh = vb >> 2, s = vb & 3;
#pragma unroll 1
    for (int i = 0; i < 4; ++i) { const int qb = (i == 0) ? 15 - s : (i == 1) ? 8 + s : (i == 2) ? 7 - s : s; attn_unit<MODE>(p, lds, bh >> 3, bh & 7, qb); }
  } else {
#pragma unroll 1
    for (int u = vb; u < 1024; u += G) { const int qb = 15 - (u >> 6), bh = u & 63; attn_unit<MODE>(p, lds, bh >> 3, bh & 7, qb); }
  }
}

constexpr int GL_BC = 0;
constexpr int GL_QE = 17408;
constexpr int GL_KE = 26624;
constexpr int GL_KD = 35840;
constexpr int GL_V = 44032;
constexpr int GL_ST = 60416;
constexpr int GL_RED = 78848;
constexpr int GL_TOT = 80896;
__device__ __forceinline__ int crow(int r, int hi) { return (r & 3) + 8 * (r >> 2) + 4 * hi; }

__device__ __forceinline__ void gla_gates_mfma(const bf16x8 lrA, const bf16x8 guB, const float bias_d, LAS float* bc, LAS float* tot0, int dt, int jt, int r32, int hi) {
  const f32x16 zero = {};
  const f32x16 z = __builtin_amdgcn_mfma_f32_32x32x16_bf16(lrA, guB, zero, 0, 0, 0);
  float la[16];
#pragma unroll
  for (int r = 0; r < 16; ++r) { const float zz = z[r] + bias_d; la[r] = (fminf(zz, 0.f) - __logf(1.f + __expf(-fabsf(zz)))) * (1.f / 16.f); }
  float s[4], o[4];
#pragma unroll
  for (int g = 0; g < 4; ++g) { la[4 * g + 1] += la[4 * g]; la[4 * g + 2] += la[4 * g + 1]; la[4 * g + 3] += la[4 * g + 2]; s[g] = la[4 * g + 3]; }
#pragma unroll
  for (int g = 0; g < 4; ++g) { auto rr = __builtin_amdgcn_permlane32_swap(__float_as_uint(s[g]), __float_as_uint(s[g]), false, false); o[g] = __uint_as_float(hi ? rr[0] : rr[1]); }
  float off = 0.f;
#pragma unroll
  for (int g = 0; g < 4; ++g) { const float add = off + (hi ? o[g] : 0.f);
#pragma unroll
    for (int q = 0; q < 4; ++q) la[4 * g + q] += add;
    off += s[g] + o[g]; }
#pragma unroll
  for (int r = 0; r < 16; ++r) bc[(32 * jt + crow(r, hi)) * 68 + 32 * dt + r32] = la[r];
  if (jt == 0 && hi == 0) tot0[32 * dt + r32] = off;
}

__device__ __forceinline__ bf16x8 trfrag(const LAS unsigned char* p, int off_lo, int off_hi) {
  const s16x4 l = vtr(p + off_lo), h = vtr(p + off_hi);
  return (bf16x8){l[0], l[1], l[2], l[3], h[0], h[1], h[2], h[3]};
}

__device__ __forceinline__ void gla_a_phase(const Params& p, LAS unsigned char* lds, int G, int vb) {
  const int tid = threadIdx.x, lane = tid & 63, r32 = lane & 31, hi = lane >> 5; const int wid = __builtin_amdgcn_readfirstlane(tid >> 6);
  const bf16_t* PROJ = (const bf16_t*)(p.ws + WS_PROJ); const bf16_t* GUT = (const bf16_t*)(p.ws + WS_GUT);
  bf16_t* UPD = (bf16_t*)(p.ws + WS_Y); float* DEC = (float*)(p.ws + WS_DEC); const float* gbias = p.in[5];
  LAS float* bc = (LAS float*)(lds + GL_BC);
  const int j = tid >> 3, c = tid & 7;
  u32x4 kq, v0, v1, lr0 = {}, gub = {}; float gbs = 0.f;
  LAS float* tot0 = (LAS float*)(lds + GL_TOT);
#define GLA_A_LOAD(item_) do { const int n_ = (item_) & 63, bh_ = (item_) >> 6, h_ = bh_ & 3, b_ = bh_ >> 2; const size_t r0_ = (size_t)b_ * SEQ + n_ * 64; \
    if (wid < 4) { lr0 = *(const u32x4*)(PROJ + (r0_ + 32 * (wid >> 1) + r32) * NP + LR_OFF + 8 * hi); \
      gub = *(const u32x4*)(GUT + (h_ * 64 + 32 * (wid & 1) + r32) * 16 + 8 * hi); gbs = gbias[h_ * 64 + 32 * (wid & 1) + r32]; } \
    kq = *(const u32x4*)(PROJ + (r0_ + j) * NP + K_OFF + h_ * 64 + c * 8); \
    v0 = *(const u32x4*)(PROJ + (r0_ + (tid >> 4)) * NP + V_OFF + h_ * 128 + (tid & 15) * 8); \
    v1 = *(const u32x4*)(PROJ + (r0_ + 32 + (tid >> 4)) * NP + V_OFF + h_ * 128 + (tid & 15) * 8); } while (0)
  int item = vb;
  if (item < 2048) GLA_A_LOAD(item);
#pragma unroll 1
  for (; item < 2048; item += G) {
    if (wid < 4) gla_gates_mfma(__builtin_bit_cast(bf16x8, lr0), __builtin_bit_cast(bf16x8, gub), gbs, bc, tot0, wid & 1, wid >> 1, r32, hi);
    LBAR();
    {
      const unsigned kk[4] = {kq.x, kq.y, kq.z, kq.w}; float kd[8];
#pragma unroll
      for (int i = 0; i < 8; ++i) { const int d = c * 8 + i; const float kv = (i & 1) ? bfhi(kk[i >> 1]) : bflo(kk[i >> 1]); const float t0 = tot0[d];
        kd[i] = kv * __expf((bc[63 * 68 + d] + t0) - (bc[j * 68 + d] + (j >= 32 ? t0 : 0.f))); }
      *(LAS u32x4*)(lds + GL_KD + (c >> 2) * 4096 + j * 64 + (c & 3) * 16) = (u32x4){pk2(kd[0], kd[1]), pk2(kd[2], kd[3]), pk2(kd[4], kd[5]), pk2(kd[6], kd[7])};
      const int jj = tid >> 4, cc = tid & 15;
      *(LAS u32x4*)(lds + GL_V + (cc >> 2) * 4096 + jj * 64 + (cc & 3) * 16) = v0;
      *(LAS u32x4*)(lds + GL_V + (cc >> 2) * 4096 + (32 + jj) * 64 + (cc & 3) * 16) = v1;
      if (tid < 64) DEC[(size_t)item * 64 + tid] = __expf(bc[63 * 68 + tid] + tot0[tid]);
    }
    if (item + G < 2048) GLA_A_LOAD(item + G);
    LBAR();
    { const int vt = wid >> 1, dt = wid & 1; f32x16 acc = {};
      const int lo = ((lane >> 4) & 1) * 32 + (lane & 3) * 8 + (8 * hi + ((lane & 15) >> 2)) * 64;
#pragma unroll
      for (int ks = 0; ks < 4; ++ks) {
        const bf16x8 a = trfrag(lds + GL_V + vt * 4096, lo + ks * 1024, lo + ks * 1024 + 256);
        const bf16x8 bb = trfrag(lds + GL_KD + dt * 4096, lo + ks * 1024, lo + ks * 1024 + 256);
        acc = __builtin_amdgcn_mfma_f32_32x32x16_bf16(a, bb, acc, 0, 0, 0);
      }
      bf16_t* dst = UPD + (size_t)item * 8192 + 32 * dt + r32;
#pragma unroll
      for (int r = 0; r < 16; ++r) dst[(size_t)(32 * vt + crow(r, hi)) * 64] = (bf16_t)(pk2(acc[r], 0.f) & 0xffffu);
    }
  }
  LBAR();
#undef GLA_A_LOAD
}

__device__ __forceinline__ void gla_scan(const Params& p, int G, int vb) {
  const bf16_t* UPD = (const bf16_t*)(p.ws + WS_Y); const float* DEC = (const float*)(p.ws + WS_DEC); bf16_t* SPT = (bf16_t*)(p.ws + WS_SPT);
  for (int idx = vb * 512 + threadIdx.x; idx < 32 * 4096; idx += G * 512) {
    const int bh = idx >> 12, vd = (idx & 4095) * 2, d = vd & 63;
    float S0 = 0.f, S1 = 0.f;
#pragma unroll 16
    for (int n = 0; n < 64; ++n) { const size_t item = (size_t)bh * 64 + n;
      const unsigned uw = *(const unsigned*)(UPD + item * 8192 + vd); const f32x2 dc = *(const f32x2*)(DEC + item * 64 + d);
      *(unsigned*)(SPT + item * 8192 + vd) = pk2(S0, S1); S0 = dc.x * S0 + bflo(uw); S1 = dc.y * S1 + bfhi(uw); }
  }
}

__device__ __forceinline__ void gla_scan_block(const Params& p, LAS unsigned char* lds, int bh) {
  const bf16_t* UPD = (const bf16_t*)(p.ws + WS_Y); const float* DEC = (const float*)(p.ws + WS_DEC); bf16_t* SPT = (bf16_t*)(p.ws + WS_SPT);
  const int tid = threadIdx.x, d8 = tid & 7;
  LAS float* dl = (LAS float*)lds;
  for (int i = tid; i < 1024; i += 512) *(LAS f32x4*)(dl + 4 * i) = *(const f32x4*)(DEC + (size_t)bh * 4096 + 4 * i);
  __syncthreads();
  const size_t base = (size_t)bh * 64 * 8192 + (size_t)tid * 8;
  f32x4 S[4] = {};
#pragma unroll 1
  for (int n0 = 0; n0 < 64; n0 += 8) {
    u32x4 u[8][2];
#pragma unroll
    for (int k = 0; k < 8; ++k) { u[k][0] = *(const u32x4*)(UPD + base + (size_t)(n0 + k) * 8192); u[k][1] = *(const u32x4*)(UPD + base + (size_t)(n0 + k) * 8192 + 4096); }
#pragma unroll
    for (int k = 0; k < 8; ++k) {
      const f32x4 da = *(LAS f32x4*)(dl + (n0 + k) * 64 + d8 * 8), db = *(LAS f32x4*)(dl + (n0 + k) * 64 + d8 * 8 + 4);
      *(u32x4*)(SPT + base + (size_t)(n0 + k) * 8192) = pack8(S[0], S[1]);
      *(u32x4*)(SPT + base + (size_t)(n0 + k) * 8192 + 4096) = pack8(S[2], S[3]);
#pragma unroll
      for (int r = 0; r < 2; ++r) { const u32x4 w = u[k][r];
        S[2 * r][0] = da[0] * S[2 * r][0] + bflo(w.x); S[2 * r][1] = da[1] * S[2 * r][1] + bfhi(w.x);
        S[2 * r][2] = da[2] * S[2 * r][2] + bflo(w.y); S[2 * r][3] = da[3] * S[2 * r][3] + bfhi(w.y);
        S[2 * r + 1][0] = db[0] * S[2 * r + 1][0] + bflo(w.z); S[2 * r + 1][1] = db[1] * S[2 * r + 1][1] + bfhi(w.z);
        S[2 * r + 1][2] = db[2] * S[2 * r + 1][2] + bflo(w.w); S[2 * r + 1][3] = db[3] * S[2 * r + 1][3] + bfhi(w.w); }
    }
  }
  __syncthreads();
}

template <int MODE>
__device__ __forceinline__ void gla_c_phase(const Params& p, LAS unsigned char* lds, int G, int vb, int k0, int k1) {
  int tid_ = threadIdx.x; asm volatile("" : "+v"(tid_));
  const int tid = tid_, lane = tid & 63, r32 = lane & 31, hi = lane >> 5; const int wid = __builtin_amdgcn_readfirstlane(tid >> 6);
  const bf16_t* PROJ = (const bf16_t*)(p.ws + WS_PROJ); const bf16_t* GUT = (const bf16_t*)(p.ws + WS_GUT); const bf16_t* SPT = (const bf16_t*)(p.ws + WS_SPT);
  bf16_t* Y = (bf16_t*)(p.ws + WS_Y); const float* gbias = p.in[5]; const float* gnw = p.in[6];
  LAS float* bc = (LAS float*)(lds + GL_BC); LAS bf16_t* QE = (LAS bf16_t*)(lds + GL_QE); LAS bf16_t* KE = (LAS bf16_t*)(lds + GL_KE); LAS bf16_t* ST = (LAS bf16_t*)(lds + GL_ST);
  LAS float* red = (LAS float*)(lds + GL_RED);
  const int j = tid >> 3, c = tid & 7;
  const int it = wid & 1, vt = wid >> 1;
  u32x4 qq, kq, v0, v1, s0, s1, lr0 = {}, gub = {}; float gbs = 0.f; u32x2 og[4];
  LAS float* tot0 = (LAS float*)(lds + GL_TOT);
#define GLA_C_LOAD(item_) do { const int n_ = (item_) & 63, bh_ = (item_) >> 6, h_ = bh_ & 3, b_ = bh_ >> 2; const size_t r0_ = (size_t)b_ * SEQ + n_ * 64; \
    if (wid < 4) { lr0 = *(const u32x4*)(PROJ + (r0_ + 32 * (wid >> 1) + r32) * NP + LR_OFF + 8 * hi); \
      gub = *(const u32x4*)(GUT + (h_ * 64 + 32 * (wid & 1) + r32) * 16 + 8 * hi); gbs = gbias[h_ * 64 + 32 * (wid & 1) + r32]; } \
    qq = *(const u32x4*)(PROJ + (r0_ + j) * NP + Q_OFF + h_ * 64 + c * 8); \
    kq = *(const u32x4*)(PROJ + (r0_ + j) * NP + K_OFF + h_ * 64 + c * 8); \
    v0 = *(const u32x4*)(PROJ + (r0_ + (tid >> 4)) * NP + V_OFF + h_ * 128 + (tid & 15) * 8); \
    v1 = *(const u32x4*)(PROJ + (r0_ + 32 + (tid >> 4)) * NP + V_OFF + h_ * 128 + (tid & 15) * 8); \
    s0 = *(const u32x4*)(SPT + (size_t)(item_) * 8192 + (size_t)tid * 8); s1 = *(const u32x4*)(SPT + (size_t)(item_) * 8192 + 4096 + (size_t)tid * 8); \
    _Pragma("unroll") for (int g_ = 0; g_ < 4; ++g_) og[g_] = *(const u32x2*)(PROJ + (r0_ + 32 * it + r32) * NP + OG_OFF + h_ * 128 + 32 * vt + 8 * g_ + 4 * hi); } while (0)
  f32x4 nwr[4];
  { const float* gnw_l = gnw; asm volatile("" : "+v"(gnw_l));
#pragma unroll
  for (int g = 0; g < 4; ++g) nwr[g] = *(const f32x4*)(gnw_l + 32 * vt + 8 * g + 4 * hi); }
  int item = vb + k0 * G; const int iend = vb + (k1 < 64 ? k1 : 64) * G;
  if (item < iend && item < 2048) GLA_C_LOAD(item);
#define GLA_C_LOAD_NEXT(it_) do { if (MODE != 2) GLA_C_LOAD(it_); } while (0)
#pragma unroll 1
  for (; item < iend && item < 2048; item += G) {
    const int n = item & 63, bh = item >> 6, h = bh & 3, b = bh >> 2; const size_t r0 = (size_t)b * SEQ + n * 64;
    if (wid < 4) gla_gates_mfma(__builtin_bit_cast(bf16x8, lr0), __builtin_bit_cast(bf16x8, gub), gbs, bc, tot0, wid & 1, wid >> 1, r32, hi);
    LBAR();
    {
      const unsigned q4[4] = {qq.x, qq.y, qq.z, qq.w}, k4[4] = {kq.x, kq.y, kq.z, kq.w}; float qv[8], kv[8];
#pragma unroll
      for (int i = 0; i < 8; ++i) { const float bb = bc[j * 68 + c * 8 + i] + (j >= 32 ? tot0[c * 8 + i] : 0.f);
        qv[i] = ((i & 1) ? bfhi(q4[i >> 1]) : bflo(q4[i >> 1])) * 0.125f * __expf(bb);
        kv[i] = ((i & 1) ? bfhi(k4[i >> 1]) : bflo(k4[i >> 1])) * __expf(-bb); }
      *(LAS u32x4*)(QE + j * 72 + c * 8) = (u32x4){pk2(qv[0], qv[1]), pk2(qv[2], qv[3]), pk2(qv[4], qv[5]), pk2(qv[6], qv[7])};
      *(LAS u32x4*)(KE + j * 72 + c * 8) = (u32x4){pk2(kv[0], kv[1]), pk2(kv[2], kv[3]), pk2(kv[4], kv[5]), pk2(kv[6], kv[7])};
      const int jj = tid >> 4, cc = tid & 15;
      *(LAS u32x4*)(lds + GL_V + (cc >> 2) * 4096 + jj * 64 + (cc & 3) * 16) = v0;
      *(LAS u32x4*)(lds + GL_V + (cc >> 2) * 4096 + (32 + jj) * 64 + (cc & 3) * 16) = v1;
      *(LAS u32x4*)(ST + (tid >> 3) * 72 + (tid & 7) * 8) = s0;
      *(LAS u32x4*)(ST + (64 + (tid >> 3)) * 72 + (tid & 7) * 8) = s1;
    }
    u32x2 ogc[4];
#pragma unroll
    for (int g = 0; g < 4; ++g) ogc[g] = og[g];
    if (item + G < iend && item + G < 2048) GLA_C_LOAD_NEXT(item + G);
    LBAR();
    f32x16 acc = {};
    {
      bf16x8 qf[4];
#pragma unroll
      for (int ks = 0; ks < 4; ++ks) qf[ks] = *(const LAS bf16x8*)(QE + (32 * it + r32) * 72 + 16 * ks + 8 * hi);
      const int i_abs = 32 * it + r32;
      const int lo = ((lane >> 4) & 1) * 32 + (lane & 3) * 8 + (4 * hi + ((lane & 15) >> 2)) * 64;
#pragma unroll
      for (int jt = 0; jt < 2; ++jt) {
        if (jt <= it) {
          f32x16 at = {};
#pragma unroll
          for (int ks = 0; ks < 4; ++ks) {
            const bf16x8 a = *(const LAS bf16x8*)(KE + (32 * jt + r32) * 72 + 16 * ks + 8 * hi);
            at = __builtin_amdgcn_mfma_f32_32x32x16_bf16(a, qf[ks], at, 0, 0, 0);
          }
#pragma unroll
          for (int r = 0; r < 16; ++r) if (32 * jt + crow(r, hi) > i_abs) at[r] = 0.f;
#pragma unroll
          for (int s = 0; s < 2; ++s) {
            const u32x4 pw = (u32x4){pk2(at[8 * s + 0], at[8 * s + 1]), pk2(at[8 * s + 2], at[8 * s + 3]), pk2(at[8 * s + 4], at[8 * s + 5]), pk2(at[8 * s + 6], at[8 * s + 7])};
            const int ks = 2 * jt + s;
            const bf16x8 vf = trfrag(lds + GL_V + vt * 4096, lo + ks * 1024, lo + ks * 1024 + 512);
            acc = __builtin_amdgcn_mfma_f32_32x32x16_bf16(vf, __builtin_bit_cast(bf16x8, pw), acc, 0, 0, 0);
          }
        }
      }
#pragma unroll
      for (int ks = 0; ks < 4; ++ks) {
        const bf16x8 a = *(const LAS bf16x8*)(ST + (32 * vt + r32) * 72 + 16 * ks + 8 * hi);
        acc = __builtin_amdgcn_mfma_f32_32x32x16_bf16(a, qf[ks], acc, 0, 0, 0);
      }
    }
    float sq = 0.f;
#pragma unroll
    for (int r = 0; r < 16; ++r) sq += acc[r] * acc[r];
    red[(32 * it + r32) * 8 + vt * 2 + hi] = sq;
    LBAR();
    {
      const LAS f32x4* rr = (const LAS f32x4*)(red + (32 * it + r32) * 8);
      const f32x4 ra = rr[0], rb = rr[1];
      const float tot = ((ra[0] + ra[1]) + (ra[2] + ra[3])) + ((rb[0] + rb[1]) + (rb[2] + rb[3]));
      const float rinv = rsqrtf(tot * (1.f / 128.f) + EPS);
      bf16_t* dst = Y + (r0 + 32 * it + r32) * 1024 + h * 128 + 32 * vt + 4 * hi;
#pragma unroll
      for (int g = 0; g < 4; ++g) {
        const f32x4 nw = nwr[g];
        const float o0 = bflo(ogc[g].x), o1 = bfhi(ogc[g].x), o2 = bflo(ogc[g].y), o3 = bfhi(ogc[g].y);
        const float y0 = acc[4 * g + 0] * rinv * nw[0] * (o0 * __builtin_amdgcn_rcpf(1.f + __expf(-o0)));
        const float y1 = acc[4 * g + 1] * rinv * nw[1] * (o1 * __builtin_amdgcn_rcpf(1.f + __expf(-o1)));
        const float y2 = acc[4 * g + 2] * rinv * nw[2] * (o2 * __builtin_amdgcn_rcpf(1.f + __expf(-o2)));
        const float y3 = acc[4 * g + 3] * rinv * nw[3] * (o3 * __builtin_amdgcn_rcpf(1.f + __expf(-o3)));
        u32x2 w; w.x = pk2(y0, y1); w.y = pk2(y2, y3);
        if (MODE == 0 || w.x == 0x12345679u) *(u32x2*)(dst + 8 * g) = w;
      }
    }
  }
  LBAR();
#undef GLA_C_LOAD
}

constexpr int RT_LG = 0;
constexpr int RT_HIST = 8 * 16 * 49 * 4;
constexpr int RT_BASE = RT_HIST + 128;
__device__ __forceinline__ void router_phase(const Params& p, LAS unsigned char* lds, int G, int vb) {
  const int tid = threadIdx.x, lane = tid & 63, wave = tid >> 6;
  const bf16_t* HB = (const bf16_t*)(p.ws + WS_XB); const bf16_t* WrT = (const bf16_t*)(p.ws + WS_WR);
  float* RS2 = (float*)(p.ws + WS_RS2); int* cnt = (int*)(p.ws + WS_CNT); int* LTOK = (int*)(p.ws + WS_LTOK); float* LGATE = (float*)(p.ws + WS_LGATE);
  const float* gbias = p.in[14]; const float* ebias = p.in[16];
  LAS float* lg = (LAS float*)(lds + RT_LG) + wave * 16 * 49; LAS int* hist = (LAS int*)(lds + RT_HIST); LAS int* basee = (LAS int*)(lds + RT_BASE);
  for (int base = vb * 8; base < NTOK / 16; base += G * 8) {
    if (tid < 32) hist[tid] = 0;
    const int r0 = (base + wave) * 16;
    f32x4 acc[3] = {{0.f, 0.f, 0.f, 0.f}, {0.f, 0.f, 0.f, 0.f}, {0.f, 0.f, 0.f, 0.f}};
    const bf16_t* arow = HB + (size_t)(r0 + (lane & 15)) * 1024 + (lane >> 4) * 8;
    const bf16_t* brow = WrT + (size_t)(lane & 15) * 1024 + (lane >> 4) * 8;
    float hsq = 0.f;
#pragma unroll 4
    for (int kk = 0; kk < 32; ++kk) {
      const bf16x8 a = *(const bf16x8*)(arow + kk * 32);
      { const u32x4 aw = __builtin_bit_cast(u32x4, a); const float e0 = bflo(aw.x), e1 = bfhi(aw.x), e2 = bflo(aw.y), e3 = bfhi(aw.y), e4 = bflo(aw.z), e5 = bfhi(aw.z), e6 = bflo(aw.w), e7 = bfhi(aw.w);
        hsq += ((e0 * e0 + e1 * e1) + (e2 * e2 + e3 * e3)) + ((e4 * e4 + e5 * e5) + (e6 * e6 + e7 * e7)); }
#pragma unroll
      for (int n = 0; n < 3; ++n) { const bf16x8 bb = *(const bf16x8*)(brow + (size_t)n * 16 * 1024 + kk * 32); acc[n] = __builtin_amdgcn_mfma_f32_16x16x32_bf16(a, bb, acc[n], 0, 0, 0); }
    }
    hsq += __shfl_xor(hsq, 16); hsq += __shfl_xor(hsq, 32);
#pragma unroll
    for (int n = 0; n < 3; ++n)
#pragma unroll
      for (int r = 0; r < 4; ++r) lg[((lane >> 4) * 4 + r) * 49 + 16 * n + (lane & 15)] = acc[n][r];
    __syncthreads();
    int e1 = 0, e2 = 0, lp1 = 0, lp2 = 0; float g1 = 0.f, g2 = 0.f, rsk = 0.f; const int tok = r0 + lane;
    if (lane < 16) {
      const float rs = rsqrtf(hsq * (1.f / 1024.f) + EPS);
      RS2[tok] = rs; rsk = rs;
      float gl[4]; int gs = 0;
#pragma unroll
      for (int i = 0; i < 4; ++i) gl[i] = lg[lane * 49 + i] * rs + gbias[i];
#pragma unroll
      for (int i = 1; i < 4; ++i) if (gl[i] > gl[gs]) gs = i;
      float den = 0.f;
#pragma unroll
      for (int i = 0; i < 4; ++i) den += __expf(gl[i] - gl[gs]);
      const float pg = 1.f / den;
      float el[8];
#pragma unroll
      for (int i = 0; i < 8; ++i) el[i] = lg[lane * 49 + 4 + gs * 8 + i] * rs + ebias[gs * 8 + i];
      int i1 = 0;
#pragma unroll
      for (int i = 1; i < 8; ++i) if (el[i] > el[i1]) i1 = i;
      int i2 = (i1 == 0) ? 1 : 0;
#pragma unroll
      for (int i = 0; i < 8; ++i) if (i != i1 && el[i] > el[i2]) i2 = i;
      const float t = __expf(el[i2] - el[i1]);
      g1 = pg / (1.f + t); g2 = pg * t / (1.f + t);
      e1 = gs * 8 + i1; e2 = gs * 8 + i2;
      lp1 = atomicAdd((int*)(hist + e1), 1); lp2 = atomicAdd((int*)(hist + e2), 1);
    }
    __syncthreads();
    if (tid < 32) { const int hc = hist[tid]; basee[tid] = hc ? atomicAdd(cnt + tid, hc) : 0; }
    __syncthreads();
    if (lane < 16) {
      const int p1 = e1 * ECAP + basee[e1] + lp1, p2 = e2 * ECAP + basee[e2] + lp2;
      LTOK[p1] = tok * 2; LGATE[p1] = g1; LTOK[p2] = tok * 2 + 1; LGATE[p2] = g2;
      float* LRS2 = (float*)(p.ws + WS_LRS2); LRS2[p1] = rsk; LRS2[p2] = rsk;
    }
    __syncthreads();
  }
}

__device__ __forceinline__ void final_phase(const Params& p, int G, int vb, float pc1, float pc2) {
  const int lane = threadIdx.x & 63, wave = threadIdx.x >> 6;
  const float* fw = p.in[20]; const bf16_t* Y2 = (const bf16_t*)(p.ws + WS_PROJ); const bf16_t* HB = (const bf16_t*)(p.ws + WS_XB);
  for (int m = vb * 8 + wave; m < NTOK; m += G * 8) {
    f32x4* orow = (f32x4*)(p.out + (size_t)m * DM) + lane;
    f32x4 v[4]; float s = 0.f;
#pragma unroll
    for (int j = 0; j < 4; ++j) {
      const u32x2 hh = *((const u32x2*)(HB + (size_t)m * 1024) + lane + 64 * j);
      v[j] = (f32x4){bflo(hh.x), bfhi(hh.x), bflo(hh.y), bfhi(hh.y)};
#if ENABLE_MOE
      const u32x2 a = *((const u32x2*)(Y2 + (size_t)(2 * m) * 1024) + lane + 64 * j), b = *((const u32x2*)(Y2 + (size_t)(2 * m + 1) * 1024) + lane + 64 * j);
      v[j].x += bflo(a.x) + bflo(b.x); v[j].y += bfhi(a.x) + bfhi(b.x); v[j].z += bflo(a.y) + bflo(b.y); v[j].w += bfhi(a.y) + bfhi(b.y);
#endif
      s += (v[j].x * v[j].x + v[j].y * v[j].y) + (v[j].z * v[j].z + v[j].w * v[j].w);
    }
    s = wave_sum(s);
    const float rs = rsqrtf(s * (1.f / DM) + EPS);
#pragma unroll
    for (int j = 0; j < 4; ++j) { const f32x4 w = *((const f32x4*)fw + lane + 64 * j); f32x4 o = v[j] * rs * w;
#ifdef PROBE_T1
      o = o + pc1;
#endif
      orow[64 * j] = o; }
  }
}


#define XB_TMO      128
#define XB_XCNT(j)  (256  + 64 * (j))
#define XB_XSUB(j)  (1280 + 64 * (j))
#define XB_XGEN(j)  (2304 + 64 * (j))
#define XB_TOP      3328
#define XB_TOPGEN   3392
#define XB_SPIN_CAP (1u << 22)
__device__ __forceinline__ unsigned xb_ld(unsigned* p)              { return __hip_atomic_load(p, __ATOMIC_RELAXED, __HIP_MEMORY_SCOPE_AGENT); }
__device__ __forceinline__ unsigned xb_add(unsigned* p, unsigned v) { return __hip_atomic_fetch_add(p, v, __ATOMIC_RELAXED, __HIP_MEMORY_SCOPE_AGENT); }
__device__ __forceinline__ unsigned xb_xcc_id() { return (unsigned)__builtin_amdgcn_s_getreg((3 << 11) | 20) & 0xFu; }
#define XB_SPIN(cond, bar) do { unsigned _sp = 0; while (cond) { __builtin_amdgcn_s_sleep(1); \
    if ((++_sp & 255u) == 0u) { if (xb_ld(&(bar)[XB_TMO])) break; if (_sp > XB_SPIN_CAP) { atomicAdd(&(bar)[XB_TMO], 1u); break; } } } } while (0)
struct XcdBarrier { unsigned* bar; unsigned x; volatile LAS unsigned* st; };
__device__ __forceinline__ XcdBarrier xcd_barrier_post(unsigned* bar, volatile LAS unsigned* st) {
  XcdBarrier b; b.bar = bar; b.x = xb_xcc_id(); b.st = st;
  if (threadIdx.x == 0) st[2] = xb_add(&bar[XB_XCNT(b.x)], 1u);
  return b;
}
__device__ __forceinline__ void xcd_barrier_complete(unsigned* bar, unsigned x, unsigned& nloc, unsigned& nx) {
  const unsigned G = gridDim.x * gridDim.y * gridDim.z;
  unsigned sum, cnt, mine, sp = 0u;
  for (;;) {
    sum = 0u; cnt = 0u; mine = 0u;
#pragma unroll
    for (unsigned j = 0; j < 16; ++j) { const unsigned c = xb_ld(&bar[XB_XCNT(j)]); sum += c; cnt += (c > 0u) ? 1u : 0u; mine = (j == x) ? c : mine; }
    if (sum == G) break;
    __builtin_amdgcn_s_sleep(1);
    if ((++sp & 255u) == 0u) { if (xb_ld(&bar[XB_TMO])) break; if (sp > XB_SPIN_CAP) { atomicAdd(&bar[XB_TMO], 1u); break; } }
  }
  nloc = mine > 0u ? mine : 1u; nx = cnt > 0u ? cnt : 1u;
}
__device__ __forceinline__ void xcd_barrier(const XcdBarrier& b) {
  asm volatile("s_waitcnt vmcnt(0)" ::: "memory");
  __syncthreads();
  if (threadIdx.x == 0) {
    unsigned* bar = b.bar;
    __builtin_amdgcn_s_waitcnt(0);
    unsigned nloc = b.st[0], nx = b.st[1];
    if (nloc == 0u) { xcd_barrier_complete(bar, b.x, nloc, nx); b.st[0] = nloc; b.st[1] = nx; }
    const unsigned old = xb_add(&bar[XB_XSUB(b.x)], 1u);
    const unsigned gen = old / nloc;
    if (old + 1u == (gen + 1u) * nloc) {
      __builtin_amdgcn_fence(__ATOMIC_RELEASE, "agent");
      asm volatile("s_waitcnt vmcnt(0)" ::: "memory");
      const unsigned og = xb_add(&bar[XB_TOP], 1u);
      const unsigned tg = og / nx;
      if (og + 1u == (tg + 1u) * nx) xb_add(&bar[XB_TOPGEN], 1u);
      else XB_SPIN(xb_ld(&bar[XB_TOPGEN]) == tg, bar);
      xb_add(&bar[XB_XGEN(b.x)], 1u);
      __builtin_amdgcn_fence(__ATOMIC_ACQUIRE, "agent");
      asm volatile("s_waitcnt vmcnt(0)" ::: "memory");
    } else {
      XB_SPIN(xb_ld(&bar[XB_XGEN(b.x)]) == gen, bar);
      __builtin_amdgcn_fence(__ATOMIC_ACQUIRE, "agent");
      asm volatile("s_waitcnt vmcnt(0)" ::: "memory");
    }
  }
  __syncthreads();
}

constexpr int LDS_CTL = 131072;
constexpr int LDS_BYTES = 131072 + 1024 + 8192;

__global__ void __launch_bounds__(512) fwd(Params p, int ph_lo, int ph_hi) {
  extern __shared__ __attribute__((aligned(16))) unsigned char lds_raw[];
  LAS unsigned char* lds = (LAS unsigned char*)lds_raw;
  cg::grid_group grid = cg::this_grid();
  const int G = gridDim.x, bx = blockIdx.x;
  int vb = bx;
  int crr = bx;
  unsigned char* ws = p.ws;
#ifndef PHMASK
#define PHMASK 0x3ff
#endif
#define PH(k) (((PHMASK >> (k)) & 1) && ph_lo <= (k) && (k) < ph_hi)
#ifdef PROBE_T1
  LAS unsigned long long* tsx = (LAS unsigned long long*)(lds + LDS_CTL + 512);
  if (threadIdx.x == 0) tsx[0] = __builtin_amdgcn_s_memrealtime();
#define SEAM(k) do { if (PH(k) && PH((k) + 1)) grid.sync(); if (threadIdx.x == 0) tsx[(k) + 1] = __builtin_amdgcn_s_memrealtime(); } while (0)
#else
#define SEAM(k) do { if (PH(k) && PH((k) + 1)) xcd_barrier(xbar); } while (0)
#endif
  volatile LAS unsigned* xst = (volatile LAS unsigned*)(lds + LDS_CTL + 768);
  if (threadIdx.x == 0) { xst[0] = 0u; xst[1] = 0u; }
  if (blockIdx.x == 0) for (int i = threadIdx.x; i < XCD_BAR_WORDS; i += 512) ((unsigned*)(ws + WS_BAR))[i] = 0u;
  grid.sync();
  XcdBarrier xbar = xcd_barrier_post((unsigned*)(ws + WS_BAR), xst);
  if (PH(0)) for (int rep = 0; rep < ((REPEAT_PHASE == 0) ? 2 : 1); ++rep) { if (rep) grid.sync(); p0_prologue(p, lds, G, vb); }
  SEAM(0);
  {
    volatile LAS unsigned* xs = xst;
    if (threadIdx.x == 0) { unsigned pre = 0u; for (unsigned j = 0; j < xbar.x; ++j) pre += xb_ld(&xbar.bar[XB_XCNT(j)]); xs[3] = pre + xs[2]; }
    __syncthreads();
    if (G % 8 == 0) { vb = (int)xs[3]; if (vb >= G) vb = bx; const int per = G / 8; crr = (vb % per) * 8 + vb / per; }
  }
  if (PH(1)) for (int rep = 0; rep < NREP(1); ++rep) {
    if (rep) grid.sync();
    g8::DenseSched S; S.init(ws + WS_XB, 1024, ws + WS_WIN, 1024, NTOK, NP, G, crr);
    EpiInproj E{(bf16_t*)(ws + WS_PROJ), (const float*)(ws + WS_RS1), (float*)(ws + WS_SSQP), (const f32x2*)(ws + WS_CS)};
    g8::gemm_phase(lds, 1024, S, E);
    if (G == 256 && crr >= 128 && rep == 0) {
      LAS float* scr = (LAS float*)(lds + (threadIdx.x >> 6) * 8704);
      for (int r = (crr - 128) * 8 + (threadIdx.x >> 6); r < CONV_GU_P1; r += 1024) conv_gu_item(p, CONV_GU_P0 + r, scr, threadIdx.x & 63);
      for (int r = (crr - 128) * 8 + (threadIdx.x >> 6); r < CONV_D_P1; r += 1024) conv_d_item(p, r, scr, threadIdx.x & 63);
      __syncthreads();
    }
  }
  SEAM(1);
  const bool split23 = (G == 256);
  const int Gg = split23 ? 224 : G;
#define P2_GEMMS(DRY) do { \
    { g8::DenseSched S; S.init((const bf16_t*)(ws + WS_PROJ) + CQ_OFF, NP, ws + WS_WUQ, 384, NTOK, 768, Gg, crr); \
      EpiUq E{(bf16_t*)(ws + WS_QB), (const float*)(ws + WS_SSQP), (const f32x2*)(ws + WS_CS), DRY}; \
      g8::gemm_phase(lds, 384, S, E); } \
    { g8::DenseSched S; S.init((const bf16_t*)(ws + WS_PROJ) + CKV_OFF, NP, ws + WS_WUKV, 256, NTOK, 1024, Gg, split23 ? (crr + 64) % 224 : crr);     \
      EpiUkv E{(bf16_t*)(ws + WS_KVB), (const float*)(ws + WS_SSQP), DRY}; \
      g8::gemm_phase(lds, 256, S, E); } } while (0)
#define P2_GLA() gla_a_phase(p, lds, G, vb)
#define P4_GLA() gla_c_phase<0>(p, lds, G, vb, 0, 1 << 20)
  if (PH(2)) {
#if ENABLE_GLA
    P2_GLA();
#endif
#if REPEAT_PHASE == 2
    grid.sync();
    P2_GLA();
#endif
  }
  SEAM(2);
  if (PH(3)) {
#if ENABLE_MLA
    if (!split23 || crr < 224) P2_GEMMS(false);
#endif
#if ENABLE_GLA
    if (!split23) gla_scan(p, G, vb);
    else if (crr >= 224) {
      gla_scan_block(p, lds, crr - 224);
      LAS float* scr_ = (LAS float*)(lds + (threadIdx.x >> 6) * 8704);
      for (int r_ = (crr - 224) * 8 + (threadIdx.x >> 6); r_ < CONV_GU_P2; r_ += 256) conv_gu_item(p, CONV_GU_P0 + CONV_GU_P1 + r_, scr_, threadIdx.x & 63);
      for (int r_ = CONV_D_P1 + (crr - 224) * 8 + (threadIdx.x >> 6); r_ < 4096; r_ += 256) conv_d_item(p, r_, scr_, threadIdx.x & 63);
      __syncthreads();
    }
#endif
#if REPEAT_PHASE == 3
    grid.sync();
    if ((REPEAT_SUB & 1) && (!split23 || crr < 224)) P2_GEMMS(true);
    if ((REPEAT_SUB & 2) && split23 && crr >= 224) {
      gla_scan_block(p, lds, crr - 224);
      if (REPEAT_SUB & 4) { LAS float* scr_ = (LAS float*)(lds + (threadIdx.x >> 6) * 8704);
      for (int r_ = (crr - 224) * 8 + (threadIdx.x >> 6); r_ < CONV_GU_P2; r_ += 256) conv_gu_item(p, CONV_GU_P0 + CONV_GU_P1 + r_, scr_, threadIdx.x & 63);
      for (int r_ = CONV_D_P1 + (crr - 224) * 8 + (threadIdx.x >> 6); r_ < 4096; r_ += 256) conv_d_item(p, r_, scr_, threadIdx.x & 63);
      __syncthreads(); }
    }
#endif
  }
  SEAM(3);
  if (PH(4)) {
#if ENABLE_MLA && ENABLE_GLA
    if (G == 256) {
      const int bh = vb >> 2, s4 = vb & 3;
      const int odd = vb & 1;
#pragma unroll 1
      for (int k = 0; k < 8; ++k) { const int i = k >> 1;
        if (((k + odd) & 1) == 0) { const int qb = (i == 0) ? 15 - s4 : (i == 1) ? 8 + s4 : (i == 2) ? 7 - s4 : s4; attn_unit<0>(p, lds, bh >> 3, bh & 7, qb); }
        else gla_c_phase<0>(p, lds, G, vb, 2 * i, 2 * i + 2); }
    } else { attn_phase<0>(p, lds, G, vb); P4_GLA(); }
#elif ENABLE_MLA
    attn_phase<0>(p, lds, G, vb);
#else
    { u32x4* Yz = (u32x4*)(ws + WS_Y); for (int i = vb * 512 + threadIdx.x; i < NTOK * 64; i += G * 512) Yz[(size_t)(i >> 6) * 128 + 64 + (i & 63)] = (u32x4){0u, 0u, 0u, 0u}; }
#endif
#if ENABLE_GLA && !ENABLE_MLA
    P4_GLA();
#endif
#if REPEAT_PHASE == 4
    grid.sync();
#ifndef ATTN_PROBE_MODE
#define ATTN_PROBE_MODE 0
#endif
    if (REPEAT_SUB & 1) attn_phase<ATTN_PROBE_MODE>(p, lds, G, vb);
#ifndef GLA_PROBE_MODE
#define GLA_PROBE_MODE 0
#endif
    if (REPEAT_SUB & 2) gla_c_phase<GLA_PROBE_MODE>(p, lds, G, vb, 0, 1 << 20);
#endif
  }
  SEAM(4);
  if (PH(5)) for (int rep = 0; rep < NREP(5); ++rep) {
    if (rep) grid.sync();
    g8::DenseSched S; S.init(ws + WS_Y, 1024, ws + WS_WOUT, 1024, NTOK, 1024, G, crr);
    EpiWout E{p.in[0], (bf16_t*)(ws + WS_XB), ws + WS_H8};
    g8::gemm_phase(lds, 1024, S, E);
  }
  SEAM(5);
#if ENABLE_MOE
  if (PH(6)) router_phase(p, lds, G, vb);
  SEAM(6);
  if (PH(7) || PH(8)) {
    LAS int* tb = (LAS int*)(lds + LDS_CTL); LAS int* cn = (LAS int*)(lds + LDS_CTL + 256);
    if (threadIdx.x == 0) { const int* cnt = (const int*)(ws + WS_CNT); int acc = 0;
      for (int e = 0; e < NEXP; ++e) { const int c = cnt[e]; cn[e] = c; tb[e] = acc; acc += (c + 255) >> 8; }
      tb[NEXP] = acc; }
    __syncthreads();
    const int T = tb[NEXP];
    if (PH(7)) for (int rep = 0; rep < NREP(7); ++rep) {
      if (rep) grid.sync();
#if MOE_FP8
      MoeSched<true> S; S.A = (const char*)(ws + WS_H8); S.B = (const char*)(ws + WS_WGU); S.lda = 512; S.ldb = 512; S.ncol = 2; S.total = T * 2; S.G = G; S.c = vb;
      S.tb = tb; S.cn = cn; S.ltok = (const int*)(ws + WS_LTOK); S.bstride = (size_t)512 * 1024; S.n1 = 0; S.r = 0; S.flg = nullptr;
#else
      MoeSched<true> S; S.A = (const char*)(ws + WS_XB); S.B = (const char*)(ws + WS_WGU); S.lda = 1024; S.ldb = 1024; S.ncol = 2; S.total = T * 2; S.G = G; S.c = vb;
      S.tb = tb; S.cn = cn; S.ltok = (const int*)(ws + WS_LTOK); S.bstride = (size_t)512 * 1024 * 2; S.n1 = 0; S.r = 0; S.flg = nullptr;
#endif
      EpiGU E{(bf16_t*)(ws + WS_QB), (const float*)(ws + WS_LRS2), (const int*)(ws + WS_LTOK), cn, rep > 0 && P8_DRY, (int*)(ws + WS_FLG)};
      g8::gemm_phase<MOE_FP8 ? 2 : 0>(lds, MOE_FP8 ? 512 : 1024, S, E);
    }
    if (PH(8)) for (int rep = 0; rep < NREP(8); ++rep) {
      if (rep) grid.sync();
#if MOE_FP8
      MoeSched<false> S; S.A = (const char*)(ws + WS_QB); S.B = (const char*)(ws + WS_WD); S.lda = 128; S.ldb = 128; S.ncol = 4; S.total = T * 4; S.G = G; S.c = vb;
      S.tb = tb; S.cn = cn; S.ltok = (const int*)(ws + WS_LTOK); S.bstride = (size_t)1024 * 256;
#else
      MoeSched<false> S; S.A = (const char*)(ws + WS_QB); S.B = (const char*)(ws + WS_WD); S.lda = 256; S.ldb = 256; S.ncol = 4; S.total = T * 4; S.G = G; S.c = vb;
      S.tb = tb; S.cn = cn; S.ltok = (const int*)(ws + WS_LTOK); S.bstride = (size_t)1024 * 256 * 2;
#endif
      { const int rr_ = (T * 2) % G, n0_ = (T * 4 + 2 * rr_ + G - 1) / G; S.r = rr_; S.n1 = n0_ > 2 ? n0_ - 2 : 0; S.flg = (const int*)(ws + WS_FLG); }
      EpiDown E{(bf16_t*)(ws + WS_PROJ), (const int*)(ws + WS_LTOK), (const float*)(ws + WS_LGATE), cn, rep > 0 && P8_DRY};
      g8::gemm_phase<MOE_FP8 ? 1 : 0>(lds, MOE_FP8 ? 128 : 256, S, E);
    }
  }
  SEAM(8);
#endif
#ifdef PROBE_T1
  __syncthreads();
  const float probe_c1 = 0.1f * log2f((float)(tsx[PROBE_T1 + 1] - tsx[PROBE_T1]) * 0.01f), probe_c2 = 0.f;
  if (PH(9)) final_phase(p, G, vb, probe_c1, probe_c2);
#else
#ifdef EXTRA_SYNCS
  for (int i = 0; i < EXTRA_SYNCS; ++i) grid.sync();
#endif
  if (PH(9)) final_phase(p, G, vb, 0.f, 0.f);
#endif
#undef PH
#undef SEAM
}

extern "C" void kernel_launch(void* const* d_in, const int* in_sizes, int n_in, void* d_out, int out_size,
                              void* d_ws, size_t ws_size, hipStream_t stream) {
  static int grid_blocks = 0;
  if (grid_blocks == 0) {
    if (n_in != 21 || ws_size < WS_END) { fprintf(stderr, "kernel_launch: unexpected n_in %d or ws_size %zu (< %zu)\n", n_in, ws_size, (size_t)WS_END); grid_blocks = -1; return; }
    int dev = 0, cus = 0, per_cu = 0;
    hipGetDevice(&dev);
    hipDeviceGetAttribute(&cus, hipDeviceAttributeMultiprocessorCount, dev);
    hipFuncSetAttribute((const void*)fwd, hipFuncAttributeMaxDynamicSharedMemorySize, LDS_BYTES);
    hipOccupancyMaxActiveBlocksPerMultiprocessor(&per_cu, (const void*)fwd, 512, LDS_BYTES);
    if (per_cu < 1) { fprintf(stderr, "kernel_launch: occupancy query says %d blocks/CU\n", per_cu); per_cu = 1; }
    grid_blocks = cus;
  }
  if (grid_blocks < 0) return;
  Params p{};
  for (int i = 0; i < 21; ++i) p.in[i] = (const float*)d_in[i];
  p.out = (float*)d_out; p.ws = (unsigned char*)d_ws;
  int lo = 0, hi = 10;
  void* args[] = {&p, &lo, &hi};
  hipError_t e = hipLaunchCooperativeKernel((void*)fwd, dim3(grid_blocks), dim3(512), args, LDS_BYTES, stream);
  if (e != hipSuccess) fprintf(stderr, "cooperative launch failed: %s (grid %d)\n", hipGetErrorString(e), grid_blocks);
}
```

```cpp
#include <hip/hip_runtime.h>
#include <hip/hip_cooperative_groups.h>
#include <cstdio>
#include <cstdint>
#include <cmath>
namespace cg = cooperative_groups;

#ifndef MOE_FP8
#define MOE_FP8 1
#endif
#ifndef ENABLE_GLA
#define ENABLE_GLA 1
#endif
#ifndef ENABLE_MLA
#define ENABLE_MLA 1
#endif
#ifndef ENABLE_MOE
#define ENABLE_MOE 1
#endif

#ifndef P8_DRY
#define P8_DRY false
#endif
#ifndef REPEAT_PHASE
#define REPEAT_PHASE -1
#endif
#ifndef REPEAT_SUB
#define REPEAT_SUB 3
#endif
#define NREP(k) ((REPEAT_PHASE == (k)) ? 2 : 1)
#define LAS __attribute__((address_space(3)))
typedef unsigned short bf16_t;
typedef short bf16x8 __attribute__((ext_vector_type(8)));
typedef short s16x4 __attribute__((ext_vector_type(4)));
typedef float f32x4 __attribute__((ext_vector_type(4)));
typedef float f32x2 __attribute__((ext_vector_type(2)));
typedef float f32x16 __attribute__((ext_vector_type(16)));
typedef unsigned u32x4 __attribute__((ext_vector_type(4)));
typedef unsigned u32x2 __attribute__((ext_vector_type(2)));
typedef int i32x4 __attribute__((ext_vector_type(4)));
typedef int i32x8 __attribute__((ext_vector_type(8)));
typedef __bf16 bf16x2_t __attribute__((ext_vector_type(2)));

constexpr int NTOK = 32768, DM = 1024, SEQ = 4096, NBATCH = 8;
constexpr int NP = 2304;
constexpr int Q_OFF = 0, K_OFF = 256, V_OFF = 512, OG_OFF = 1024, CQ_OFF = 1536, CKV_OFF = 1920, KR_OFF = 2176, LR_OFF = 2208;
constexpr int NEXP = 32, ECAP = 32768;
constexpr float EPS = 1e-6f;
constexpr float F8_SH = 4.f, F8_SWGU = 32.f, F8_SHID = 4.f, F8_SWD = 16.f;
constexpr float QSCALE = 0.10206207261596575f * 1.4426950408889634f;

constexpr size_t MiB = 1u << 20;
constexpr size_t WS_CNT = 0;
constexpr size_t WS_FLG = 4096;
constexpr size_t WS_BAR = 128 * 1024;
constexpr size_t WS_GUT = 64 * 1024;
constexpr size_t WS_RS1 = 1 * MiB;
constexpr size_t WS_RS2 = 1 * MiB + 512 * 1024;
constexpr size_t WS_SSQP = 2 * MiB;
constexpr size_t WS_CS = 4 * MiB;
constexpr size_t WS_LTOK = 8 * MiB;
constexpr size_t WS_LGATE = 12 * MiB;
constexpr size_t WS_WIN = 16 * MiB;
constexpr size_t WS_WUQ = 21 * MiB;
constexpr size_t WS_WUKV = 22 * MiB;
constexpr size_t WS_WOUT = 23 * MiB;
constexpr size_t WS_WR = 25 * MiB;
constexpr size_t WS_WGU = 26 * MiB;
constexpr size_t WS_WD = 58 * MiB;
constexpr size_t WS_DEC = 74 * MiB;
constexpr size_t WS_XB = 80 * MiB;
constexpr size_t WS_PROJ = 144 * MiB;
constexpr size_t WS_QB = 288 * MiB;
constexpr size_t WS_KVB = 336 * MiB;
constexpr size_t WS_Y = 400 * MiB;
constexpr size_t WS_SPT = 464 * MiB;
constexpr size_t WS_H8 = WS_KVB;
constexpr size_t WS_LRS2 = 496 * MiB;
constexpr size_t WS_END = 500 * MiB;

struct Params {
  const float* in[21];
  float* out;
  unsigned char* ws;
};

__device__ __forceinline__ unsigned pk2(float lo, float hi) { f32x2 v = {lo, hi}; bf16x2_t b = __builtin_convertvector(v, bf16x2_t); return __builtin_bit_cast(unsigned, b); }
__device__ __forceinline__ float bf2f(unsigned short h) { return __uint_as_float(((unsigned)h) << 16); }
__device__ __forceinline__ float bflo(unsigned w) { return __uint_as_float(w << 16); }
__device__ __forceinline__ float bfhi(unsigned w) { return __uint_as_float(w & 0xffff0000u); }
__device__ __forceinline__ u32x2 pk8_fp8(const f32x4& a, const f32x4& b, float sc) {
  float t[8] = {a[0] * sc, a[1] * sc, a[2] * sc, a[3] * sc, b[0] * sc, b[1] * sc, b[2] * sc, b[3] * sc};
#pragma unroll
  for (int i = 0; i < 8; ++i) t[i] = fminf(fmaxf(t[i], -448.f), 448.f);
  int lo = __builtin_amdgcn_cvt_pk_fp8_f32(t[0], t[1], 0, false); lo = __builtin_amdgcn_cvt_pk_fp8_f32(t[2], t[3], lo, true);
  int hi = __builtin_amdgcn_cvt_pk_fp8_f32(t[4], t[5], 0, false); hi = __builtin_amdgcn_cvt_pk_fp8_f32(t[6], t[7], hi, true);
  u32x2 r; r.x = (unsigned)lo; r.y = (unsigned)hi; return r;
}
__device__ __forceinline__ int perm32(int rho) { const int n = rho >> 4, i = rho & 15; return 8 * (i >> 2) + 4 * n + (i & 3); }
__device__ __forceinline__ float wave_sum(float v) {
#pragma unroll
  for (int o = 1; o < 64; o <<= 1) v += __shfl_xor(v, o);
  return v;
}
#define XCD_BAR_WORDS 3456
#define LDS_WAIT() asm volatile("s_waitcnt lgkmcnt(0)" ::: "memory")
#define LBAR() asm volatile("s_waitcnt lgkmcnt(0)\n\ts_barrier" ::: "memory")

namespace g8 {
constexpr int BM = 256, BK = 64, HALF = 128, HTB = HALF * BK * 2, STAGE_BYTES = 8 * HTB, NXCD = 8, WGM = 8;
__device__ __forceinline__ int lds_byte(int r, int c) { const int st = (r >> 4) * 2 + (c >> 5), rr = r & 15, cc = c & 31, ob = rr * 64 + cc * 2; return st * 1024 + (ob ^ (((ob >> 9) & 1) << 5)); }
__device__ __forceinline__ void stage_rc(int b, int& R, int& C) { const int st = b / 1024, sb = b % 1024, swz = sb ^ (((sb >> 9) & 1) << 5); R = (st >> 1) * 16 + swz / 64; C = (st & 1) * 32 + (swz % 64) / 2; }

struct Unit { const char* A; const char* B; int a, b, c, d; };

template <int F8 = 0  , class Epi, class Sched>
__device__ __forceinline__ void gemm_phase(LAS unsigned char* lds, const int K, const Sched& S, const Epi& E) {
  const int tid = threadIdx.x, wid = __builtin_amdgcn_readfirstlane(tid >> 6), lane = tid & 63, wr = wid >> 2, wc = wid & 3, fr = lane & 15, fq = lane >> 4;
  const int nt = K / BK;
  int R[2], C[2];
#pragma unroll
  for (int i = 0; i < 2; ++i) stage_rc(tid * 16 + i * 8192, R[i], C[i]);
  constexpr bool GA = Sched::GATHER;
  unsigned oB[2], oA[2][2];
  LAS unsigned* onxt = (LAS unsigned*)(lds + STAGE_BYTES + 1024) + tid;
#pragma unroll
  for (int i = 0; i < 2; ++i) oB[i] = (unsigned)(R[i] * S.ldb + C[i]) * 2u;
  const size_t hB = (size_t)HALF * S.ldb * 2, hA = GA ? (size_t)0 : (size_t)HALF * S.lda * 2;
  const size_t kstep = (size_t)(BK * 2);
  const unsigned ldsw = (unsigned)wid * 1024u;
  const int aoff = lds_byte(wr * 64 + fr, fq * 8), boff = lds_byte(wc * 32 + fr, fq * 8);
#define G8_SA(b, h) (((b) * 2 + (h)) * HTB)
#define G8_SB(b, h) ((4 + (b) * 2 + (h)) * HTB)
#define G8_STAGE_X(bufoff, gbase, off2, AUX) do { _Pragma("unroll") for (int _i = 0; _i < 2; ++_i) \
    __builtin_amdgcn_global_load_lds((const unsigned*)((const char*)(gbase) + (off2)[_i]), (LAS unsigned*)(lds + (bufoff) + ldsw + _i * 8192), 16, 0, AUX); } while (0)
#define G8_STAGE(bufoff, gbase, off2) G8_STAGE_X(bufoff, gbase, off2, 0)
#define G8_STAGEA(bufoff, gbase, off2) G8_STAGE_X(bufoff, gbase, off2, (Sched::A_SC1 ? 16 : 0))
#define G8_LD16(off_) (*(const LAS i32x4*)(lds + (off_)))
#define G8_LDA(dst, b, h) do { _Pragma("unroll") for (int m = 0; m < 4; ++m) { \
    if constexpr (F8 == 2) dst##8[m] = __builtin_shufflevector(G8_LD16(G8_SA(b, h) + aoff + m * 2048), G8_LD16(G8_SA(b, h) + aoff + m * 2048 + 1024), 0, 1, 2, 3, 4, 5, 6, 7); \
    else { _Pragma("unroll") for (int k = 0; k < 2; ++k) dst[m][k] = *(const LAS bf16x8*)(lds + G8_SA(b, h) + aoff + m * 2048 + k * 1024); } } } while (0)
#define G8_LDB(dst, b, h) do { _Pragma("unroll") for (int n = 0; n < 2; ++n) { \
    if constexpr (F8 == 2) dst##8[n] = __builtin_shufflevector(G8_LD16(G8_SB(b, h) + boff + n * 2048), G8_LD16(G8_SB(b, h) + boff + n * 2048 + 1024), 0, 1, 2, 3, 4, 5, 6, 7); \
    else { _Pragma("unroll") for (int k = 0; k < 2; ++k) dst[n][k] = *(const LAS bf16x8*)(lds + G8_SB(b, h) + boff + n * 2048 + k * 1024); } } } while (0)
#define G8_MMA(ai, bj, At, Bt) do { __builtin_amdgcn_s_setprio(1); \
    if constexpr (F8 == 2) {   \
      _Pragma("unroll") for (int m = 0; m < 4; ++m) _Pragma("unroll") for (int n = 0; n < 2; ++n) \
        acc[ai][bj][m][n] = __builtin_amdgcn_mfma_scale_f32_16x16x128_f8f6f4(Bt##8[n], At##8[m], acc[ai][bj][m][n], 0, 0, 0, 0x7f7f7f7f, 0, 0x7f7f7f7f); \
    } else if constexpr (F8 == 1) { \
      _Pragma("unroll") for (int m = 0; m < 4; ++m) _Pragma("unroll") for (int n = 0; n < 2; ++n) { \
        const i32x4 b0_ = __builtin_bit_cast(i32x4, Bt[n][0]), b1_ = __builtin_bit_cast(i32x4, Bt[n][1]), a0_ = __builtin_bit_cast(i32x4, At[m][0]), a1_ = __builtin_bit_cast(i32x4, At[m][1]); \
        acc[ai][bj][m][n] = __builtin_amdgcn_mfma_scale_f32_16x16x128_f8f6f4(__builtin_shufflevector(b0_, b1_, 0, 1, 2, 3, 4, 5, 6, 7), __builtin_shufflevector(a0_, a1_, 0, 1, 2, 3, 4, 5, 6, 7), \
                                                                             acc[ai][bj][m][n], 0, 0, 0, 0x7f7f7f7f, 0, 0x7f7f7f7f); } \
    } else { \
      _Pragma("unroll") for (int m = 0; m < 4; ++m) _Pragma("unroll") for (int n = 0; n < 2; ++n) _Pragma("unroll") for (int k = 0; k < 2; ++k) \
        acc[ai][bj][m][n] = __builtin_amdgcn_mfma_f32_16x16x32_bf16(Bt[n][k], At[m][k], acc[ai][bj][m][n], 0, 0, 0); } \
    __builtin_amdgcn_s_setprio(0); } while (0)
#define G8_WAIT_V(n) asm volatile("s_waitcnt vmcnt(" #n ")" ::: "memory")
#define G8_WAIT_L(n) asm volatile("s_waitcnt lgkmcnt(" #n ")" ::: "memory")
#define G8_BAR __builtin_amdgcn_s_barrier()
#define G8_SCHED __builtin_amdgcn_sched_barrier(0)
  Unit cur, nxt; int ui = 0;
  if (!S.next(0, cur)) return;
  S.offs(cur, R, C, oA);
  f32x4 acc[2][2][4][2];
#pragma unroll
  for (int a = 0; a < 2; ++a)
#pragma unroll
    for (int b = 0; b < 2; ++b)
#pragma unroll
      for (int m = 0; m < 4; ++m)
#pragma unroll
        for (int n = 0; n < 2; ++n) acc[a][b][m][n] = (f32x4){0.f, 0.f, 0.f, 0.f};
  bf16x8 At[4][2], B0[2][2], B1[2][2];
  i32x8 At8[4], B08[2], B18[2];
  const char* cA = cur.A; const char* cB = cur.B;
  G8_STAGE(G8_SB(0, 0), cB, oB); G8_STAGE(G8_SB(0, 1), cB + hB, oB); G8_STAGEA(G8_SA(0, 0), cA, oA[0]); G8_STAGEA(G8_SA(0, 1), cA + hA, oA[GA]);
  if (wr == 1) G8_BAR;
  G8_WAIT_V(2); G8_BAR;
  G8_STAGE(G8_SB(1, 0), cB + kstep, oB); G8_STAGEA(G8_SA(1, 0), cA + kstep, oA[0]); G8_STAGE(G8_SB(1, 1), cB + kstep + hB, oB);
  G8_WAIT_V(6); G8_BAR;
  for (;;) {
    const bool has_next = S.next(ui + 1, nxt);
    if (GA && has_next) {
      unsigned oAn[2][2]; S.offs(nxt, R, C, oAn);
#pragma unroll
      for (int h = 0; h < 2; ++h)
#pragma unroll
        for (int i = 0; i < 2; ++i) onxt[(h * 2 + i) * 512] = oAn[h][i];
    }
    const char* nA = has_next ? nxt.A : cA; const char* nB = has_next ? nxt.B : cB;
#pragma unroll 1
    for (int t = 0; t < nt; t += 2) {
      const bool last = (t == nt - 2);
      const char* a1 = cA + (size_t)(t + 1) * kstep;
      const char* a2 = last ? nA : cA + (size_t)(t + 2) * kstep; const char* b2 = last ? nB : cB + (size_t)(t + 2) * kstep;
      const char* a3 = a2 + kstep; const char* b3 = b2 + kstep;
      G8_LDB(B0, 0, 0); G8_LDB(B1, 0, 1); G8_SCHED; G8_LDA(At, 0, 0); G8_STAGEA(G8_SA(1, 1), a1 + hA, oA[GA]);
      G8_WAIT_V(8); G8_WAIT_L(0); G8_BAR; G8_MMA(0, 0, At, B0); G8_MMA(0, 1, At, B1); G8_BAR; G8_SCHED;
      if (GA && last && has_next) {
#pragma unroll
        for (int h = 0; h < 2; ++h)
#pragma unroll
          for (int i = 0; i < 2; ++i) oA[h][i] = onxt[(h * 2 + i) * 512];
      }
      G8_LDA(At, 0, 1); G8_STAGE(G8_SB(0, 0), b2, oB); G8_STAGE(G8_SB(0, 1), b2 + hB, oB); G8_STAGEA(G8_SA(0, 0), a2, oA[0]);
      G8_WAIT_V(8); G8_WAIT_L(0); G8_BAR; G8_MMA(1, 0, At, B0); G8_MMA(1, 1, At, B1); G8_BAR; G8_SCHED;
      G8_LDB(B0, 1, 0); G8_LDB(B1, 1, 1); G8_SCHED; G8_LDA(At, 1, 0); G8_STAGEA(G8_SA(0, 1), a2 + hA, oA[GA]);
      G8_WAIT_V(8); G8_WAIT_L(0); G8_BAR; G8_MMA(0, 0, At, B0); G8_MMA(0, 1, At, B1); G8_BAR; G8_SCHED;
      G8_LDA(At, 1, 1); G8_STAGE(G8_SB(1, 0), b3, oB); G8_STAGE(G8_SB(1, 1), b3 + hB, oB); G8_STAGEA(G8_SA(1, 0), a3, oA[0]);
      G8_WAIT_V(8); G8_WAIT_L(0); G8_BAR; G8_MMA(1, 0, At, B0); G8_MMA(1, 1, At, B1); G8_BAR; G8_SCHED;
    }
    if (wr == 0) G8_BAR;
    E(acc, cur, wr, wc, fr, fq);
    if (!has_next) break;
#pragma unroll
    for (int a = 0; a < 2; ++a)
#pragma unroll
      for (int b = 0; b < 2; ++b)
#pragma unroll
        for (int m = 0; m < 4; ++m)
#pragma unroll
          for (int n = 0; n < 2; ++n) acc[a][b][m][n] = (f32x4){0.f, 0.f, 0.f, 0.f};
    cur = nxt; cA = nA; cB = nB; ++ui;
    if (wr == 1) G8_BAR;
  }
  G8_WAIT_V(0);
  G8_BAR;
#undef G8_SA
#undef G8_SB
#undef G8_STAGE
#undef G8_STAGEA
#undef G8_STAGE_X
#undef G8_LD16
#undef G8_LDA
#undef G8_LDB
#undef G8_MMA
#undef G8_WAIT_V
#undef G8_WAIT_L
#undef G8_BAR
#undef G8_SCHED
}

struct DenseSched {
  static constexpr bool GATHER = false, A_SC1 = false;
  const char* A; const char* B; int lda, ldb; int nM, nN, nwg, G, c;
  __device__ __forceinline__ void init(const void* A_, int lda_, const void* B_, int ldb_, int M, int N, int G_, int c_) {
    A = (const char*)A_; B = (const char*)B_; lda = lda_; ldb = ldb_; nM = M / BM; nN = N / BM; nwg = nM * nN; G = G_; c = c_; }
  __device__ __forceinline__ bool next(int i, Unit& u) const {
    const long L = (long)i * G + c; if (L >= nwg) return false;
    int wgid = (int)L; { const int q = nwg / NXCD, r = nwg % NXCD, xcd = wgid % NXCD, off = wgid / NXCD; wgid = (xcd < r ? xcd * (q + 1) : r * (q + 1) + (xcd - r) * q) + off; }
    const int nig = WGM * nN, gid = wgid / nig, fm = gid * WGM, gsz = (nM % WGM == 0) ? WGM : ((nM - fm) < WGM ? (nM - fm) : WGM);
    const int pm = fm + ((wgid % nig) % gsz), pn = (wgid % nig) / gsz;
    u.a = pm; u.b = pn; u.c = 0; u.d = 0;
    u.A = A + (size_t)pm * BM * lda * 2; u.B = B + (size_t)pn * BM * ldb * 2; return true;
  }
  __device__ __forceinline__ void offs(const Unit&, const int (&R)[2], const int (&C)[2], unsigned (&o)[2][2]) const {
#pragma unroll
    for (int h = 0; h < 2; ++h)
#pragma unroll
      for (int i = 0; i < 2; ++i) o[h][i] = (unsigned)(R[i] * lda + C[i]) * 2u;
  }
};
}

__device__ __forceinline__ u32x4 pack8(const f32x4& a, const f32x4& b) { u32x4 w; w.x = pk2(a[0], a[1]); w.y = pk2(a[2], a[3]); w.z = pk2(b[0], b[1]); w.w = pk2(b[2], b[3]); return w; }

__device__ __forceinline__ __amdgpu_buffer_rsrc_t mk_rsrc(const void* base) { return __builtin_amdgcn_make_buffer_rsrc((void*)base, 0, 0x7fffffff, 0x00020000); }

__device__ __forceinline__ void rope4(f32x4& a, f32x4& b, const f32x2* cs) {
#pragma unroll
  for (int j = 0; j < 4; ++j) { const float c = cs[j].x, s = cs[j].y, x1 = a[j], x2 = b[j]; a[j] = x1 * c - x2 * s; b[j] = x1 * s + x2 * c; }
}

#define EPI_ROW(ri) (((ri) >> 2) * 128 + wr * 64 + ((ri) & 3) * 16 + fr)
#define EPI_FENCE() asm volatile("" ::: "memory")

struct EpiInproj {
  bf16_t* PROJ; const float* rs1; float* ssqp; const f32x2* CS;
  __device__ __forceinline__ void operator()(const f32x4 (&acc)[2][2][4][2], const g8::Unit& u, int wr, int wc, int fr, int fq) const {
    asm volatile("" : "+v"(fr), "+v"(fq));
    const int pm = u.a, pn = u.b;
    const bool cq0 = (pn == 6 || pn == 7), cq1 = (pn == 6), ckv0 = (pn == 8), ckv1 = (pn == 7);
    float rsv[8];
#pragma unroll
    for (int ri = 0; ri < 8; ++ri) rsv[ri] = rs1[pm * 256 + EPI_ROW(ri)];
#pragma unroll
    for (int ri = 0; ri < 8; ++ri) {
      EPI_FENCE();
      const int ai = ri >> 2, m = ri & 3;
      const int row = pm * 256 + EPI_ROW(ri);
      const float rs = rsv[ri];
      float sq = 0.f, skv = 0.f;
#pragma unroll
      for (int bj = 0; bj < 2; ++bj) {
        const int G = 8 * pn + 4 * bj + wc;
        f32x4 v0 = acc[ai][bj][m][0] * rs, v1 = acc[ai][bj][m][1] * rs;
        if (G == 68) {
          f32x2 cs[4];
#pragma unroll
          for (int j = 0; j < 4; ++j) cs[j] = CS[(size_t)row * 16 + 4 * fq + j];
          rope4(v0, v1, cs);
          u32x2 w0, w1; w0.x = pk2(v0[0], v0[1]); w0.y = pk2(v0[2], v0[3]); w1.x = pk2(v1[0], v1[1]); w1.y = pk2(v1[2], v1[3]);
          *(u32x2*)(PROJ + (size_t)row * NP + KR_OFF + 4 * fq) = w0;
          *(u32x2*)(PROJ + (size_t)row * NP + KR_OFF + 16 + 4 * fq) = w1;
        } else {
          *(u32x4*)(PROJ + (size_t)row * NP + 32 * G + 8 * fq) = pack8(v0, v1);
          const float s = (v0[0] * v0[0] + v0[1] * v0[1]) + (v0[2] * v0[2] + v0[3] * v0[3]) + (v1[0] * v1[0] + v1[1] * v1[1]) + (v1[2] * v1[2] + v1[3] * v1[3]);
          if (bj == 0 ? cq0 : cq1) sq += s;
          if (bj == 0 ? ckv0 : ckv1) skv += s;
        }
      }
      if (cq0) { sq += __shfl_xor(sq, 16); sq += __shfl_xor(sq, 32); if (fq == 0) ssqp[(size_t)row * 16 + (pn - 6) * 4 + wc] = sq; }
      if (ckv0 || ckv1) { skv += __shfl_xor(skv, 16); skv += __shfl_xor(skv, 32); if (fq == 0) ssqp[(size_t)row * 16 + 8 + (pn - 7) * 4 + wc] = skv; }
    }
  }
};

struct EpiUq {
  bf16_t* QB; const float* ssqp; const f32x2* CS; bool dry;
  __device__ __forceinline__ void operator()(const f32x4 (&acc)[2][2][4][2], const g8::Unit& u, int wr, int wc, int fr, int fq) const {
    asm volatile("" : "+v"(fr), "+v"(fq));
    const int pm = u.a, pn = u.b;
    const bool rope0 = ((8 * pn + wc) % 3) == 2, rope1 = ((8 * pn + 4 + wc) % 3) == 2;
    f32x4 na, nb;
    { const f32x4* pp = (const f32x4*)(ssqp + (size_t)(pm * 256 + EPI_ROW(0)) * 16); na = pp[0]; nb = pp[1]; }
#pragma unroll
    for (int ri = 0; ri < 8; ++ri) {
      const int ai = ri >> 2, m = ri & 3;
      const int row = pm * 256 + EPI_ROW(ri);
      const f32x4 a = na, b = nb;
      EPI_FENCE();
      if (ri < 7) { const f32x4* pp = (const f32x4*)(ssqp + (size_t)(pm * 256 + EPI_ROW(ri + 1)) * 16); na = pp[0]; nb = pp[1]; }
      const float ss = ((a[0] + a[1]) + (a[2] + a[3])) + ((b[0] + b[1]) + (b[2] + b[3]));
      const float rs = rsqrtf(ss * (1.f / 384.f) + EPS) * QSCALE;
#pragma unroll
      for (int bj = 0; bj < 2; ++bj) {
        const int G = 8 * pn + 4 * bj + wc;
        f32x4 v0 = acc[ai][bj][m][0] * rs, v1 = acc[ai][bj][m][1] * rs;
        if (bj == 0 ? rope0 : rope1) {
          f32x2 cs[4];
#pragma unroll
          for (int j = 0; j < 4; ++j) cs[j] = CS[(size_t)row * 16 + 4 * fq + j];
          rope4(v0, v1, cs);
          u32x2 w0, w1; w0.x = pk2(v0[0], v0[1]); w0.y = pk2(v0[2], v0[3]); w1.x = pk2(v1[0], v1[1]); w1.y = pk2(v1[2], v1[3]);
          if (!dry || w0.x == 0x12345679u) { *(u32x2*)(QB + (size_t)row * 768 + 32 * G + 4 * fq) = w0;
          *(u32x2*)(QB + (size_t)row * 768 + 32 * G + 16 + 4 * fq) = w1; }
        } else {
          { const u32x4 w_ = pack8(v0, v1); if (!dry || w_.x == 0x12345679u) *(u32x4*)(QB + (size_t)row * 768 + 32 * G + 8 * fq) = w_; }
        }
      }
    }
  }
};

struct EpiUkv {
  bf16_t* KVB; const float* ssqp; bool dry;
  __device__ __forceinline__ void operator()(const f32x4 (&acc)[2][2][4][2], const g8::Unit& u, int wr, int wc, int fr, int fq) const {
    asm volatile("" : "+v"(fr), "+v"(fq));
    const int pm = u.a, pn = u.b;
    float rsv[8];
#pragma unroll
    for (int ri = 0; ri < 8; ++ri) { const f32x4* pp = (const f32x4*)(ssqp + (size_t)(pm * 256 + EPI_ROW(ri)) * 16 + 8); const f32x4 a = pp[0], b = pp[1]; rsv[ri] = ((a[0] + a[1]) + (a[2] + a[3])) + ((b[0] + b[1]) + (b[2] + b[3])); }
#pragma unroll
    for (int ri = 0; ri < 8; ++ri) {
      const int ai = ri >> 2, m = ri & 3;
      const int row = pm * 256 + EPI_ROW(ri);
      const float rs = rsqrtf(rsv[ri] * (1.f / 256.f) + EPS);
#pragma unroll
      for (int bj = 0; bj < 2; ++bj) {
        const int G = 8 * pn + 4 * bj + wc;
        { const u32x4 w_ = pack8(acc[ai][bj][m][0] * rs, acc[ai][bj][m][1] * rs); if (!dry || w_.x == 0x12345679u) *(u32x4*)(KVB + (size_t)row * 1024 + 32 * G + 8 * fq) = w_; }
      }
    }
  }
};

struct EpiWout {
  const float* x; bf16_t* HB; unsigned char* H8;
  __device__ __forceinline__ void operator()(const f32x4 (&acc)[2][2][4][2], const g8::Unit& u, int wr, int wc, int fr, int fq) const {
    asm volatile("" : "+v"(fr), "+v"(fq));
    const int pm = u.a, pn = u.b;
#pragma unroll
    for (int half = 0; half < 2; ++half) {
      EPI_FENCE();
      u32x4 xr[4][2];
#pragma unroll
      for (int q = 0; q < 4; ++q) { const int row = pm * 256 + EPI_ROW(half * 4 + q);
#pragma unroll
        for (int bj = 0; bj < 2; ++bj) xr[q][bj] = *(const u32x4*)(HB + (size_t)row * 1024 + 32 * (8 * pn + 4 * bj + wc) + 8 * fq); }
#pragma unroll
      for (int q = 0; q < 4; ++q) {
        const int ri = half * 4 + q, ai = ri >> 2, m = ri & 3;
        const int row = pm * 256 + EPI_ROW(ri);
#pragma unroll
        for (int bj = 0; bj < 2; ++bj) {
          const size_t off = (size_t)row * 1024 + 32 * (8 * pn + 4 * bj + wc) + 8 * fq;
          const u32x4 xw = xr[q][bj];
          const f32x4 x0 = {bflo(xw.x), bfhi(xw.x), bflo(xw.y), bfhi(xw.y)}, x1 = {bflo(xw.z), bfhi(xw.z), bflo(xw.w), bfhi(xw.w)};
          const f32x4 v0 = acc[ai][bj][m][0] + x0, v1 = acc[ai][bj][m][1] + x1;
          *(u32x4*)(HB + off) = pack8(v0, v1);
#if MOE_FP8
          *(u32x2*)(H8 + off) = pk8_fp8(v0, v1, F8_SH);
#endif
        }
      }
    }
  }
};

template <bool GATHER_>
struct MoeSched {
  static constexpr bool GATHER = GATHER_;
  static constexpr bool A_SC1 = !GATHER_;
  const char* A; const char* B; int lda, ldb; int ncol, total, G, c;
  const LAS int* tb; const LAS int* cn; const int* ltok; size_t bstride;
  int n1, r; const int* flg;
  __device__ __forceinline__ bool next(int i, g8::Unit& u) const {
    long L = (long)i * G + c;
    if (!GATHER_ && i >= n1) { if (c < r) return false; L = (long)n1 * G + (long)(i - n1) * (G - r) + (c - r); }
    if (L >= total) return false;
    const int rt = (int)(L / ncol), pn = (int)(L % ncol);
    if (!GATHER_) { unsigned sp_ = 0; while (__hip_atomic_load(flg + rt, __ATOMIC_RELAXED, __HIP_MEMORY_SCOPE_AGENT) < 16) { __builtin_amdgcn_s_sleep(2); if (++sp_ > (1u << 22)) break; } }
    const int e = __builtin_popcount((unsigned)__ballot(tb[threadIdx.x & 31] <= rt)) - 1;
    const int mt = rt - tb[e];
    u.a = e; u.b = mt; u.c = pn; u.d = rt;
    u.B = B + (size_t)e * bstride + (size_t)pn * 256 * ldb * 2;
    u.A = GATHER_ ? A : A + (size_t)rt * 256 * lda * 2;
    return true;
  }
  __device__ __forceinline__ void offs(const g8::Unit& u, const int (&R)[2], const int (&C)[2], unsigned (&o)[2][2]) const {
    if (GATHER_) {
      const int cnt = cn[u.a];
#pragma unroll
      for (int h = 0; h < 2; ++h)
#pragma unroll
        for (int i = 0; i < 2; ++i) { int pos = u.b * 256 + h * 128 + R[i]; pos = pos < cnt ? pos : cnt - 1; const int tok = ltok[u.a * ECAP + pos] >> 1;
          o[h][i] = (unsigned)(tok * lda + C[i]) * 2u; }
    } else {
#pragma unroll
      for (int h = 0; h < 2; ++h)
#pragma unroll
        for (int i = 0; i < 2; ++i) o[h][i] = (unsigned)(R[i] * lda + C[i]) * 2u;
    }
  }
};

struct EpiGU {
  bf16_t* HID; const float* rs2; const int* ltok; const LAS int* cn; bool dry; int* flg;
  __device__ __forceinline__ void operator()(const f32x4 (&acc)[2][2][4][2], const g8::Unit& u, int wr, int wc, int fr, int fq) const {
    asm volatile("" : "+v"(fr), "+v"(fq));
    const int e = u.a, mt = u.b, pn = u.c, rt = u.d; const int cnt = cn[e];
    const __amdgpu_buffer_rsrc_t rsrc = mk_rsrc(HID);
    float rsa[8];
#pragma unroll
    for (int ri = 0; ri < 8; ++ri) { int pos = mt * 256 + EPI_ROW(ri); pos = pos < cnt ? pos : cnt - 1; rsa[ri] = rs2[e * ECAP + pos]; }
#pragma unroll
    for (int half = 0; half < 2; ++half) {
      EPI_FENCE();
#pragma unroll
      for (int q = 0; q < 4; ++q) {
        const int ri = half * 4 + q, ai = ri >> 2, m = ri & 3;
        const int r = EPI_ROW(ri), pos = mt * 256 + r;
        if (pos < cnt) {
          const float rs = rsa[ri] * (MOE_FP8 ? 1.f / (F8_SH * F8_SWGU) : 1.f);
          f32x4 h0, h1;
#pragma unroll
          for (int j = 0; j < 4; ++j) {
            const float g0 = acc[ai][0][m][0][j] * rs, u0 = acc[ai][1][m][0][j] * rs, g1 = acc[ai][0][m][1][j] * rs, u1 = acc[ai][1][m][1][j] * rs;
            h0[j] = g0 * __builtin_amdgcn_rcpf(1.f + __expf(-g0)) * u0; h1[j] = g1 * __builtin_amdgcn_rcpf(1.f + __expf(-g1)) * u1;
          }
#if MOE_FP8
          __builtin_amdgcn_raw_buffer_store_b64(pk8_fp8(h0, h1, F8_SHID), rsrc, (int)((unsigned)((rt * 256 + r) * 256 + pn * 128 + wc * 32 + 8 * fq)), 0, 16);
#else
          { const u32x4 w_ = pack8(h0, h1); if (!dry || w_.x == 0x12345679u) __builtin_amdgcn_raw_buffer_store_b128(w_, rsrc, (int)((unsigned)(((rt * 256 + r) * 256 + pn * 128 + wc * 32 + 8 * fq) * 2)), 0, 16); }
#endif
        }
      }
    }
    asm volatile("s_waitcnt vmcnt(0)" ::: "memory");
    if (fr == 0 && fq == 0) __hip_atomic_fetch_add(flg + rt, 1, __ATOMIC_RELAXED, __HIP_MEMORY_SCOPE_AGENT);
  }
};

struct EpiDown {
  bf16_t* Y2; const int* ltok; const float* lgate; const LAS int* cn; bool dry;
  __device__ __forceinline__ void operator()(const f32x4 (&acc)[2][2][4][2], const g8::Unit& u, int wr, int wc, int fr, int fq) const {
    asm volatile("" : "+v"(fr), "+v"(fq));
    const int e = u.a, mt = u.b, pn = u.c; const int cnt = cn[e];
    int ds[8]; float gv[8];
#pragma unroll
    for (int ri = 0; ri < 8; ++ri) { int pos = mt * 256 + EPI_ROW(ri); pos = pos < cnt ? pos : cnt - 1; ds[ri] = ltok[e * ECAP + pos]; gv[ri] = lgate[e * ECAP + pos]; }
#pragma unroll
    for (int ri = 0; ri < 8; ++ri) {
      const int ai = ri >> 2, m = ri & 3;
      const int pos = mt * 256 + EPI_ROW(ri);
      if (pos < cnt) {
        const float g = gv[ri] * (MOE_FP8 ? 1.f / (F8_SHID * F8_SWD) : 1.f);
#pragma unroll
        for (int bj = 0; bj < 2; ++bj)
          { const u32x4 w_ = pack8(acc[ai][bj][m][0] * g, acc[ai][bj][m][1] * g); if (!dry || w_.x == 0x12345679u) *(u32x4*)(Y2 + (size_t)ds[ri] * 1024 + pn * 256 + wc * 64 + bj * 32 + 8 * fq) = w_; }
      }
    }
  }
};

__device__ __forceinline__ int inproj_src_col(int L) {
  if (L < 1024) return L;
  if (L < 1536) return 1040 + (L - 1024);
  if (L < 1920) return 1552 + (L - 1536);
  if (L < 2176) return 1936 + (L - 1920);
  if (L < 2208) return 2192 + (L - 2176);
  if (L < 2224) return 1024 + (L - 2208);
  return -1;
}
__device__ __forceinline__ void tr_item(const float* src, int ld, int cbase, int nvalid, bool permute, const float* kscale, int k0, bf16_t* dst, int K, LAS float* scr, int lane) {
  if (nvalid > 0) {
    f32x4 v[8];
#pragma unroll
    for (int i = 0; i < 8; ++i) v[i] = *(const f32x4*)(src + (size_t)(k0 + i * 8 + (lane >> 3)) * ld + cbase + (lane & 7) * 4);
#pragma unroll
    for (int i = 0; i < 8; ++i) { const int kk = i * 8 + (lane >> 3); const float sc = kscale ? kscale[k0 + kk] : 1.f; LAS float* w = scr + kk * 33 + (lane & 7) * 4;
      w[0] = v[i].x * sc; w[1] = v[i].y * sc; w[2] = v[i].z * sc; w[3] = v[i].w * sc; }
  }
  LDS_WAIT();
  const int c = lane & 7;
#pragma unroll
  for (int j = 0; j < 4; ++j) { const int n = (lane >> 3) + 8 * j; const int sc_ = permute ? perm32(n) : n; const LAS float* s = scr + (8 * c) * 33 + sc_;
    u32x4 o = {0u, 0u, 0u, 0u};
    if (sc_ < nvalid) { o.x = pk2(s[0 * 33], s[1 * 33]); o.y = pk2(s[2 * 33], s[3 * 33]); o.z = pk2(s[4 * 33], s[5 * 33]); o.w = pk2(s[6 * 33], s[7 * 33]); }
    *(u32x4*)(dst + (size_t)n * K + 8 * c) = o; }
  LDS_WAIT();
}
__device__ __forceinline__ void tr_item8(const float* src, int ld, int cbase, const float* kscale, float gscale, int k0, unsigned char* dst, int K8, LAS float* scr, int lane) {
  f32x4 v[8];
#pragma unroll
  for (int i = 0; i < 8; ++i) v[i] = *(const f32x4*)(src + (size_t)(k0 + i * 8 + (lane >> 3)) * ld + cbase + (lane & 7) * 4);
#pragma unroll
  for (int i = 0; i < 8; ++i) { const int kk = i * 8 + (lane >> 3); const float sc = kscale ? kscale[k0 + kk] : 1.f; LAS float* w = scr + kk * 33 + (lane & 7) * 4;
    w[0] = v[i].x * sc; w[1] = v[i].y * sc; w[2] = v[i].z * sc; w[3] = v[i].w * sc; }
  LDS_WAIT();
  const int c = lane & 7;
#pragma unroll
  for (int j = 0; j < 4; ++j) { const int n = (lane >> 3) + 8 * j; const LAS float* s = scr + (8 * c) * 33 + perm32(n);
    const f32x4 a = {s[0 * 33], s[1 * 33], s[2 * 33], s[3 * 33]}, b = {s[4 * 33], s[5 * 33], s[6 * 33], s[7 * 33]};
    *(u32x2*)(dst + (size_t)n * K8 + 8 * c) = pk8_fp8(a, b, gscale); }
  LDS_WAIT();
}
__device__ __forceinline__ void tr_item_s(const float* src, int ld, int col, const float* kscale, int k0, bf16_t* dst, int K, LAS float* scr, int lane) {
#pragma unroll 8
  for (int i = 0; i < 32; ++i) { const int kk = 2 * i + (lane >> 5); float v = 0.f;
    if (col >= 0) { v = src[(size_t)(k0 + kk) * ld + col]; if (kscale) v *= kscale[k0 + kk]; }
    scr[kk * 33 + (lane & 31)] = v; }
  LDS_WAIT();
  const int c = lane & 7;
#pragma unroll
  for (int j = 0; j < 4; ++j) { const int n = (lane >> 3) + 8 * j; const LAS float* s = scr + (8 * c) * 33 + n;
    u32x4 o; o.x = pk2(s[0 * 33], s[1 * 33]); o.y = pk2(s[2 * 33], s[3 * 33]); o.z = pk2(s[4 * 33], s[5 * 33]); o.w = pk2(s[6 * 33], s[7 * 33]);
    *(u32x4*)(dst + (size_t)n * K + 8 * c) = o; }
  LDS_WAIT();
}

__device__ __forceinline__ void conv_gu_item(const Params& p, int r, LAS float* scr, int lane) {
  const int e = r / 256, kb = (r % 256) / 16, nb = r % 16;
  const int pn = nb >> 3, bj = (nb >> 2) & 1;
  const float* src = (bj ? p.in[18] : p.in[17]) + (size_t)e * 1024 * 256;
#if MOE_FP8
  tr_item8(src, 256, 128 * pn + 32 * (nb & 3), p.in[12], F8_SWGU, kb * 64, p.ws + WS_WGU + ((size_t)e * 512 + nb * 32) * 1024 + kb * 64, 1024, scr, lane);
#else
  tr_item(src, 256, 128 * pn + 32 * (nb & 3), 32, true, p.in[12], kb * 64, (bf16_t*)(p.ws + WS_WGU) + ((size_t)e * 512 + nb * 32) * 1024 + kb * 64, 1024, scr, lane);
#endif
}
__device__ __forceinline__ int glog8(int nb) { return (nb & ~7) + 2 * (nb & 3) + ((nb >> 2) & 1); }
__device__ __forceinline__ void conv_d_item(const Params& p, int r, LAS float* scr, int lane) {
  const int e = r / 128, kb = (r % 128) / 32, nb = r % 32;
#if MOE_FP8
  tr_item8(p.in[19] + (size_t)e * 256 * 1024, 1024, 32 * glog8(nb), nullptr, F8_SWD, kb * 64, p.ws + WS_WD + ((size_t)e * 1024 + nb * 32) * 256 + kb * 64, 256, scr, lane);
#else
  tr_item(p.in[19] + (size_t)e * 256 * 1024, 1024, 32 * glog8(nb), 32, true, nullptr, kb * 64, (bf16_t*)(p.ws + WS_WD) + ((size_t)e * 1024 + nb * 32) * 256 + kb * 64, 256, scr, lane);
#endif
}
constexpr int CONV_GU_P0 = 2048, CONV_GU_P1 = 4096, CONV_GU_P2 = 2048;
constexpr int CONV_D_P1 = 4096;

__device__ __forceinline__ void p0_prologue(const Params& p, LAS unsigned char* lds, int G, int vb) {
  const int tid = threadIdx.x, lane = tid & 63, wave = tid >> 6;
  LAS float* scr = (LAS float*)(lds + wave * 8704);
  const int gw = vb * 8 + wave, NGW = G * 8;
  unsigned char* ws = p.ws;
  const float* attn_nw = p.in[2]; const float* w_in = p.in[3];
  const float* qnw = p.in[7]; const float* w_uq = p.in[8]; const float* kvnw = p.in[9]; const float* w_ukv = p.in[10];
  const float* w_out = p.in[11]; const float* fnw = p.in[12]; const float* rgw = p.in[13]; const float* rew = p.in[15];
  const float* ewg = p.in[17]; const float* ewu = p.in[18]; const float* ewd = p.in[19];
  constexpr int I_IN = 16 * 72, I_UQ = 6 * 24, I_UKV = 4 * 32, I_OUT = 16 * 32, I_R = 16 * 2, I_GU = 32 * 16 * 16, I_D = 32 * 4 * 32;
  const int n = lane & 31;
  const int NITEMS = I_IN + I_UQ + I_UKV + I_OUT + I_R + ((G == 256) ? CONV_GU_P0 : I_GU + I_D);
  auto xconv = [&]() {
    const float* x = p.in[0]; bf16_t* XB = (bf16_t*)(ws + WS_XB); float* rs1 = (float*)(ws + WS_RS1);
    f32x4 v[4], w[4];
    { const int m = gw, m2 = m + NGW;
      const f32x4* xr = (const f32x4*)(x + (size_t)(m < NTOK ? m : 0) * DM) + lane; const f32x4* xr2 = (const f32x4*)(x + (size_t)(m2 < NTOK ? m2 : 0) * DM) + lane;
#pragma unroll
      for (int j = 0; j < 4; ++j) { v[j] = xr[64 * j]; w[j] = xr2[64 * j]; } }
#pragma unroll 1
    for (int m = gw; m < NTOK; m += 2 * NGW) {
      const int m2 = m + NGW; const bool has2 = m2 < NTOK;
      const int mn = m + 2 * NGW, mn2 = mn + NGW;
      f32x4 nv[4], nw[4];
      { const f32x4* xr = (const f32x4*)(x + (size_t)(mn < NTOK ? mn : m) * DM) + lane; const f32x4* xr2 = (const f32x4*)(x + (size_t)(mn2 < NTOK ? mn2 : m) * DM) + lane;
#pragma unroll
        for (int j = 0; j < 4; ++j) { nv[j] = xr[64 * j]; nw[j] = xr2[64 * j]; } }
      float s = 0.f, s2 = 0.f;
#pragma unroll
      for (int j = 0; j < 4; ++j) { s += (v[j].x * v[j].x + v[j].y * v[j].y) + (v[j].z * v[j].z + v[j].w * v[j].w); s2 += (w[j].x * w[j].x + w[j].y * w[j].y) + (w[j].z * w[j].z + w[j].w * w[j].w); }
      s = wave_sum(s); s2 = wave_sum(s2);
      if (lane == 0) { rs1[m] = rsqrtf(s * (1.f / DM) + EPS); if (has2) rs1[m2] = rsqrtf(s2 * (1.f / DM) + EPS); }
      u32x2* o8 = (u32x2*)(XB + (size_t)m * DM) + lane; u32x2* o82 = (u32x2*)(XB + (size_t)m2 * DM) + lane;
#pragma unroll
      for (int j = 0; j < 4; ++j) { u32x2 q; q.x = pk2(v[j].x, v[j].y); q.y = pk2(v[j].z, v[j].w); o8[64 * j] = q; }
      if (has2) {
#pragma unroll
        for (int j = 0; j < 4; ++j) { u32x2 q; q.x = pk2(w[j].x, w[j].y); q.y = pk2(w[j].z, w[j].w); o82[64 * j] = q; }
      }
#pragma unroll
      for (int j = 0; j < 4; ++j) { v[j] = nv[j]; w[j] = nw[j]; }
    }
  };
  auto wconv = [&]() {
  for (int it = gw; it < NITEMS; it += NGW) {
    int r = it;
    if (r < I_IN) { const int kb = r / 72, nb = r % 72; const int c0 = inproj_src_col(32 * nb); const int nv = (nb < 69) ? 32 : (nb == 69 ? 16 : 0);
      tr_item(w_in, 2224, c0 < 0 ? 0 : c0, nv, nb != 68, attn_nw, kb * 64, (bf16_t*)(ws + WS_WIN) + (size_t)(nb * 32) * 1024 + kb * 64, 1024, scr, lane); continue; }
    r -= I_IN;
    if (r < I_UQ) { const int kb = r / 24, nb = r % 24;
      tr_item(w_uq, 768, 32 * nb, 32, (nb % 3) != 2, qnw, kb * 64, (bf16_t*)(ws + WS_WUQ) + (size_t)(nb * 32) * 384 + kb * 64, 384, scr, lane); continue; }
    r -= I_UQ;
    if (r < I_UKV) { const int kb = r / 32, nb = r % 32;
      tr_item(w_ukv, 1024, 32 * nb, 32, true, kvnw, kb * 64, (bf16_t*)(ws + WS_WUKV) + (size_t)(nb * 32) * 256 + kb * 64, 256, scr, lane); continue; }
    r -= I_UKV;
    if (r < I_OUT) { const int kb = r / 32, nb = r % 32;
      tr_item(w_out, 1024, 32 * nb, 32, true, nullptr, kb * 64, (bf16_t*)(ws + WS_WOUT) + (size_t)(nb * 32) * 1024 + kb * 64, 1024, scr, lane); continue; }
    r -= I_OUT;
    if (r < I_R) { const int kb = r / 2, nb = r % 2; const int Rr = nb * 32 + n;
      const float* src = (Rr < 4) ? rgw : rew; const int ld = (Rr < 4) ? 4 : 32; const int col = (Rr < 4) ? Rr : (Rr < 36 ? Rr - 4 : -1);
      tr_item_s(src, ld, col, fnw, kb * 64, (bf16_t*)(ws + WS_WR) + (size_t)(nb * 32) * 1024 + kb * 64, 1024, scr, lane); continue; }
    r -= I_R;
    if (r < I_GU) { conv_gu_item(p, r, scr, lane); continue; }
    r -= I_GU;
    conv_d_item(p, r, scr, lane);
  }
  };
  if (wave & 1) { xconv(); wconv(); } else { wconv(); xconv(); }
  const int gt = vb * 512 + tid, NGT = G * 512;
  const int* pos = (const int*)p.in[1]; f32x2* CS = (f32x2*)(ws + WS_CS);
  const float inv = powf(10000.0f, -(float)(gt & 15) / 16.0f);
  for (int i = gt; i < NTOK * 16; i += NGT) {
    const int row = i >> 4;
    const float ang = (float)pos[row] * inv;
    const double rev = (double)ang * 0.15915494309189535; const float frc = (float)(rev - floor(rev));
    CS[i] = (f32x2){__builtin_amdgcn_cosf(frc), __builtin_amdgcn_sinf(frc)};
  }
  if (gt < NEXP) ((int*)(ws + WS_CNT))[gt] = 0;
  if (gt < 512) ((int*)(ws + WS_FLG))[gt] = 0;
  if (gt < 4096) { const int dd = gt >> 4, rr = gt & 15; ((bf16_t*)(ws + WS_GUT))[gt] = (bf16_t)(pk2(p.in[4][rr * 256 + dd], 0.f) & 0xffffu); }
#if !ENABLE_GLA || !ENABLE_MLA
  { u32x4* Y = (u32x4*)(ws + WS_Y); for (int i = gt; i < NTOK * 1024 / 8; i += NGT) Y[i] = (u32x4){0u, 0u, 0u, 0u}; }
#endif
}

constexpr int AT_KSTR = 208;
constexpr int AT_KBUF = 64 * AT_KSTR, AT_VBUF = 8192;
constexpr int AT_KOFF = 0, AT_VOFF = 2 * AT_KBUF;
typedef short v4i16_t __attribute__((ext_vector_type(4)));
__device__ __forceinline__ s16x4 vtr(const LAS unsigned char* p) { return __builtin_bit_cast(s16x4, __builtin_amdgcn_ds_read_tr16_b64_v4i16((LAS v4i16_t*)p)); }

template <bool DO_NEXT>
__device__ __forceinline__ void attn_step(const LAS unsigned char* Kn, const LAS unsigned char* Vc, const bf16x8 (&qf)[6], f32x16& pc0, f32x16& pc1, f32x16& pn0, f32x16& pn1,
                                          f32x16& o0, f32x16& o1, float& mrun, float& lrun, const bool first, const bool diag, const int kb, const int qabs, const int r32, const int hi, const int voffl) {
  const LAS unsigned char* Kb = Kn + r32 * AT_KSTR + hi * 16;
  bf16x8 kf[6];
#pragma unroll
  for (int d0 = 0; d0 < 3; ++d0) { kf[2 * d0] = *(const LAS bf16x8*)(Kb + d0 * 32); kf[2 * d0 + 1] = *(const LAS bf16x8*)(Kb + 32 * AT_KSTR + d0 * 32); }
  __builtin_amdgcn_sched_barrier(0);
  if (diag) {
#pragma unroll
    for (int r = 0; r < 16; ++r) { const int kv = kb + 4 * hi + (r & 3) + 8 * (r >> 2); if (kv > qabs) pc0[r] = -INFINITY; if (kv + 32 > qabs) pc1[r] = -INFINITY; }
  }
  float ma = fmaxf(fmaxf(pc0[0], pc0[1]), pc1[0]), mb = fmaxf(fmaxf(pc0[2], pc0[3]), pc1[1]);
  ma = fmaxf(fmaxf(ma, pc1[2]), pc1[3]);
#pragma unroll
  for (int r = 4; r < 16; r += 4) { ma = fmaxf(fmaxf(ma, pc0[r]), pc0[r + 1]); mb = fmaxf(fmaxf(mb, pc0[r + 2]), pc0[r + 3]); ma = fmaxf(fmaxf(ma, pc1[r]), pc1[r + 1]); mb = fmaxf(fmaxf(mb, pc1[r + 2]), pc1[r + 3]); }
  float mt = fmaxf(ma, mb);
  { auto rr = __builtin_amdgcn_permlane32_swap(__float_as_uint(mt), __float_as_uint(mt), false, false); mt = fmaxf(__uint_as_float(rr[0]), __uint_as_float(rr[1])); }
  if (first || __any(mt > 8.0f)) {
    const float dl = first ? mt : fmaxf(mt, 0.f);
    mrun += dl;
    const float alpha = __builtin_amdgcn_exp2f(-dl);
    lrun *= alpha;
#pragma unroll
    for (int r = 0; r < 16; ++r) { pc0[r] -= dl; pc1[r] -= dl; o0[r] *= alpha; o1[r] *= alpha; }
  }
  const LAS unsigned char* Vb = Vc + voffl;
  f32x16 negm;
#pragma unroll
  for (int r = 0; r < 16; ++r) negm[r] = -mrun;
  if (DO_NEXT) {
#pragma unroll
    for (int d0 = 0; d0 < 3; ++d0) {
      pn0 = __builtin_amdgcn_mfma_f32_32x32x16_bf16(kf[2 * d0], qf[d0], d0 ? pn0 : negm, 0, 0, 0);
      pn1 = __builtin_amdgcn_mfma_f32_32x32x16_bf16(kf[2 * d0 + 1], qf[d0], d0 ? pn1 : negm, 0, 0, 0);
    }
  }
  __builtin_amdgcn_sched_barrier(0);
#pragma unroll
  for (int d0 = 3; d0 < 6; ++d0) { kf[2 * (d0 - 3)] = *(const LAS bf16x8*)(Kb + d0 * 32); kf[2 * (d0 - 3) + 1] = *(const LAS bf16x8*)(Kb + 32 * AT_KSTR + d0 * 32); }
  s16x4 vl[4], vh[4];
#pragma unroll
  for (int ks = 0; ks < 2; ++ks) { vl[2 * ks] = vtr(Vb + ks * 1024); vh[2 * ks] = vtr(Vb + ks * 1024 + 512); vl[2 * ks + 1] = vtr(Vb + 4096 + ks * 1024); vh[2 * ks + 1] = vtr(Vb + 4096 + ks * 1024 + 512); }
  __builtin_amdgcn_sched_barrier(0);
#pragma unroll
  for (int r = 0; r < 16; ++r) { pc0[r] = __builtin_amdgcn_exp2f(pc0[r]); pc1[r] = __builtin_amdgcn_exp2f(pc1[r]); }
  if (DO_NEXT) {
#pragma unroll
    for (int d0 = 3; d0 < 6; ++d0) {
      pn0 = __builtin_amdgcn_mfma_f32_32x32x16_bf16(kf[2 * (d0 - 3)], qf[d0], pn0, 0, 0, 0);
      pn1 = __builtin_amdgcn_mfma_f32_32x32x16_bf16(kf[2 * (d0 - 3) + 1], qf[d0], pn1, 0, 0, 0);
    }
  }
  float sacc = pc0[0] + pc1[0];
#pragma unroll
  for (int r = 1; r < 16; ++r) { sacc += pc0[r]; sacc += pc1[r]; if ((r & 1) == 1) asm volatile("" : "+v"(sacc)); }
  lrun += sacc;
  u32x4 pw[4];
#pragma unroll
  for (int s = 0; s < 2; ++s) {
    pw[s] = (u32x4){pk2(pc0[8 * s + 0], pc0[8 * s + 1]), pk2(pc0[8 * s + 2], pc0[8 * s + 3]), pk2(pc0[8 * s + 4], pc0[8 * s + 5]), pk2(pc0[8 * s + 6], pc0[8 * s + 7])};
    pw[2 + s] = (u32x4){pk2(pc1[8 * s + 0], pc1[8 * s + 1]), pk2(pc1[8 * s + 2], pc1[8 * s + 3]), pk2(pc1[8 * s + 4], pc1[8 * s + 5]), pk2(pc1[8 * s + 6], pc1[8 * s + 7])};
  }
  s16x4 wl[4], wh[4];
#pragma unroll
  for (int ks = 2; ks < 4; ++ks) { wl[2 * (ks - 2)] = vtr(Vb + ks * 1024); wh[2 * (ks - 2)] = vtr(Vb + ks * 1024 + 512); wl[2 * (ks - 2) + 1] = vtr(Vb + 4096 + ks * 1024); wh[2 * (ks - 2) + 1] = vtr(Vb + 4096 + ks * 1024 + 512); }
  __builtin_amdgcn_sched_barrier(0);
#pragma unroll
  for (int ks = 0; ks < 2; ++ks) {
    const bf16x8 vf0 = {vl[2 * ks][0], vl[2 * ks][1], vl[2 * ks][2], vl[2 * ks][3], vh[2 * ks][0], vh[2 * ks][1], vh[2 * ks][2], vh[2 * ks][3]};
    const bf16x8 vf1 = {vl[2 * ks + 1][0], vl[2 * ks + 1][1], vl[2 * ks + 1][2], vl[2 * ks + 1][3], vh[2 * ks + 1][0], vh[2 * ks + 1][1], vh[2 * ks + 1][2], vh[2 * ks + 1][3]};
    const bf16x8 pf = __builtin_bit_cast(bf16x8, pw[ks]);
    o0 = __builtin_amdgcn_mfma_f32_32x32x16_bf16(vf0, pf, o0, 0, 0, 0);
    o1 = __builtin_amdgcn_mfma_f32_32x32x16_bf16(vf1, pf, o1, 0, 0, 0);
  }
#pragma unroll
  for (int ks = 2; ks < 4; ++ks) { const int q = 2 * (ks - 2);
    const bf16x8 vf0 = {wl[q][0], wl[q][1], wl[q][2], wl[q][3], wh[q][0], wh[q][1], wh[q][2], wh[q][3]};
    const bf16x8 vf1 = {wl[q + 1][0], wl[q + 1][1], wl[q + 1][2], wl[q + 1][3], wh[q + 1][0], wh[q + 1][1], wh[q + 1][2], wh[q + 1][3]};
    const bf16x8 pf = __builtin_bit_cast(bf16x8, pw[ks]);
    o0 = __builtin_amdgcn_mfma_f32_32x32x16_bf16(vf0, pf, o0, 0, 0, 0);
    o1 = __builtin_amdgcn_mfma_f32_32x32x16_bf16(vf1, pf, o1, 0, 0, 0);
  }
}
__device__ __forceinline__ void attn_qk0(const LAS unsigned char* Kt, const bf16x8 (&qf)[6], f32x16& p0, f32x16& p1, const int r32, const int hi) {
  const LAS unsigned char* Kb = Kt + r32 * AT_KSTR + hi * 16;
  const f32x16 z = {};
#pragma unroll
  for (int d0 = 0; d0 < 6; ++d0) {
    const bf16x8 a0 = *(const LAS bf16x8*)(Kb + d0 * 32), a1 = *(const LAS bf16x8*)(Kb + 32 * AT_KSTR + d0 * 32);
    p0 = __builtin_amdgcn_mfma_f32_32x32x16_bf16(a0, qf[d0], d0 ? p0 : z, 0, 0, 0);
    p1 = __builtin_amdgcn_mfma_f32_32x32x16_bf16(a1, qf[d0], d0 ? p1 : z, 0, 0, 0);
  }
}

template <int MODE>
__device__ __forceinline__ void attn_unit(const Params& p, LAS unsigned char* lds, int b, int h, int qb) {
  int tid_ = threadIdx.x; asm volatile("" : "+v"(tid_));
  const int tid = tid_, lane = tid & 63, r32 = lane & 31, hi = lane >> 5; const int wid = __builtin_amdgcn_readfirstlane(tid >> 6);
  const bf16_t* QB = (const bf16_t*)(p.ws + WS_QB); const bf16_t* KVB = (const bf16_t*)(p.ws + WS_KVB); const bf16_t* PROJ = (const bf16_t*)(p.ws + WS_PROJ);
  bf16_t* Y = (bf16_t*)(p.ws + WS_Y);
  const size_t rowbase = (size_t)b * SEQ; const int q0 = qb * 256;
  bf16x8 qf[6];
  { const bf16_t* qrow = QB + (rowbase + q0 + wid * 32 + r32) * 768 + h * 96 + hi * 8;
#pragma unroll
    for (int d0 = 0; d0 < 6; ++d0) qf[d0] = *(const bf16x8*)(qrow + d0 * 16); }
  f32x16 o0 = {}, o1 = {}; float mrun = 0.f, lrun = 0.f;
  const int NT = 4 * (qb + 1);
  const int id0 = tid, id1 = (tid < 256) ? tid + 512 : tid;
  const int kv0 = id0 / 12, c0 = id0 % 12, kv1 = id1 / 12, c1 = id1 % 12;
  const bf16_t* ks0 = (c0 < 8) ? KVB + (rowbase + kv0) * 1024 + h * 128 + c0 * 8 : PROJ + (rowbase + kv0) * NP + KR_OFF + (c0 - 8) * 8;
  const size_t kstr0 = (c0 < 8) ? (size_t)64 * 1024 : (size_t)64 * NP;
  const bf16_t* ks1 = (c1 < 8) ? KVB + (rowbase + kv1) * 1024 + h * 128 + c1 * 8 : PROJ + (rowbase + kv1) * NP + KR_OFF + (c1 - 8) * 8;
  const size_t kstr1 = (c1 < 8) ? (size_t)64 * 1024 : (size_t)64 * NP;
  const int kd0 = kv0 * AT_KSTR + c0 * 16, kd1 = kv1 * AT_KSTR + c1 * 16;
  const int vkv = tid >> 3, vc = tid & 7;
  const bf16_t* vs = KVB + (rowbase + vkv) * 1024 + h * 128 + 64 + vc * 8;
  const int vd = (vc >> 2) * 4096 + vkv * 64 + (vc & 3) * 16;
  u32x4 kA0 = {}, kA1 = {}, vA = {}, kB0 = {}, kB1 = {}, vB = {};
#define AT_LOADK(K0, K1, u) do { if (MODE == 2) break; const int u_ = (MODE == 1) ? 0 : ((u) < NT ? (u) : NT - 1); K0 = *(const u32x4*)(ks0 + (size_t)u_ * kstr0); K1 = *(const u32x4*)(ks1 + (size_t)u_ * kstr1); } while (0)
#define AT_LOADV(V, u) do { if (MODE == 2) break; const int u_ = (MODE == 1) ? 0 : ((u) < NT ? (u) : NT - 1); V = *(const u32x4*)(vs + (size_t)u_ * 64 * 1024); } while (0)
#define AT_STOREK(K0, K1, buf) do { *(LAS u32x4*)(lds + AT_KOFF + (buf) * AT_KBUF + kd0) = K0; *(LAS u32x4*)(lds + AT_KOFF + (buf) * AT_KBUF + kd1) = K1; } while (0)
#define AT_STOREV(V, buf) do { *(LAS u32x4*)(lds + AT_VOFF + (buf) * AT_VBUF + vd) = V; } while (0)
  AT_LOADK(kA0, kA1, 0); AT_LOADV(vA, 0); AT_LOADK(kB0, kB1, 1);
  AT_STOREK(kA0, kA1, 0); AT_STOREV(vA, 0); AT_STOREK(kB0, kB1, 1);
  AT_LOADK(kA0, kA1, 2); AT_LOADV(vB, 1); AT_LOADK(kB0, kB1, 3); AT_LOADV(vA, 2);
  LBAR();
  const int qabs = q0 + wid * 32 + r32;
  const int voffl = ((lane >> 4) & 1) * 32 + (lane & 3) * 8 + (4 * hi + ((lane & 15) >> 2)) * 64;
  const int wlast = q0 + wid * 32 + 31;
  f32x16 pa0, pa1, pb0, pb1;
  if (wid >= 4) __builtin_amdgcn_s_setprio(1);
  attn_qk0(lds + AT_KOFF, qf, pa0, pa1, r32, hi);
  LBAR();
#pragma unroll 1
  for (int t = 0; t < NT; t += 2) {
    if (MODE != 3 && t * 64 <= wlast) {
      attn_step<true>(lds + AT_KOFF + AT_KBUF, lds + AT_VOFF, qf, pa0, pa1, pb0, pb1, o0, o1, mrun, lrun, t == 0, t >= NT - 4, t * 64, qabs, r32, hi, voffl);
    }
    AT_STOREK(kA0, kA1, 0); AT_STOREV(vB, 1);
    AT_LOADK(kA0, kA1, t + 4); AT_LOADV(vB, t + 3);
    LBAR();
    if (MODE != 3 && (t + 1) * 64 <= wlast) {
      attn_step<true>(lds + AT_KOFF, lds + AT_VOFF + AT_VBUF, qf, pb0, pb1, pa0, pa1, o0, o1, mrun, lrun, false, t + 1 >= NT - 4, (t + 1) * 64, qabs, r32, hi, voffl);
    }
    AT_STOREK(kB0, kB1, 1); AT_STOREV(vA, 0);
    AT_LOADK(kB0, kB1, t + 5); AT_LOADV(vA, t + 4);
    LBAR();
  }
#undef AT_LOADK
#undef AT_LOADV
#undef AT_STOREK
#undef AT_STOREV
  __builtin_amdgcn_s_setprio(0);
  lrun += __shfl_xor(lrun, 32);
  const float inv = __builtin_amdgcn_rcpf(lrun);
  bf16_t* dst = Y + (rowbase + q0 + wid * 32 + r32) * 1024 + 512 + h * 64 + 4 * hi;
#pragma unroll
  for (int g = 0; g < 4; ++g) {
    u32x2 w0, w1; w0.x = pk2(o0[4 * g] * inv, o0[4 * g + 1] * inv); w0.y = pk2(o0[4 * g + 2] * inv, o0[4 * g + 3] * inv);
    w1.x = pk2(o1[4 * g] * inv, o1[4 * g + 1] * inv); w1.y = pk2(o1[4 * g + 2] * inv, o1[4 * g + 3] * inv);
    if (MODE == 0 || w0.x == 0x12345679u) { *(u32x2*)(dst + 8 * g) = w0; *(u32x2*)(dst + 32 + 8 * g) = w1; }
  }
}

template <int MODE>
__device__ __forceinline__ void attn_phase(const Params& p, LAS unsigned char* lds, int G, int vb) {
  if (G == 256) {
    const int bh = vb >> 2, s = vb & 3;
#pragma unroll 1
    for (int i = 0; i < 4; ++i) { const int qb = (i == 0) ? 15 - s : (i == 1) ? 8 + s : (i == 2) ? 7 - s : s; attn_unit<MODE>(p, lds, bh >> 3, bh & 7, qb); }
  } else {
#pragma unroll 1
    for (int u = vb; u < 1024; u += G) { const int qb = 15 - (u >> 6), bh = u & 63; attn_unit<MODE>(p, lds, bh >> 3, bh & 7, qb); }
  }
}

constexpr int GL_BC = 0;
constexpr int GL_QE = 17408;
constexpr int GL_KE = 26624;
constexpr int GL_KD = 35840;
constexpr int GL_V = 44032;
constexpr int GL_ST = 60416;
constexpr int GL_RED = 78848;
constexpr int GL_TOT = 80896;
__device__ __forceinline__ int crow(int r, int hi) { return (r & 3) + 8 * (r >> 2) + 4 * hi; }

__device__ __forceinline__ void gla_gates_mfma(const bf16x8 lrA, const bf16x8 guB, const float bias_d, LAS float* bc, LAS float* tot0, int dt, int jt, int r32, int hi) {
  const f32x16 zero = {};
  const f32x16 z = __builtin_amdgcn_mfma_f32_32x32x16_bf16(lrA, guB, zero, 0, 0, 0);
  float la[16];
#pragma unroll
  for (int r = 0; r < 16; ++r) { const float zz = z[r] + bias_d; la[r] = (fminf(zz, 0.f) - __logf(1.f + __expf(-fabsf(zz)))) * (1.f / 16.f); }
  float s[4], o[4];
#pragma unroll
  for (int g = 0; g < 4; ++g) { la[4 * g + 1] += la[4 * g]; la[4 * g + 2] += la[4 * g + 1]; la[4 * g + 3] += la[4 * g + 2]; s[g] = la[4 * g + 3]; }
#pragma unroll
  for (int g = 0; g < 4; ++g) { auto rr = __builtin_amdgcn_permlane32_swap(__float_as_uint(s[g]), __float_as_uint(s[g]), false, false); o[g] = __uint_as_float(hi ? rr[0] : rr[1]); }
  float off = 0.f;
#pragma unroll
  for (int g = 0; g < 4; ++g) { const float add = off + (hi ? o[g] : 0.f);
#pragma unroll
    for (int q = 0; q < 4; ++q) la[4 * g + q] += add;
    off += s[g] + o[g]; }
#pragma unroll
  for (int r = 0; r < 16; ++r) bc[(32 * jt + crow(r, hi)) * 68 + 32 * dt + r32] = la[r];
  if (jt == 0 && hi == 0) tot0[32 * dt + r32] = off;
}

__device__ __forceinline__ bf16x8 trfrag(const LAS unsigned char* p, int off_lo, int off_hi) {
  const s16x4 l = vtr(p + off_lo), h = vtr(p + off_hi);
  return (bf16x8){l[0], l[1], l[2], l[3], h[0], h[1], h[2], h[3]};
}

__device__ __forceinline__ void gla_a_phase(const Params& p, LAS unsigned char* lds, int G, int vb) {
  const int tid = threadIdx.x, lane = tid & 63, r32 = lane & 31, hi = lane >> 5; const int wid = __builtin_amdgcn_readfirstlane(tid >> 6);
  const bf16_t* PROJ = (const bf16_t*)(p.ws + WS_PROJ); const bf16_t* GUT = (const bf16_t*)(p.ws + WS_GUT);
  bf16_t* UPD = (bf16_t*)(p.ws + WS_Y); float* DEC = (float*)(p.ws + WS_DEC); const float* gbias = p.in[5];
  LAS float* bc = (LAS float*)(lds + GL_BC);
  const int j = tid >> 3, c = tid & 7;
  u32x4 kq, v0, v1, lr0 = {}, gub = {}; float gbs = 0.f;
  LAS float* tot0 = (LAS float*)(lds + GL_TOT);
#define GLA_A_LOAD(item_) do { const int n_ = (item_) & 63, bh_ = (item_) >> 6, h_ = bh_ & 3, b_ = bh_ >> 2; const size_t r0_ = (size_t)b_ * SEQ + n_ * 64; \
    if (wid < 4) { lr0 = *(const u32x4*)(PROJ + (r0_ + 32 * (wid >> 1) + r32) * NP + LR_OFF + 8 * hi); \
      gub = *(const u32x4*)(GUT + (h_ * 64 + 32 * (wid & 1) + r32) * 16 + 8 * hi); gbs = gbias[h_ * 64 + 32 * (wid & 1) + r32]; } \
    kq = *(const u32x4*)(PROJ + (r0_ + j) * NP + K_OFF + h_ * 64 + c * 8); \
    v0 = *(const u32x4*)(PROJ + (r0_ + (tid >> 4)) * NP + V_OFF + h_ * 128 + (tid & 15) * 8); \
    v1 = *(const u32x4*)(PROJ + (r0_ + 32 + (tid >> 4)) * NP + V_OFF + h_ * 128 + (tid & 15) * 8); } while (0)
  int item = vb;
  if (item < 2048) GLA_A_LOAD(item);
#pragma unroll 1
  for (; item < 2048; item += G) {
    if (wid < 4) gla_gates_mfma(__builtin_bit_cast(bf16x8, lr0), __builtin_bit_cast(bf16x8, gub), gbs, bc, tot0, wid & 1, wid >> 1, r32, hi);
    LBAR();
    {
      const unsigned kk[4] = {kq.x, kq.y, kq.z, kq.w}; float kd[8];
#pragma unroll
      for (int i = 0; i < 8; ++i) { const int d = c * 8 + i; const float kv = (i & 1) ? bfhi(kk[i >> 1]) : bflo(kk[i >> 1]); const float t0 = tot0[d];
        kd[i] = kv * __expf((bc[63 * 68 + d] + t0) - (bc[j * 68 + d] + (j >= 32 ? t0 : 0.f))); }
      *(LAS u32x4*)(lds + GL_KD + (c >> 2) * 4096 + j * 64 + (c & 3) * 16) = (u32x4){pk2(kd[0], kd[1]), pk2(kd[2], kd[3]), pk2(kd[4], kd[5]), pk2(kd[6], kd[7])};
      const int jj = tid >> 4, cc = tid & 15;
      *(LAS u32x4*)(lds + GL_V + (cc >> 2) * 4096 + jj * 64 + (cc & 3) * 16) = v0;
      *(LAS u32x4*)(lds + GL_V + (cc >> 2) * 4096 + (32 + jj) * 64 + (cc & 3) * 16) = v1;
      if (tid < 64) DEC[(size_t)item * 64 + tid] = __expf(bc[63 * 68 + tid] + tot0[tid]);
    }
    if (item + G < 2048) GLA_A_LOAD(item + G);
    LBAR();
    { const int vt = wid >> 1, dt = wid & 1; f32x16 acc = {};
      const int lo = ((lane >> 4) & 1) * 32 + (lane & 3) * 8 + (8 * hi + ((lane & 15) >> 2)) * 64;
#pragma unroll
      for (int ks = 0; ks < 4; ++ks) {
        const bf16x8 a = trfrag(lds + GL_V + vt * 4096, lo + ks * 1024, lo + ks * 1024 + 256);
        const bf16x8 bb = trfrag(lds + GL_KD + dt * 4096, lo + ks * 1024, lo + ks * 1024 + 256);
        acc = __builtin_amdgcn_mfma_f32_32x32x16_bf16(a, bb, acc, 0, 0, 0);
      }
      bf16_t* dst = UPD + (size_t)item * 8192 + 32 * dt + r32;
#pragma unroll
      for (int r = 0; r < 16; ++r) dst[(size_t)(32 * vt + crow(r, hi)) * 64] = (bf16_t)(pk2(acc[r], 0.f) & 0xffffu);
    }
  }
  LBAR();
#undef GLA_A_LOAD
}

__device__ __forceinline__ void gla_scan(const Params& p, int G, int vb) {
  const bf16_t* UPD = (const bf16_t*)(p.ws + WS_Y); const float* DEC = (const float*)(p.ws + WS_DEC); bf16_t* SPT = (bf16_t*)(p.ws + WS_SPT);
  for (int idx = vb * 512 + threadIdx.x; idx < 32 * 4096; idx += G * 512) {
    const int bh = idx >> 12, vd = (idx & 4095) * 2, d = vd & 63;
    float S0 = 0.f, S1 = 0.f;
#pragma unroll 16
    for (int n = 0; n < 64; ++n) { const size_t item = (size_t)bh * 64 + n;
      const unsigned uw = *(const unsigned*)(UPD + item * 8192 + vd); const f32x2 dc = *(const f32x2*)(DEC + item * 64 + d);
      *(unsigned*)(SPT + item * 8192 + vd) = pk2(S0, S1); S0 = dc.x * S0 + bflo(uw); S1 = dc.y * S1 + bfhi(uw); }
  }
}

__device__ __forceinline__ void gla_scan_block(const Params& p, LAS unsigned char* lds, int bh) {
  const bf16_t* UPD = (const bf16_t*)(p.ws + WS_Y); const float* DEC = (const float*)(p.ws + WS_DEC); bf16_t* SPT = (bf16_t*)(p.ws + WS_SPT);
  const int tid = threadIdx.x, d8 = tid & 7;
  LAS float* dl = (LAS float*)lds;
  for (int i = tid; i < 1024; i += 512) *(LAS f32x4*)(dl + 4 * i) = *(const f32x4*)(DEC + (size_t)bh * 4096 + 4 * i);
  __syncthreads();
  const size_t base = (size_t)bh * 64 * 8192 + (size_t)tid * 8;
  f32x4 S[4] = {};
#pragma unroll 1
  for (int n0 = 0; n0 < 64; n0 += 8) {
    u32x4 u[8][2];
#pragma unroll
    for (int k = 0; k < 8; ++k) { u[k][0] = *(const u32x4*)(UPD + base + (size_t)(n0 + k) * 8192); u[k][1] = *(const u32x4*)(UPD + base + (size_t)(n0 + k) * 8192 + 4096); }
#pragma unroll
    for (int k = 0; k < 8; ++k) {
      const f32x4 da = *(LAS f32x4*)(dl + (n0 + k) * 64 + d8 * 8), db = *(LAS f32x4*)(dl + (n0 + k) * 64 + d8 * 8 + 4);
      *(u32x4*)(SPT + base + (size_t)(n0 + k) * 8192) = pack8(S[0], S[1]);
      *(u32x4*)(SPT + base + (size_t)(n0 + k) * 8192 + 4096) = pack8(S[2], S[3]);
#pragma unroll
      for (int r = 0; r < 2; ++r) { const u32x4 w = u[k][r];
        S[2 * r][0] = da[0] * S[2 * r][0] + bflo(w.x); S[2 * r][1] = da[1] * S[2 * r][1] + bfhi(w.x);
        S[2 * r][2] = da[2] * S[2 * r][2] + bflo(w.y); S[2 * r][3] = da[3] * S[2 * r][3] + bfhi(w.y);
        S[2 * r + 1][0] = db[0] * S[2 * r + 1][0] + bflo(w.z); S[2 * r + 1][1] = db[1] * S[2 * r + 1][1] + bfhi(w.z);
        S[2 * r + 1][2] = db[2] * S[2 * r + 1][2] + bflo(w.w); S[2 * r + 1][3] = db[3] * S[2 * r + 1][3] + bfhi(w.w); }
    }
  }
  __syncthreads();
}

template <int MODE>
__device__ __forceinline__ void gla_c_phase(const Params& p, LAS unsigned char* lds, int G, int vb, int k0, int k1) {
  int tid_ = threadIdx.x; asm volatile("" : "+v"(tid_));
  const int tid = tid_, lane = tid & 63, r32 = lane & 31, hi = lane >> 5; const int wid = __builtin_amdgcn_readfirstlane(tid >> 6);
  const bf16_t* PROJ = (const bf16_t*)(p.ws + WS_PROJ); const bf16_t* GUT = (const bf16_t*)(p.ws + WS_GUT); const bf16_t* SPT = (const bf16_t*)(p.ws + WS_SPT);
  bf16_t* Y = (bf16_t*)(p.ws + WS_Y); const float* gbias = p.in[5]; const float* gnw = p.in[6];
  LAS float* bc = (LAS float*)(lds + GL_BC); LAS bf16_t* QE = (LAS bf16_t*)(lds + GL_QE); LAS bf16_t* KE = (LAS bf16_t*)(lds + GL_KE); LAS bf16_t* ST = (LAS bf16_t*)(lds + GL_ST);
  LAS float* red = (LAS float*)(lds + GL_RED);
  const int j = tid >> 3, c = tid & 7;
  const int it = wid & 1, vt = wid >> 1;
  u32x4 qq, kq, v0, v1, s0, s1, lr0 = {}, gub = {}; float gbs = 0.f; u32x2 og[4];
  LAS float* tot0 = (LAS float*)(lds + GL_TOT);
#define GLA_C_LOAD(item_) do { const int n_ = (item_) & 63, bh_ = (item_) >> 6, h_ = bh_ & 3, b_ = bh_ >> 2; const size_t r0_ = (size_t)b_ * SEQ + n_ * 64; \
    if (wid < 4) { lr0 = *(const u32x4*)(PROJ + (r0_ + 32 * (wid >> 1) + r32) * NP + LR_OFF + 8 * hi); \
      gub = *(const u32x4*)(GUT + (h_ * 64 + 32 * (wid & 1) + r32) * 16 + 8 * hi); gbs = gbias[h_ * 64 + 32 * (wid & 1) + r32]; } \
    qq = *(const u32x4*)(PROJ + (r0_ + j) * NP + Q_OFF + h_ * 64 + c * 8); \
    kq = *(const u32x4*)(PROJ + (r0_ + j) * NP + K_OFF + h_ * 64 + c * 8); \
    v0 = *(const u32x4*)(PROJ + (r0_ + (tid >> 4)) * NP + V_OFF + h_ * 128 + (tid & 15) * 8); \
    v1 = *(const u32x4*)(PROJ + (r0_ + 32 + (tid >> 4)) * NP + V_OFF + h_ * 128 + (tid & 15) * 8); \
    s0 = *(const u32x4*)(SPT + (size_t)(item_) * 8192 + (size_t)tid * 8); s1 = *(const u32x4*)(SPT + (size_t)(item_) * 8192 + 4096 + (size_t)tid * 8); \
    _Pragma("unroll") for (int g_ = 0; g_ < 4; ++g_) og[g_] = *(const u32x2*)(PROJ + (r0_ + 32 * it + r32) * NP + OG_OFF + h_ * 128 + 32 * vt + 8 * g_ + 4 * hi); } while (0)
  f32x4 nwr[4];
  { const float* gnw_l = gnw; asm volatile("" : "+v"(gnw_l));
#pragma unroll
  for (int g = 0; g < 4; ++g) nwr[g] = *(const f32x4*)(gnw_l + 32 * vt + 8 * g + 4 * hi); }
  int item = vb + k0 * G; const int iend = vb + (k1 < 64 ? k1 : 64) * G;
  if (item < iend && item < 2048) GLA_C_LOAD(item);
#define GLA_C_LOAD_NEXT(it_) do { if (MODE != 2) GLA_C_LOAD(it_); } while (0)
#pragma unroll 1
  for (; item < iend && item < 2048; item += G) {
    const int n = item & 63, bh = item >> 6, h = bh & 3, b = bh >> 2; const size_t r0 = (size_t)b * SEQ + n * 64;
    if (wid < 4) gla_gates_mfma(__builtin_bit_cast(bf16x8, lr0), __builtin_bit_cast(bf16x8, gub), gbs, bc, tot0, wid & 1, wid >> 1, r32, hi);
    LBAR();
    {
      const unsigned q4[4] = {qq.x, qq.y, qq.z, qq.w}, k4[4] = {kq.x, kq.y, kq.z, kq.w}; float qv[8], kv[8];
#pragma unroll
      for (int i = 0; i < 8; ++i) { const float bb = bc[j * 68 + c * 8 + i] + (j >= 32 ? tot0[c * 8 + i] : 0.f);
        qv[i] = ((i & 1) ? bfhi(q4[i >> 1]) : bflo(q4[i >> 1])) * 0.125f * __expf(bb);
        kv[i] = ((i & 1) ? bfhi(k4[i >> 1]) : bflo(k4[i >> 1])) * __expf(-bb); }
      *(LAS u32x4*)(QE + j * 72 + c * 8) = (u32x4){pk2(qv[0], qv[1]), pk2(qv[2], qv[3]), pk2(qv[4], qv[5]), pk2(qv[6], qv[7])};
      *(LAS u32x4*)(KE + j * 72 + c * 8) = (u32x4){pk2(kv[0], kv[1]), pk2(kv[2], kv[3]), pk2(kv[4], kv[5]), pk2(kv[6], kv[7])};
      const int jj = tid >> 4, cc = tid & 15;
      *(LAS u32x4*)(lds + GL_V + (cc >> 2) * 4096 + jj * 64 + (cc & 3) * 16) = v0;
      *(LAS u32x4*)(lds + GL_V + (cc >> 2) * 4096 + (32 + jj) * 64 + (cc & 3) * 16) = v1;
      *(LAS u32x4*)(ST + (tid >> 3) * 72 + (tid & 7) * 8) = s0;
      *(LAS u32x4*)(ST + (64 + (tid >> 3)) * 72 + (tid & 7) * 8) = s1;
    }
    u32x2 ogc[4];
#pragma unroll
    for (int g = 0; g < 4; ++g) ogc[g] = og[g];
    if (item + G < iend && item + G < 2048) GLA_C_LOAD_NEXT(item + G);
    LBAR();
    f32x16 acc = {};
    {
      bf16x8 qf[4];
#pragma unroll
      for (int ks = 0; ks < 4; ++ks) qf[ks] = *(const LAS bf16x8*)(QE + (32 * it + r32) * 72 + 16 * ks + 8 * hi);
      const int i_abs = 32 * it + r32;
      const int lo = ((lane >> 4) & 1) * 32 + (lane & 3) * 8 + (4 * hi + ((lane & 15) >> 2)) * 64;
#pragma unroll
      for (int jt = 0; jt < 2; ++jt) {
        if (jt <= it) {
          f32x16 at = {};
#pragma unroll
          for (int ks = 0; ks < 4; ++ks) {
            const bf16x8 a = *(const LAS bf16x8*)(KE + (32 * jt + r32) * 72 + 16 * ks + 8 * hi);
            at = __builtin_amdgcn_mfma_f32_32x32x16_bf16(a, qf[ks], at, 0, 0, 0);
          }
#pragma unroll
          for (int r = 0; r < 16; ++r) if (32 * jt + crow(r, hi) > i_abs) at[r] = 0.f;
#pragma unroll
          for (int s = 0; s < 2; ++s) {
            const u32x4 pw = (u32x4){pk2(at[8 * s + 0], at[8 * s + 1]), pk2(at[8 * s + 2], at[8 * s + 3]), pk2(at[8 * s + 4], at[8 * s + 5]), pk2(at[8 * s + 6], at[8 * s + 7])};
            const int ks = 2 * jt + s;
            const bf16x8 vf = trfrag(lds + GL_V + vt * 4096, lo + ks * 1024, lo + ks * 1024 + 512);
            acc = __builtin_amdgcn_mfma_f32_32x32x16_bf16(vf, __builtin_bit_cast(bf16x8, pw), acc, 0, 0, 0);
          }
        }
      }
#pragma unroll
      for (int ks = 0; ks < 4; ++ks) {
        const bf16x8 a = *(const LAS bf16x8*)(ST + (32 * vt + r32) * 72 + 16 * ks + 8 * hi);
        acc = __builtin_amdgcn_mfma_f32_32x32x16_bf16(a, qf[ks], acc, 0, 0, 0);
      }
    }
    float sq = 0.f;
#pragma unroll
    for (int r = 0; r < 16; ++r) sq += acc[r] * acc[r];
    red[(32 * it + r32) * 8 + vt * 2 + hi] = sq;
    LBAR();
    {
      const LAS f32x4* rr = (const LAS f32x4*)(red + (32 * it + r32) * 8);
      const f32x4 ra = rr[0], rb = rr[1];
      const float tot = ((ra[0] + ra[1]) + (ra[2] + ra[3])) + ((rb[0] + rb[1]) + (rb[2] + rb[3]));
      const float rinv = rsqrtf(tot * (1.f / 128.f) + EPS);
      bf16_t* dst = Y + (r0 + 32 * it + r32) * 1024 + h * 128 + 32 * vt + 4 * hi;
#pragma unroll
      for (int g = 0; g < 4; ++g) {
        const f32x4 nw = nwr[g];
        const float o0 = bflo(ogc[g].x), o1 = bfhi(ogc[g].x), o2 = bflo(ogc[g].y), o3 = bfhi(ogc[g].y);
        const float y0 = acc[4 * g + 0] * rinv * nw[0] * (o0 * __builtin_amdgcn_rcpf(1.f + __expf(-o0)));
        const float y1 = acc[4 * g + 1] * rinv * nw[1] * (o1 * __builtin_amdgcn_rcpf(1.f + __expf(-o1)));
        const float y2 = acc[4 * g + 2] * rinv * nw[2] * (o2 * __builtin_amdgcn_rcpf(1.f + __expf(-o2)));
        const float y3 = acc[4 * g + 3] * rinv * nw[3] * (o3 * __builtin_amdgcn_rcpf(1.f + __expf(-o3)));
        u32x2 w; w.x = pk2(y0, y1); w.y = pk2(y2, y3);
        if (MODE == 0 || w.x == 0x12345679u) *(u32x2*)(dst + 8 * g) = w;
      }
    }
  }
  LBAR();
#undef GLA_C_LOAD
}

constexpr int RT_LG = 0;
constexpr int RT_HIST = 8 * 16 * 49 * 4;
constexpr int RT_BASE = RT_HIST + 128;
__device__ __forceinline__ void router_phase(const Params& p, LAS unsigned char* lds, int G, int vb) {
  const int tid = threadIdx.x, lane = tid & 63, wave = tid >> 6;
  const bf16_t* HB = (const bf16_t*)(p.ws + WS_XB); const bf16_t* WrT = (const bf16_t*)(p.ws + WS_WR);
  float* RS2 = (float*)(p.ws + WS_RS2); int* cnt = (int*)(p.ws + WS_CNT); int* LTOK = (int*)(p.ws + WS_LTOK); float* LGATE = (float*)(p.ws + WS_LGATE);
  const float* gbias = p.in[14]; const float* ebias = p.in[16];
  LAS float* lg = (LAS float*)(lds + RT_LG) + wave * 16 * 49; LAS int* hist = (LAS int*)(lds + RT_HIST); LAS int* basee = (LAS int*)(lds + RT_BASE);
  for (int base = vb * 8; base < NTOK / 16; base += G * 8) {
    if (tid < 32) hist[tid] = 0;
    const int r0 = (base + wave) * 16;
    f32x4 acc[3] = {{0.f, 0.f, 0.f, 0.f}, {0.f, 0.f, 0.f, 0.f}, {0.f, 0.f, 0.f, 0.f}};
    const bf16_t* arow = HB + (size_t)(r0 + (lane & 15)) * 1024 + (lane >> 4) * 8;
    const bf16_t* brow = WrT + (size_t)(lane & 15) * 1024 + (lane >> 4) * 8;
    float hsq = 0.f;
#pragma unroll 4
    for (int kk = 0; kk < 32; ++kk) {
      const bf16x8 a = *(const bf16x8*)(arow + kk * 32);
      { const u32x4 aw = __builtin_bit_cast(u32x4, a); const float e0 = bflo(aw.x), e1 = bfhi(aw.x), e2 = bflo(aw.y), e3 = bfhi(aw.y), e4 = bflo(aw.z), e5 = bfhi(aw.z), e6 = bflo(aw.w), e7 = bfhi(aw.w);
        hsq += ((e0 * e0 + e1 * e1) + (e2 * e2 + e3 * e3)) + ((e4 * e4 + e5 * e5) + (e6 * e6 + e7 * e7)); }
#pragma unroll
      for (int n = 0; n < 3; ++n) { const bf16x8 bb = *(const bf16x8*)(brow + (size_t)n * 16 * 1024 + kk * 32); acc[n] = __builtin_amdgcn_mfma_f32_16x16x32_bf16(a, bb, acc[n], 0, 0, 0); }
    }
    hsq += __shfl_xor(hsq, 16); hsq += __shfl_xor(hsq, 32);
#pragma unroll
    for (int n = 0; n < 3; ++n)
#pragma unroll
      for (int r = 0; r < 4; ++r) lg[((lane >> 4) * 4 + r) * 49 + 16 * n + (lane & 15)] = acc[n][r];
    __syncthreads();
    int e1 = 0, e2 = 0, lp1 = 0, lp2 = 0; float g1 = 0.f, g2 = 0.f, rsk = 0.f; const int tok = r0 + lane;
    if (lane < 16) {
      const float rs = rsqrtf(hsq * (1.f / 1024.f) + EPS);
      RS2[tok] = rs; rsk = rs;
      float gl[4]; int gs = 0;
#pragma unroll
      for (int i = 0; i < 4; ++i) gl[i] = lg[lane * 49 + i] * rs + gbias[i];
#pragma unroll
      for (int i = 1; i < 4; ++i) if (gl[i] > gl[gs]) gs = i;
      float den = 0.f;
#pragma unroll
      for (int i = 0; i < 4; ++i) den += __expf(gl[i] - gl[gs]);
      const float pg = 1.f / den;
      float el[8];
#pragma unroll
      for (int i = 0; i < 8; ++i) el[i] = lg[lane * 49 + 4 + gs * 8 + i] * rs + ebias[gs * 8 + i];
      int i1 = 0;
#pragma unroll
      for (int i = 1; i < 8; ++i) if (el[i] > el[i1]) i1 = i;
      int i2 = (i1 == 0) ? 1 : 0;
#pragma unroll
      for (int i = 0; i < 8; ++i) if (i != i1 && el[i] > el[i2]) i2 = i;
      const float t = __expf(el[i2] - el[i1]);
      g1 = pg / (1.f + t); g2 = pg * t / (1.f + t);
      e1 = gs * 8 + i1; e2 = gs * 8 + i2;
      lp1 = atomicAdd((int*)(hist + e1), 1); lp2 = atomicAdd((int*)(hist + e2), 1);
    }
    __syncthreads();
    if (tid < 32) { const int hc = hist[tid]; basee[tid] = hc ? atomicAdd(cnt + tid, hc) : 0; }
    __syncthreads();
    if (lane < 16) {
      const int p1 = e1 * ECAP + basee[e1] + lp1, p2 = e2 * ECAP + basee[e2] + lp2;
      LTOK[p1] = tok * 2; LGATE[p1] = g1; LTOK[p2] = tok * 2 + 1; LGATE[p2] = g2;
      float* LRS2 = (float*)(p.ws + WS_LRS2); LRS2[p1] = rsk; LRS2[p2] = rsk;
    }
    __syncthreads();
  }
}

__device__ __forceinline__ void final_phase(const Params& p, int G, int vb, float pc1, float pc2) {
  const int lane = threadIdx.x & 63, wave = threadIdx.x >> 6;
  const float* fw = p.in[20]; const bf16_t* Y2 = (const bf16_t*)(p.ws + WS_PROJ); const bf16_t* HB = (const bf16_t*)(p.ws + WS_XB);
  for (int m = vb * 8 + wave; m < NTOK; m += G * 8) {
    f32x4* orow = (f32x4*)(p.out + (size_t)m * DM) + lane;
    f32x4 v[4]; float s = 0.f;
#pragma unroll
    for (int j = 0; j < 4; ++j) {
      const u32x2 hh = *((const u32x2*)(HB + (size_t)m * 1024) + lane + 64 * j);
      v[j] = (f32x4){bflo(hh.x), bfhi(hh.x), bflo(hh.y), bfhi(hh.y)};
#if ENABLE_MOE
      const u32x2 a = *((const u32x2*)(Y2 + (size_t)(2 * m) * 1024) + lane + 64 * j), b = *((const u32x2*)(Y2 + (size_t)(2 * m + 1) * 1024) + lane + 64 * j);
      v[j].x += bflo(a.x) + bflo(b.x); v[j].y += bfhi(a.x) + bfhi(b.x); v[j].z += bflo(a.y) + bflo(b.y); v[j].w += bfhi(a.y) + bfhi(b.y);
#endif
      s += (v[j].x * v[j].x + v[j].y * v[j].y) + (v[j].z * v[j].z + v[j].w * v[j].w);
    }
    s = wave_sum(s);
    const float rs = rsqrtf(s * (1.f / DM) + EPS);
#pragma unroll
    for (int j = 0; j < 4; ++j) { const f32x4 w = *((const f32x4*)fw + lane + 64 * j); f32x4 o = v[j] * rs * w;
#ifdef PROBE_T1
      o = o + pc1;
#endif
      orow[64 * j] = o; }
  }
}


#define XB_TMO      128
#define XB_XCNT(j)  (256  + 64 * (j))
#define XB_XSUB(j)  (1280 + 64 * (j))
#define XB_XGEN(j)  (2304 + 64 * (j))
#define XB_TOP      3328
#define XB_TOPGEN   3392
#define XB_SPIN_CAP (1u << 22)
__device__ __forceinline__ unsigned xb_ld(unsigned* p)              { return __hip_atomic_load(p, __ATOMIC_RELAXED, __HIP_MEMORY_SCOPE_AGENT); }
__device__ __forceinline__ unsigned xb_add(unsigned* p, unsigned v) { return __hip_atomic_fetch_add(p, v, __ATOMIC_RELAXED, __HIP_MEMORY_SCOPE_AGENT); }
__device__ __forceinline__ unsigned xb_xcc_id() { return (unsigned)__builtin_amdgcn_s_getreg((3 << 11) | 20) & 0xFu; }
#define XB_SPIN(cond, bar) do { unsigned _sp = 0; while (cond) { __builtin_amdgcn_s_sleep(1); \
    if ((++_sp & 255u) == 0u) { if (xb_ld(&(bar)[XB_TMO])) break; if (_sp > XB_SPIN_CAP) { atomicAdd(&(bar)[XB_TMO], 1u); break; } } } } while (0)
struct XcdBarrier { unsigned* bar; unsigned x; volatile LAS unsigned* st; };
__device__ __forceinline__ XcdBarrier xcd_barrier_post(unsigned* bar, volatile LAS unsigned* st) {
  XcdBarrier b; b.bar = bar; b.x = xb_xcc_id(); b.st = st;
  if (threadIdx.x == 0) st[2] = xb_add(&bar[XB_XCNT(b.x)], 1u);
  return b;
}
__device__ __forceinline__ void xcd_barrier_complete(unsigned* bar, unsigned x, unsigned& nloc, unsigned& nx) {
  const unsigned G = gridDim.x * gridDim.y * gridDim.z;
  unsigned sum, cnt, mine, sp = 0u;
  for (;;) {
    sum = 0u; cnt = 0u; mine = 0u;
#pragma unroll
    for (unsigned j = 0; j < 16; ++j) { const unsigned c = xb_ld(&bar[XB_XCNT(j)]); sum += c; cnt += (c > 0u) ? 1u : 0u; mine = (j == x) ? c : mine; }
    if (sum == G) break;
    __builtin_amdgcn_s_sleep(1);
    if ((++sp & 255u) == 0u) { if (xb_ld(&bar[XB_TMO])) break; if (sp > XB_SPIN_CAP) { atomicAdd(&bar[XB_TMO], 1u); break; } }
  }
  nloc = mine > 0u ? mine : 1u; nx = cnt > 0u ? cnt : 1u;
}
__device__ __forceinline__ void xcd_barrier(const XcdBarrier& b) {
  asm volatile("s_waitcnt vmcnt(0)" ::: "memory");
  __syncthreads();
  if (threadIdx.x == 0) {
    unsigned* bar = b.bar;
    __builtin_amdgcn_s_waitcnt(0);
    unsigned nloc = b.st[0], nx = b.st[1];
    if (nloc == 0u) { xcd_barrier_complete(bar, b.x, nloc, nx); b.st[0] = nloc; b.st[1] = nx; }
    const unsigned old = xb_add(&bar[XB_XSUB(b.x)], 1u);
    const unsigned gen = b.st[4]; b.st[4] = gen + 1u;
    if (old + 1u == (gen + 1u) * nloc) {
      __builtin_amdgcn_fence(__ATOMIC_RELEASE, "agent");
      asm volatile("s_waitcnt vmcnt(0)" ::: "memory");
      const unsigned og = xb_add(&bar[XB_TOP], 1u);
      const unsigned tg = gen;
      if (og + 1u == (tg + 1u) * nx) xb_add(&bar[XB_TOPGEN], 1u);
      else XB_SPIN(xb_ld(&bar[XB_TOPGEN]) == tg, bar);
      xb_add(&bar[XB_XGEN(b.x)], 1u);
      __builtin_amdgcn_fence(__ATOMIC_ACQUIRE, "agent");
      asm volatile("s_waitcnt vmcnt(0)" ::: "memory");
    } else {
      XB_SPIN(xb_ld(&bar[XB_XGEN(b.x)]) == gen, bar);
      __builtin_amdgcn_fence(__ATOMIC_ACQUIRE, "agent");
      asm volatile("s_waitcnt vmcnt(0)" ::: "memory");
    }
  }
  __syncthreads();
}

constexpr int LDS_CTL = 131072;
constexpr int LDS_BYTES = 131072 + 1024 + 8192;

__global__ void __launch_bounds__(512) fwd(Params p, int ph_lo, int ph_hi) {
  extern __shared__ __attribute__((aligned(16))) unsigned char lds_raw[];
  LAS unsigned char* lds = (LAS unsigned char*)lds_raw;
  cg::grid_group grid = cg::this_grid();
  const int G = gridDim.x, bx = blockIdx.x;
  int vb = bx;
  int crr = bx;
  unsigned char* ws = p.ws;
#ifndef PHMASK
#define PHMASK 0x3ff
#endif
#define PH(k) (((PHMASK >> (k)) & 1) && ph_lo <= (k) && (k) < ph_hi)
#ifdef PROBE_T1
  LAS unsigned long long* tsx = (LAS unsigned long long*)(lds + LDS_CTL + 512);
  if (threadIdx.x == 0) tsx[0] = __builtin_amdgcn_s_memrealtime();
#define SEAM(k) do { if (PH(k) && PH((k) + 1)) grid.sync(); if (threadIdx.x == 0) tsx[(k) + 1] = __builtin_amdgcn_s_memrealtime(); } while (0)
#else
#define SEAM(k) do { if (PH(k) && PH((k) + 1)) xcd_barrier(xbar); } while (0)
#endif
  volatile LAS unsigned* xst = (volatile LAS unsigned*)(lds + LDS_CTL + 768);
  if (threadIdx.x == 0) { xst[0] = 0u; xst[1] = 0u; xst[4] = 0u; }
  if (blockIdx.x == 0) for (int i = threadIdx.x; i < XCD_BAR_WORDS; i += 512) ((unsigned*)(ws + WS_BAR))[i] = 0u;
  grid.sync();
  XcdBarrier xbar = xcd_barrier_post((unsigned*)(ws + WS_BAR), xst);
  if (PH(0)) for (int rep = 0; rep < ((REPEAT_PHASE == 0) ? 2 : 1); ++rep) { if (rep) grid.sync(); p0_prologue(p, lds, G, vb); }
  SEAM(0);
  {
    volatile LAS unsigned* xs = xst;
    if (threadIdx.x == 0) { unsigned pre = 0u; for (unsigned j = 0; j < xbar.x; ++j) pre += xb_ld(&xbar.bar[XB_XCNT(j)]); xs[3] = pre + xs[2]; }
    __syncthreads();
    if (G % 8 == 0) { vb = (int)xs[3]; if (vb >= G) vb = bx; const int per = G / 8; crr = (vb % per) * 8 + vb / per; }
  }
  if (PH(1)) for (int rep = 0; rep < NREP(1); ++rep) {
    if (rep) grid.sync();
    g8::DenseSched S; S.init(ws + WS_XB, 1024, ws + WS_WIN, 1024, NTOK, NP, G, crr);
    EpiInproj E{(bf16_t*)(ws + WS_PROJ), (const float*)(ws + WS_RS1), (float*)(ws + WS_SSQP), (const f32x2*)(ws + WS_CS)};
    g8::gemm_phase(lds, 1024, S, E);
    if (G == 256 && crr >= 128 && rep == 0) {
      LAS float* scr = (LAS float*)(lds + (threadIdx.x >> 6) * 8704);
      for (int r = (crr - 128) * 8 + (threadIdx.x >> 6); r < CONV_GU_P1; r += 1024) conv_gu_item(p, CONV_GU_P0 + r, scr, threadIdx.x & 63);
      for (int r = (crr - 128) * 8 + (threadIdx.x >> 6); r < CONV_D_P1; r += 1024) conv_d_item(p, r, scr, threadIdx.x & 63);
      __syncthreads();
    }
  }
  SEAM(1);
  const bool split23 = (G == 256);
  const int Gg = split23 ? 224 : G;
#define P2_GEMMS(DRY) do { \
    { g8::DenseSched S; S.init((const bf16_t*)(ws + WS_PROJ) + CQ_OFF, NP, ws + WS_WUQ, 384, NTOK, 768, Gg, crr); \
      EpiUq E{(bf16_t*)(ws + WS_QB), (const float*)(ws + WS_SSQP), (const f32x2*)(ws + WS_CS), DRY}; \
      g8::gemm_phase(lds, 384, S, E); } \
    { g8::DenseSched S; S.init((const bf16_t*)(ws + WS_PROJ) + CKV_OFF, NP, ws + WS_WUKV, 256, NTOK, 1024, Gg, split23 ? (crr + 64) % 224 : crr);     \
      EpiUkv E{(bf16_t*)(ws + WS_KVB), (const float*)(ws + WS_SSQP), DRY}; \
      g8::gemm_phase(lds, 256, S, E); } } while (0)
#define P2_GLA() gla_a_phase(p, lds, G, vb)
#define P4_GLA() gla_c_phase<0>(p, lds, G, vb, 0, 1 << 20)
  if (PH(2)) {
#if ENABLE_GLA
    P2_GLA();
#endif
#if REPEAT_PHASE == 2
    grid.sync();
    P2_GLA();
#endif
  }
  SEAM(2);
  if (PH(3)) {
#if ENABLE_MLA
    if (!split23 || crr < 224) P2_GEMMS(false);
#endif
#if ENABLE_GLA
    if (!split23) gla_scan(p, G, vb);
    else if (crr >= 224) {
      gla_scan_block(p, lds, crr - 224);
      LAS float* scr_ = (LAS float*)(lds + (threadIdx.x >> 6) * 8704);
      for (int r_ = (crr - 224) * 8 + (threadIdx.x >> 6); r_ < CONV_GU_P2; r_ += 256) conv_gu_item(p, CONV_GU_P0 + CONV_GU_P1 + r_, scr_, threadIdx.x & 63);
      for (int r_ = CONV_D_P1 + (crr - 224) * 8 + (threadIdx.x >> 6); r_ < 4096; r_ += 256) conv_d_item(p, r_, scr_, threadIdx.x & 63);
      __syncthreads();
    }
#endif
#if REPEAT_PHASE == 3
    grid.sync();
    if ((REPEAT_SUB & 1) && (!split23 || crr < 224)) P2_GEMMS(true);
    if ((REPEAT_SUB & 2) && split23 && crr >= 224) {
      gla_scan_block(p, lds, crr - 224);
      if (REPEAT_SUB & 4) { LAS float* scr_ = (LAS float*)(lds + (threadIdx.x >> 6) * 8704);
      for (int r_ = (crr - 224) * 8 + (threadIdx.x >> 6); r_ < CONV_GU_P2; r_ += 256) conv_gu_item(p, CONV_GU_P0 + CONV_GU_P1 + r_, scr_, threadIdx.x & 63);
      for (int r_ = CONV_D_P1 + (crr - 224) * 8 + (threadIdx.x >> 6); r_ < 4096; r_ += 256) conv_d_item(p, r_, scr_, threadIdx.x & 63);
      __syncthreads(); }
    }
#endif
  }
  SEAM(3);
  if (PH(4)) {
#if ENABLE_MLA && ENABLE_GLA
    if (G == 256) {
      const int bh = vb >> 2, s4 = vb & 3;
      const int odd = vb & 1;
#pragma unroll 1
      for (int k = 0; k < 8; ++k) { const int i = k >> 1;
        if (((k + odd) & 1) == 0) { const int qb = (i == 0) ? 15 - s4 : (i == 1) ? 8 + s4 : (i == 2) ? 7 - s4 : s4; attn_unit<0>(p, lds, bh >> 3, bh & 7, qb); }
        else gla_c_phase<0>(p, lds, G, vb, 2 * i, 2 * i + 2); }
    } else { attn_phase<0>(p, lds, G, vb); P4_GLA(); }
#elif ENABLE_MLA
    attn_phase<0>(p, lds, G, vb);
#else
    { u32x4* Yz = (u32x4*)(ws + WS_Y); for (int i = vb * 512 + threadIdx.x; i < NTOK * 64; i += G * 512) Yz[(size_t)(i >> 6) * 128 + 64 + (i & 63)] = (u32x4){0u, 0u, 0u, 0u}; }
#endif
#if ENABLE_GLA && !ENABLE_MLA
    P4_GLA();
#endif
#if REPEAT_PHASE == 4
    grid.sync();
#ifndef ATTN_PROBE_MODE
#define ATTN_PROBE_MODE 0
#endif
    if (REPEAT_SUB & 1) attn_phase<ATTN_PROBE_MODE>(p, lds, G, vb);
#ifndef GLA_PROBE_MODE
#define GLA_PROBE_MODE 0
#endif
    if (REPEAT_SUB & 2) gla_c_phase<GLA_PROBE_MODE>(p, lds, G, vb, 0, 1 << 20);
#endif
  }
  SEAM(4);
  if (PH(5)) for (int rep = 0; rep < NREP(5); ++rep) {
    if (rep) grid.sync();
    g8::DenseSched S; S.init(ws + WS_Y, 1024, ws + WS_WOUT, 1024, NTOK, 1024, G, crr);
    EpiWout E{p.in[0], (bf16_t*)(ws + WS_XB), ws + WS_H8};
    g8::gemm_phase(lds, 1024, S, E);
  }
  SEAM(5);
#if ENABLE_MOE
  if (PH(6)) router_phase(p, lds, G, vb);
  SEAM(6);
  if (PH(7) || PH(8)) {
    LAS int* tb = (LAS int*)(lds + LDS_CTL); LAS int* cn = (LAS int*)(lds + LDS_CTL + 256);
    if (threadIdx.x == 0) { const int* cnt = (const int*)(ws + WS_CNT); int acc = 0;
      for (int e = 0; e < NEXP; ++e) { const int c = cnt[e]; cn[e] = c; tb[e] = acc; acc += (c + 255) >> 8; }
      tb[NEXP] = acc; }
    __syncthreads();
    const int T = tb[NEXP];
    if (PH(7)) for (int rep = 0; rep < NREP(7); ++rep) {
      if (rep) grid.sync();
#if MOE_FP8
      MoeSched<true> S; S.A = (const char*)(ws + WS_H8); S.B = (const char*)(ws + WS_WGU); S.lda = 512; S.ldb = 512; S.ncol = 2; S.total = T * 2; S.G = G; S.c = vb;
      S.tb = tb; S.cn = cn; S.ltok = (const int*)(ws + WS_LTOK); S.bstride = (size_t)512 * 1024; S.n1 = 0; S.r = 0; S.flg = nullptr;
#else
      MoeSched<true> S; S.A = (const char*)(ws + WS_XB); S.B = (const char*)(ws + WS_WGU); S.lda = 1024; S.ldb = 1024; S.ncol = 2; S.total = T * 2; S.G = G; S.c = vb;
      S.tb = tb; S.cn = cn; S.ltok = (const int*)(ws + WS_LTOK); S.bstride = (size_t)512 * 1024 * 2; S.n1 = 0; S.r = 0; S.flg = nullptr;
#endif
      EpiGU E{(bf16_t*)(ws + WS_QB), (const float*)(ws + WS_LRS2), (const int*)(ws + WS_LTOK), cn, rep > 0 && P8_DRY, (int*)(ws + WS_FLG)};
      g8::gemm_phase<MOE_FP8 ? 2 : 0>(lds, MOE_FP8 ? 512 : 1024, S, E);
    }
    if (PH(8)) for (int rep = 0; rep < NREP(8); ++rep) {
      if (rep) grid.sync();
#if MOE_FP8
      MoeSched<false> S; S.A = (const char*)(ws + WS_QB); S.B = (const char*)(ws + WS_WD); S.lda = 128; S.ldb = 128; S.ncol = 4; S.total = T * 4; S.G = G; S.c = vb;
      S.tb = tb; S.cn = cn; S.ltok = (const int*)(ws + WS_LTOK); S.bstride = (size_t)1024 * 256;
#else
      MoeSched<false> S; S.A = (const char*)(ws + WS_QB); S.B = (const char*)(ws + WS_WD); S.lda = 256; S.ldb = 256; S.ncol = 4; S.total = T * 4; S.G = G; S.c = vb;
      S.tb = tb; S.cn = cn; S.ltok = (const int*)(ws + WS_LTOK); S.bstride = (size_t)1024 * 256 * 2;
#endif
      { const int rr_ = (T * 2) % G, n0_ = (T * 4 + 2 * rr_ + G - 1) / G; S.r = rr_; S.n1 = n0_ > 2 ? n0_ - 2 : 0; S.flg = (const int*)(ws + WS_FLG); }
      EpiDown E{(bf16_t*)(ws + WS_PROJ), (const int*)(ws + WS_LTOK), (const float*)(ws + WS_LGATE), cn, rep > 0 && P8_DRY};
      g8::gemm_phase<MOE_FP8 ? 1 : 0>(lds, MOE_FP8 ? 128 : 256, S, E);
    }
  }
  SEAM(8);
#endif
#ifdef PROBE_T1
  __syncthreads();
  const float probe_c1 = 0.1f * log2f((float)(tsx[PROBE_T1 + 1] - tsx[PROBE_T1]) * 0.01f), probe_c2 = 0.f;
  if (PH(9)) final_phase(p, G, vb, probe_c1, probe_c2);
#else
#ifdef EXTRA_SYNCS
  for (int i = 0; i < EXTRA_SYNCS; ++i) grid.sync();
#endif
  if (PH(9)) final_phase(p, G, vb, 0.f, 0.f);
#endif
#undef PH
#undef SEAM
}

extern "C" void kernel_launch(void* const* d_in, const int* in_sizes, int n_in, void* d_out, int out_size,
                              void* d_ws, size_t ws_size, hipStream_t stream) {
  static int grid_blocks = 0;
  if (grid_blocks == 0) {
    if (n_in != 21 || ws_size < WS_END) { fprintf(stderr, "kernel_launch: unexpected n_in %d or ws_size %zu (< %zu)\n", n_in, ws_size, (size_t)WS_END); grid_blocks = -1; return; }
    int dev = 0, cus = 0, per_cu = 0;
    hipGetDevice(&dev);
    hipDeviceGetAttribute(&cus, hipDeviceAttributeMultiprocessorCount, dev);
    hipFuncSetAttribute((const void*)fwd, hipFuncAttributeMaxDynamicSharedMemorySize, LDS_BYTES);
    hipOccupancyMaxActiveBlocksPerMultiprocessor(&per_cu, (const void*)fwd, 512, LDS_BYTES);
    if (per_cu < 1) { fprintf(stderr, "kernel_launch: occupancy query says %d blocks/CU\n", per_cu); per_cu = 1; }
    grid_blocks = cus;
  }
  if (grid_blocks < 0) return;
  Params p{};
  for (int i = 0; i < 21; ++i) p.in[i] = (const float*)d_in[i];
  p.out = (float*)d_out; p.ws = (unsigned char*)d_ws;
  int lo = 0, hi = 10;
  void* args[] = {&p, &lo, &hi};
  hipError_t e = hipLaunchCooperativeKernel((void*)fwd, dim3(grid_blocks), dim3(512), args, LDS_BYTES, stream);
  if (e != hipSuccess) fprintf(stderr, "cooperative launch failed: %s (grid %d)\n", hipGetErrorString(e), grid_blocks);
}
```

```cpp
#include <hip/hip_runtime.h>
#include <hip/hip_cooperative_groups.h>
#include <cstdio>
#include <cstdint>
#include <cmath>
namespace cg = cooperative_groups;

#ifndef WOUT_EPI_ROWS
#define WOUT_EPI_ROWS 4
#endif
#ifndef W_OUT_F8MODE
#define W_OUT_F8MODE 2
#endif
#ifndef MOE_FP8
#define MOE_FP8 1
#endif
#ifndef ENABLE_GLA
#define ENABLE_GLA 1
#endif
#ifndef ENABLE_MLA
#define ENABLE_MLA 1
#endif
#ifndef ENABLE_MOE
#define ENABLE_MOE 1
#endif

#ifndef P8_DRY
#define P8_DRY false
#endif
#ifndef REPEAT_PHASE
#define REPEAT_PHASE -1
#endif
#ifndef REPEAT_SUB
#define REPEAT_SUB 3
#endif
#define NREP(k) ((REPEAT_PHASE == (k)) ? 2 : 1)
#define LAS __attribute__((address_space(3)))
typedef unsigned short bf16_t;
typedef short bf16x8 __attribute__((ext_vector_type(8)));
typedef short s16x4 __attribute__((ext_vector_type(4)));
typedef float f32x4 __attribute__((ext_vector_type(4)));
typedef float f32x2 __attribute__((ext_vector_type(2)));
typedef float f32x16 __attribute__((ext_vector_type(16)));
typedef unsigned u32x4 __attribute__((ext_vector_type(4)));
typedef unsigned u32x2 __attribute__((ext_vector_type(2)));
typedef int i32x4 __attribute__((ext_vector_type(4)));
typedef int i32x8 __attribute__((ext_vector_type(8)));
typedef __bf16 bf16x2_t __attribute__((ext_vector_type(2)));

constexpr int NTOK = 32768, DM = 1024, SEQ = 4096, NBATCH = 8;
constexpr int NP = 2304;
constexpr int Q_OFF = 0, K_OFF = 256, V_OFF = 512, OG_OFF = 1024, CQ_OFF = 1536, CKV_OFF = 1920, KR_OFF = 2176, LR_OFF = 2208;
constexpr int NEXP = 32, ECAP = 32768;
constexpr float EPS = 1e-6f;
constexpr float F8_SY = 16.f, F8_SWO = 512.f;
constexpr float F8_SH = 4.f, F8_SWGU = 32.f, F8_SHID = 4.f, F8_SWD = 16.f;
constexpr float QSCALE = 0.10206207261596575f * 1.4426950408889634f;

constexpr size_t MiB = 1u << 20;
constexpr size_t WS_CNT = 0;
constexpr size_t WS_FLG = 4096;
constexpr size_t WS_BAR = 128 * 1024;
constexpr size_t WS_GUT = 64 * 1024;
constexpr size_t WS_RS1 = 1 * MiB;
constexpr size_t WS_RS2 = 1 * MiB + 512 * 1024;
constexpr size_t WS_SSQP = 2 * MiB;
constexpr size_t WS_CS = 4 * MiB;
constexpr size_t WS_LTOK = 8 * MiB;
constexpr size_t WS_LGATE = 12 * MiB;
constexpr size_t WS_WIN = 16 * MiB;
constexpr size_t WS_WUQ = 21 * MiB;
constexpr size_t WS_WUKV = 22 * MiB;
constexpr size_t WS_WOUT = 23 * MiB;
constexpr size_t WS_WR = 25 * MiB;
constexpr size_t WS_WGU = 26 * MiB;
constexpr size_t WS_WD = 58 * MiB;
constexpr size_t WS_DEC = 74 * MiB;
constexpr size_t WS_XB = 80 * MiB;
constexpr size_t WS_PROJ = 144 * MiB;
constexpr size_t WS_SC8 = 144 * MiB + 64 * MiB;
constexpr size_t WS_QB = 288 * MiB;
constexpr size_t WS_KVB = 336 * MiB;
constexpr size_t WS_Y = 400 * MiB;
constexpr size_t WS_SPT = 464 * MiB;
constexpr size_t WS_H8 = WS_KVB;
constexpr size_t WS_LRS2 = 496 * MiB;
constexpr size_t WS_END = 500 * MiB;

struct Params {
  const float* in[21];
  float* out;
  unsigned char* ws;
};

__device__ __forceinline__ unsigned pk2(float lo, float hi) { f32x2 v = {lo, hi}; bf16x2_t b = __builtin_convertvector(v, bf16x2_t); return __builtin_bit_cast(unsigned, b); }
__device__ __forceinline__ float bf2f(unsigned short h) { return __uint_as_float(((unsigned)h) << 16); }
__device__ __forceinline__ float bflo(unsigned w) { return __uint_as_float(w << 16); }
__device__ __forceinline__ float bfhi(unsigned w) { return __uint_as_float(w & 0xffff0000u); }
__device__ __forceinline__ u32x2 pk8_fp8(const f32x4& a, const f32x4& b, float sc) {
  float t[8] = {a[0] * sc, a[1] * sc, a[2] * sc, a[3] * sc, b[0] * sc, b[1] * sc, b[2] * sc, b[3] * sc};
#pragma unroll
  for (int i = 0; i < 8; ++i) t[i] = fminf(fmaxf(t[i], -448.f), 448.f);
  int lo = __builtin_amdgcn_cvt_pk_fp8_f32(t[0], t[1], 0, false); lo = __builtin_amdgcn_cvt_pk_fp8_f32(t[2], t[3], lo, true);
  int hi = __builtin_amdgcn_cvt_pk_fp8_f32(t[4], t[5], 0, false); hi = __builtin_amdgcn_cvt_pk_fp8_f32(t[6], t[7], hi, true);
  u32x2 r; r.x = (unsigned)lo; r.y = (unsigned)hi; return r;
}
__device__ __forceinline__ unsigned pk4_fp8(float a, float b, float c, float d) {
  a = __builtin_amdgcn_fmed3f(a, -448.f, 448.f); b = __builtin_amdgcn_fmed3f(b, -448.f, 448.f); c = __builtin_amdgcn_fmed3f(c, -448.f, 448.f); d = __builtin_amdgcn_fmed3f(d, -448.f, 448.f);
  int w = __builtin_amdgcn_cvt_pk_fp8_f32(a, b, 0, false); w = __builtin_amdgcn_cvt_pk_fp8_f32(c, d, w, true); return (unsigned)w;
}
__device__ __forceinline__ int perm32(int rho) { const int n = rho >> 4, i = rho & 15; return 8 * (i >> 2) + 4 * n + (i & 3); }
__device__ __forceinline__ float wave_sum(float v) {
#pragma unroll
  for (int o = 1; o < 64; o <<= 1) v += __shfl_xor(v, o);
  return v;
}
#define XCD_BAR_WORDS 8192
#define LDS_WAIT() asm volatile("s_waitcnt lgkmcnt(0)" ::: "memory")
#define LBAR() asm volatile("s_waitcnt lgkmcnt(0)\n\ts_barrier" ::: "memory")

namespace g8 {
constexpr int BM = 256, BK = 64, HALF = 128, HTB = HALF * BK * 2, STAGE_BYTES = 8 * HTB, NXCD = 8, WGM = 8;
__device__ __forceinline__ int lds_byte(int r, int c) { const int st = (r >> 4) * 2 + (c >> 5), rr = r & 15, cc = c & 31, ob = rr * 64 + cc * 2; return st * 1024 + (ob ^ (((ob >> 9) & 1) << 5)); }
__device__ __forceinline__ void stage_rc(int b, int& R, int& C) { const int st = b / 1024, sb = b % 1024, swz = sb ^ (((sb >> 9) & 1) << 5); R = (st >> 1) * 16 + swz / 64; C = (st & 1) * 32 + (swz % 64) / 2; }

struct Unit { const char* A; const char* B; int a, b, c, d; };

template <int F8 = 0  , class Epi, class Sched>
__device__ __forceinline__ void gemm_phase(LAS unsigned char* lds, const int K, const Sched& S, const Epi& E) {
  const int tid = threadIdx.x, wid = __builtin_amdgcn_readfirstlane(tid >> 6), lane = tid & 63, wr = wid >> 2, wc = wid & 3, fr = lane & 15, fq = lane >> 4;
  const int nt = K / BK;
  int R[2], C[2];
#pragma unroll
  for (int i = 0; i < 2; ++i) stage_rc(tid * 16 + i * 8192, R[i], C[i]);
  constexpr bool GA = Sched::GATHER;
  unsigned oB[2], oA[2][2];
  LAS unsigned* onxt = (LAS unsigned*)(lds + STAGE_BYTES + 1024) + tid;
#pragma unroll
  for (int i = 0; i < 2; ++i) oB[i] = (unsigned)(R[i] * S.ldb + C[i]) * 2u;
  const size_t hB = (size_t)HALF * S.ldb * 2, hA = GA ? (size_t)0 : (size_t)HALF * S.lda * 2;
  const size_t kstep = (size_t)(BK * 2);
  const unsigned ldsw = (unsigned)wid * 1024u;
  const int aoff = lds_byte(wr * 64 + fr, fq * 8), boff = lds_byte(wc * 32 + fr, fq * 8);
#define G8_SA(b, h) (((b) * 2 + (h)) * HTB)
#define G8_SB(b, h) ((4 + (b) * 2 + (h)) * HTB)
#define G8_STAGE_X(bufoff, gbase, off2, AUX) do { _Pragma("unroll") for (int _i = 0; _i < 2; ++_i) \
    __builtin_amdgcn_global_load_lds((const unsigned*)((const char*)(gbase) + (off2)[_i]), (LAS unsigned*)(lds + (bufoff) + ldsw + _i * 8192), 16, 0, AUX); } while (0)
#define G8_STAGE(bufoff, gbase, off2) G8_STAGE_X(bufoff, gbase, off2, 0)
#define G8_STAGEA(bufoff, gbase, off2) G8_STAGE_X(bufoff, gbase, off2, (Sched::A_SC1 ? 16 : 0))
#define G8_LD16(off_) (*(const LAS i32x4*)(lds + (off_)))
#define G8_LDA(dst, b, h) do { _Pragma("unroll") for (int m = 0; m < 4; ++m) { \
    if constexpr (F8 == 2) dst##8[m] = __builtin_shufflevector(G8_LD16(G8_SA(b, h) + aoff + m * 2048), G8_LD16(G8_SA(b, h) + aoff + m * 2048 + 1024), 0, 1, 2, 3, 4, 5, 6, 7); \
    else { _Pragma("unroll") for (int k = 0; k < 2; ++k) dst[m][k] = *(const LAS bf16x8*)(lds + G8_SA(b, h) + aoff + m * 2048 + k * 1024); } } } while (0)
#define G8_LDB(dst, b, h) do { _Pragma("unroll") for (int n = 0; n < 2; ++n) { \
    if constexpr (F8 == 2) dst##8[n] = __builtin_shufflevector(G8_LD16(G8_SB(b, h) + boff + n * 2048), G8_LD16(G8_SB(b, h) + boff + n * 2048 + 1024), 0, 1, 2, 3, 4, 5, 6, 7); \
    else { _Pragma("unroll") for (int k = 0; k < 2; ++k) dst[n][k] = *(const LAS bf16x8*)(lds + G8_SB(b, h) + boff + n * 2048 + k * 1024); } } } while (0)
#define G8_MMA(ai, bj, At, Bt) do { __builtin_amdgcn_s_setprio(1); \
    if constexpr (F8 == 2) {   \
      _Pragma("unroll") for (int m = 0; m < 4; ++m) _Pragma("unroll") for (int n = 0; n < 2; ++n) \
        acc[ai][bj][m][n] = __builtin_amdgcn_mfma_scale_f32_16x16x128_f8f6f4(Bt##8[n], At##8[m], acc[ai][bj][m][n], 0, 0, 0, 0x7f7f7f7f, 0, 0x7f7f7f7f); \
    } else if constexpr (F8 == 1) { \
      _Pragma("unroll") for (int m = 0; m < 4; ++m) _Pragma("unroll") for (int n = 0; n < 2; ++n) { \
        const i32x4 b0_ = __builtin_bit_cast(i32x4, Bt[n][0]), b1_ = __builtin_bit_cast(i32x4, Bt[n][1]), a0_ = __builtin_bit_cast(i32x4, At[m][0]), a1_ = __builtin_bit_cast(i32x4, At[m][1]); \
        acc[ai][bj][m][n] = __builtin_amdgcn_mfma_scale_f32_16x16x128_f8f6f4(__builtin_shufflevector(b0_, b1_, 0, 1, 2, 3, 4, 5, 6, 7), __builtin_shufflevector(a0_, a1_, 0, 1, 2, 3, 4, 5, 6, 7), \
                                                                             acc[ai][bj][m][n], 0, 0, 0, 0x7f7f7f7f, 0, 0x7f7f7f7f); } \
    } else { \
      _Pragma("unroll") for (int m = 0; m < 4; ++m) _Pragma("unroll") for (int n = 0; n < 2; ++n) _Pragma("unroll") for (int k = 0; k < 2; ++k) \
        acc[ai][bj][m][n] = __builtin_amdgcn_mfma_f32_16x16x32_bf16(Bt[n][k], At[m][k], acc[ai][bj][m][n], 0, 0, 0); } \
    __builtin_amdgcn_s_setprio(0); } while (0)
#define G8_WAIT_V(n) asm volatile("s_waitcnt vmcnt(" #n ")" ::: "memory")
#define G8_WAIT_L(n) asm volatile("s_waitcnt lgkmcnt(" #n ")" ::: "memory")
#define G8_BAR __builtin_amdgcn_s_barrier()
#define G8_SCHED __builtin_amdgcn_sched_barrier(0)
  Unit cur, nxt; int ui = 0;
  if (!S.next(0, cur)) return;
  S.offs(cur, R, C, oA);
  f32x4 acc[2][2][4][2];
#pragma unroll
  for (int a = 0; a < 2; ++a)
#pragma unroll
    for (int b = 0; b < 2; ++b)
#pragma unroll
      for (int m = 0; m < 4; ++m)
#pragma unroll
        for (int n = 0; n < 2; ++n) acc[a][b][m][n] = (f32x4){0.f, 0.f, 0.f, 0.f};
  bf16x8 At[4][2], B0[2][2], B1[2][2];
  i32x8 At8[4], B08[2], B18[2];
  const char* cA = cur.A; const char* cB = cur.B;
  G8_STAGE(G8_SB(0, 0), cB, oB); G8_STAGE(G8_SB(0, 1), cB + hB, oB); G8_STAGEA(G8_SA(0, 0), cA, oA[0]); G8_STAGEA(G8_SA(0, 1), cA + hA, oA[GA]);
  if (wr == 1) G8_BAR;
  G8_WAIT_V(2); G8_BAR;
  G8_STAGE(G8_SB(1, 0), cB + kstep, oB); G8_STAGEA(G8_SA(1, 0), cA + kstep, oA[0]); G8_STAGE(G8_SB(1, 1), cB + kstep + hB, oB);
  G8_WAIT_V(6); G8_BAR;
  for (;;) {
    const bool has_next = S.next(ui + 1, nxt);
    if (GA && has_next) {
      unsigned oAn[2][2]; S.offs(nxt, R, C, oAn);
#pragma unroll
      for (int h = 0; h < 2; ++h)
#pragma unroll
        for (int i = 0; i < 2; ++i) onxt[(h * 2 + i) * 512] = oAn[h][i];
    }
    const char* nA = has_next ? nxt.A : cA; const char* nB = has_next ? nxt.B : cB;
#pragma unroll 1
    for (int t = 0; t < nt; t += 2) {
      const bool last = (t == nt - 2);
      const char* a1 = cA + (size_t)(t + 1) * kstep;
      const char* a2 = last ? nA : cA + (size_t)(t + 2) * kstep; const char* b2 = last ? nB : cB + (size_t)(t + 2) * kstep;
      const char* a3 = a2 + kstep; const char* b3 = b2 + kstep;
      G8_LDB(B0, 0, 0); G8_LDB(B1, 0, 1); G8_SCHED; G8_LDA(At, 0, 0); G8_STAGEA(G8_SA(1, 1), a1 + hA, oA[GA]);
      G8_WAIT_V(8); G8_WAIT_L(0); G8_BAR; G8_MMA(0, 0, At, B0); G8_MMA(0, 1, At, B1); G8_BAR; G8_SCHED;
      if (GA && last && has_next) {
#pragma unroll
        for (int h = 0; h < 2; ++h)
#pragma unroll
          for (int i = 0; i < 2; ++i) oA[h][i] = onxt[(h * 2 + i) * 512];
      }
      G8_LDA(At, 0, 1); G8_STAGE(G8_SB(0, 0), b2, oB); G8_STAGE(G8_SB(0, 1), b2 + hB, oB); G8_STAGEA(G8_SA(0, 0), a2, oA[0]);
      G8_WAIT_V(8); G8_WAIT_L(0); G8_BAR; G8_MMA(1, 0, At, B0); G8_MMA(1, 1, At, B1); G8_BAR; G8_SCHED;
      G8_LDB(B0, 1, 0); G8_LDB(B1, 1, 1); G8_SCHED; G8_LDA(At, 1, 0); G8_STAGEA(G8_SA(0, 1), a2 + hA, oA[GA]);
      G8_WAIT_V(8); G8_WAIT_L(0); G8_BAR; G8_MMA(0, 0, At, B0); G8_MMA(0, 1, At, B1); G8_BAR; G8_SCHED;
      G8_LDA(At, 1, 1); G8_STAGE(G8_SB(1, 0), b3, oB); G8_STAGE(G8_SB(1, 1), b3 + hB, oB); G8_STAGEA(G8_SA(1, 0), a3, oA[0]);
      G8_WAIT_V(8); G8_WAIT_L(0); G8_BAR; G8_MMA(1, 0, At, B0); G8_MMA(1, 1, At, B1); G8_BAR; G8_SCHED;
    }
    if (wr == 0) G8_BAR;
    E(acc, cur, wr, wc, fr, fq);
    if (!has_next) break;
#pragma unroll
    for (int a = 0; a < 2; ++a)
#pragma unroll
      for (int b = 0; b < 2; ++b)
#pragma unroll
        for (int m = 0; m < 4; ++m)
#pragma unroll
          for (int n = 0; n < 2; ++n) acc[a][b][m][n] = (f32x4){0.f, 0.f, 0.f, 0.f};
    cur = nxt; cA = nA; cB = nB; ++ui;
    if (wr == 1) G8_BAR;
  }
  G8_WAIT_V(0);
  G8_BAR;
#undef G8_SA
#undef G8_SB
#undef G8_STAGE
#undef G8_STAGEA
#undef G8_STAGE_X
#undef G8_LD16
#undef G8_LDA
#undef G8_LDB
#undef G8_MMA
#undef G8_WAIT_V
#undef G8_WAIT_L
#undef G8_BAR
#undef G8_SCHED
}

struct DenseSched {
  static constexpr bool GATHER = false, A_SC1 = false;
  const char* A; const char* B; int lda, ldb; int nM, nN, nwg, G, c;
  __device__ __forceinline__ void init(const void* A_, int lda_, const void* B_, int ldb_, int M, int N, int G_, int c_) {
    A = (const char*)A_; B = (const char*)B_; lda = lda_; ldb = ldb_; nM = M / BM; nN = N / BM; nwg = nM * nN; G = G_; c = c_; }
  __device__ __forceinline__ bool next(int i, Unit& u) const {
    const long L = (long)i * G + c; if (L >= nwg) return false;
    int wgid = (int)L; { const int q = nwg / NXCD, r = nwg % NXCD, xcd = wgid % NXCD, off = wgid / NXCD; wgid = (xcd < r ? xcd * (q + 1) : r * (q + 1) + (xcd - r) * q) + off; }
    const int nig = WGM * nN, gid = wgid / nig, fm = gid * WGM, gsz = (nM % WGM == 0) ? WGM : ((nM - fm) < WGM ? (nM - fm) : WGM);
    const int pm = fm + ((wgid % nig) % gsz), pn = (wgid % nig) / gsz;
    u.a = pm; u.b = pn; u.c = 0; u.d = 0;
    u.A = A + (size_t)pm * BM * lda * 2; u.B = B + (size_t)pn * BM * ldb * 2; return true;
  }
  __device__ __forceinline__ void offs(const Unit&, const int (&R)[2], const int (&C)[2], unsigned (&o)[2][2]) const {
#pragma unroll
    for (int h = 0; h < 2; ++h)
#pragma unroll
      for (int i = 0; i < 2; ++i) o[h][i] = (unsigned)(R[i] * lda + C[i]) * 2u;
  }
};
struct DenseSchedG : DenseSched {
  static constexpr bool GATHER = true;
  __device__ __forceinline__ bool next(int i, Unit& u) const { const bool ok = DenseSched::next(i, u); u.A = A; return ok; }
  __device__ __forceinline__ void offs(const Unit& u, const int (&R)[2], const int (&C)[2], unsigned (&o)[2][2]) const {
#pragma unroll
    for (int h = 0; h < 2; ++h)
#pragma unroll
      for (int i = 0; i < 2; ++i) o[h][i] = (unsigned)((u.a * BM + h * HALF + R[i]) * lda + C[i]) * 2u;
  }
};
}

__device__ __forceinline__ u32x4 pack8(const f32x4& a, const f32x4& b) { u32x4 w; w.x = pk2(a[0], a[1]); w.y = pk2(a[2], a[3]); w.z = pk2(b[0], b[1]); w.w = pk2(b[2], b[3]); return w; }

__device__ __forceinline__ __amdgpu_buffer_rsrc_t mk_rsrc(const void* base) { return __builtin_amdgcn_make_buffer_rsrc((void*)base, 0, 0x7fffffff, 0x00020000); }

__device__ __forceinline__ void rope4(f32x4& a, f32x4& b, const f32x2* cs) {
#pragma unroll
  for (int j = 0; j < 4; ++j) { const float c = cs[j].x, s = cs[j].y, x1 = a[j], x2 = b[j]; a[j] = x1 * c - x2 * s; b[j] = x1 * s + x2 * c; }
}

#define EPI_ROW(ri) (((ri) >> 2) * 128 + wr * 64 + ((ri) & 3) * 16 + fr)
#define EPI_FENCE() asm volatile("" ::: "memory")

struct EpiInproj {
  bf16_t* PROJ; const float* rs1; float* ssqp; const f32x2* CS;
  __device__ __forceinline__ void operator()(const f32x4 (&acc)[2][2][4][2], const g8::Unit& u, int wr, int wc, int fr, int fq) const {
    asm volatile("" : "+v"(fr), "+v"(fq));
    const int pm = u.a, pn = u.b;
    const bool cq0 = (pn == 6 || pn == 7), cq1 = (pn == 6), ckv0 = (pn == 8), ckv1 = (pn == 7);
    float rsv[8];
#pragma unroll
    for (int ri = 0; ri < 8; ++ri) rsv[ri] = rs1[pm * 256 + EPI_ROW(ri)];
#pragma unroll
    for (int ri = 0; ri < 8; ++ri) {
      EPI_FENCE();
      const int ai = ri >> 2, m = ri & 3;
      const int row = pm * 256 + EPI_ROW(ri);
      const float rs = rsv[ri];
      float sq = 0.f, skv = 0.f;
#pragma unroll
      for (int bj = 0; bj < 2; ++bj) {
        const int G = 8 * pn + 4 * bj + wc;
        f32x4 v0 = acc[ai][bj][m][0] * rs, v1 = acc[ai][bj][m][1] * rs;
        if (G == 68) {
          f32x2 cs[4];
#pragma unroll
          for (int j = 0; j < 4; ++j) cs[j] = CS[(size_t)row * 16 + 4 * fq + j];
          rope4(v0, v1, cs);
          u32x2 w0, w1; w0.x = pk2(v0[0], v0[1]); w0.y = pk2(v0[2], v0[3]); w1.x = pk2(v1[0], v1[1]); w1.y = pk2(v1[2], v1[3]);
          *(u32x2*)(PROJ + (size_t)row * NP + KR_OFF + 4 * fq) = w0;
          *(u32x2*)(PROJ + (size_t)row * NP + KR_OFF + 16 + 4 * fq) = w1;
        } else {
          if (G < 70) *(u32x4*)(PROJ + (size_t)row * NP + 32 * G + 8 * fq) = pack8(v0, v1);
          const float s = (v0[0] * v0[0] + v0[1] * v0[1]) + (v0[2] * v0[2] + v0[3] * v0[3]) + (v1[0] * v1[0] + v1[1] * v1[1]) + (v1[2] * v1[2] + v1[3] * v1[3]);
          if (bj == 0 ? cq0 : cq1) sq += s;
          if (bj == 0 ? ckv0 : ckv1) skv += s;
        }
      }
      if (cq0) { sq += __shfl_xor(sq, 16); sq += __shfl_xor(sq, 32); if (fq == 0) ssqp[(size_t)row * 16 + (pn - 6) * 4 + wc] = sq; }
      if (ckv0 || ckv1) { skv += __shfl_xor(skv, 16); skv += __shfl_xor(skv, 32); if (fq == 0) ssqp[(size_t)row * 16 + 8 + (pn - 7) * 4 + wc] = skv; }
    }
  }
};

struct EpiUq {
  bf16_t* QB; const float* ssqp; const f32x2* CS; bool dry;
  __device__ __forceinline__ void operator()(const f32x4 (&acc)[2][2][4][2], const g8::Unit& u, int wr, int wc, int fr, int fq) const {
    asm volatile("" : "+v"(fr), "+v"(fq));
    const int pm = u.a, pn = u.b;
    const bool rope0 = ((8 * pn + wc) % 3) == 2, rope1 = ((8 * pn + 4 + wc) % 3) == 2;
    f32x4 na, nb;
    { const f32x4* pp = (const f32x4*)(ssqp + (size_t)(pm * 256 + EPI_ROW(0)) * 16); na = pp[0]; nb = pp[1]; }
#pragma unroll
    for (int ri = 0; ri < 8; ++ri) {
      const int ai = ri >> 2, m = ri & 3;
      const int row = pm * 256 + EPI_ROW(ri);
      const f32x4 a = na, b = nb;
      EPI_FENCE();
      if (ri < 7) { const f32x4* pp = (const f32x4*)(ssqp + (size_t)(pm * 256 + EPI_ROW(ri + 1)) * 16); na = pp[0]; nb = pp[1]; }
      const float ss = ((a[0] + a[1]) + (a[2] + a[3])) + ((b[0] + b[1]) + (b[2] + b[3]));
      const float rs = rsqrtf(ss * (1.f / 384.f) + EPS) * QSCALE;
#pragma unroll
      for (int bj = 0; bj < 2; ++bj) {
        const int G = 8 * pn + 4 * bj + wc;
        f32x4 v0 = acc[ai][bj][m][0] * rs, v1 = acc[ai][bj][m][1] * rs;
        if (bj == 0 ? rope0 : rope1) {
          f32x2 cs[4];
#pragma unroll
          for (int j = 0; j < 4; ++j) cs[j] = CS[(size_t)row * 16 + 4 * fq + j];
          rope4(v0, v1, cs);
          u32x2 w0, w1; w0.x = pk2(v0[0], v0[1]); w0.y = pk2(v0[2], v0[3]); w1.x = pk2(v1[0], v1[1]); w1.y = pk2(v1[2], v1[3]);
          if (!dry || w0.x == 0x12345679u) { *(u32x2*)(QB + (size_t)row * 768 + 32 * G + 4 * fq) = w0;
          *(u32x2*)(QB + (size_t)row * 768 + 32 * G + 16 + 4 * fq) = w1; }
        } else {
          { const u32x4 w_ = pack8(v0, v1); if (!dry || w_.x == 0x12345679u) *(u32x4*)(QB + (size_t)row * 768 + 32 * G + 8 * fq) = w_; }
        }
      }
    }
  }
};

struct EpiUkv {
  bf16_t* KVB; const float* ssqp; bool dry;
  __device__ __forceinline__ void operator()(const f32x4 (&acc)[2][2][4][2], const g8::Unit& u, int wr, int wc, int fr, int fq) const {
    asm volatile("" : "+v"(fr), "+v"(fq));
    const int pm = u.a, pn = u.b;
    float rsv[8];
#pragma unroll
    for (int ri = 0; ri < 8; ++ri) { const f32x4* pp = (const f32x4*)(ssqp + (size_t)(pm * 256 + EPI_ROW(ri)) * 16 + 8); const f32x4 a = pp[0], b = pp[1]; rsv[ri] = ((a[0] + a[1]) + (a[2] + a[3])) + ((b[0] + b[1]) + (b[2] + b[3])); }
#pragma unroll
    for (int ri = 0; ri < 8; ++ri) {
      const int ai = ri >> 2, m = ri & 3;
      const int row = pm * 256 + EPI_ROW(ri);
      const float rs = rsqrtf(rsv[ri] * (1.f / 256.f) + EPS);
#pragma unroll
      for (int bj = 0; bj < 2; ++bj) {
        const int G = 8 * pn + 4 * bj + wc;
        { const u32x4 w_ = pack8(acc[ai][bj][m][0] * rs, acc[ai][bj][m][1] * rs); if (!dry || w_.x == 0x12345679u) *(u32x4*)(KVB + (size_t)row * 1024 + 32 * G + 8 * fq) = w_; }
      }
    }
  }
};

struct EpiWout {
  const float* x; bf16_t* HB; unsigned char* H8;
  __device__ __forceinline__ void operator()(const f32x4 (&acc)[2][2][4][2], const g8::Unit& u, int wr, int wc, int fr, int fq) const {
    asm volatile("" : "+v"(fr), "+v"(fq));
    const int pm = u.a, pn = u.b;
#pragma unroll
    for (int half = 0; half < 8 / WOUT_EPI_ROWS; ++half) {
      EPI_FENCE();
      u32x4 xr[WOUT_EPI_ROWS][2];
#pragma unroll
      for (int q = 0; q < WOUT_EPI_ROWS; ++q) { const int row = pm * 256 + EPI_ROW(half * WOUT_EPI_ROWS + q);
#pragma unroll
        for (int bj = 0; bj < 2; ++bj) xr[q][bj] = *(const u32x4*)(HB + (size_t)row * 1024 + 32 * (8 * pn + 4 * bj + wc) + 8 * fq); }
#pragma unroll
      for (int q = 0; q < WOUT_EPI_ROWS; ++q) {
        const int ri = half * WOUT_EPI_ROWS + q, ai = ri >> 2, m = ri & 3;
        const int row = pm * 256 + EPI_ROW(ri);
#pragma unroll
        for (int bj = 0; bj < 2; ++bj) {
          const size_t off = (size_t)row * 1024 + 32 * (8 * pn + 4 * bj + wc) + 8 * fq;
          const u32x4 xw = xr[q][bj];
          const f32x4 x0 = {bflo(xw.x), bfhi(xw.x), bflo(xw.y), bfhi(xw.y)}, x1 = {bflo(xw.z), bfhi(xw.z), bflo(xw.w), bfhi(xw.w)};
          const f32x4 v0 = acc[ai][bj][m][0] * (1.f / (F8_SY * F8_SWO)) + x0, v1 = acc[ai][bj][m][1] * (1.f / (F8_SY * F8_SWO)) + x1;
          *(u32x4*)(HB + off) = pack8(v0, v1);
#if MOE_FP8
          *(u32x2*)(H8 + off) = pk8_fp8(v0, v1, F8_SH);
#endif
        }
      }
    }
  }
};

template <bool GATHER_>
struct MoeSched {
  static constexpr bool GATHER = GATHER_;
  static constexpr bool A_SC1 = !GATHER_;
  const char* A; const char* B; int lda, ldb; int ncol, total, G, c;
  const LAS int* tb; const LAS int* cn; const int* ltok; size_t bstride;
  int n1, r; const int* flg;
  __device__ __forceinline__ bool next(int i, g8::Unit& u) const {
    long L = (long)i * G + c;
    if (!GATHER_ && i >= n1) { if (c < r) return false; L = (long)n1 * G + (long)(i - n1) * (G - r) + (c - r); }
    if (L >= total) return false;
    const int rt = (int)(L / ncol), pn = (int)(L % ncol);
    if (!GATHER_) { unsigned sp_ = 0; while (__hip_atomic_load(flg + rt, __ATOMIC_RELAXED, __HIP_MEMORY_SCOPE_AGENT) < 16) { __builtin_amdgcn_s_sleep(2); if (++sp_ > (1u << 22)) break; } }
    const int e = __builtin_popcount((unsigned)__ballot(tb[threadIdx.x & 31] <= rt)) - 1;
    const int mt = rt - tb[e];
    u.a = e; u.b = mt; u.c = pn; u.d = rt;
    u.B = B + (size_t)e * bstride + (size_t)pn * 256 * ldb * 2;
    u.A = GATHER_ ? A : A + (size_t)rt * 256 * lda * 2;
    return true;
  }
  __device__ __forceinline__ void offs(const g8::Unit& u, const int (&R)[2], const int (&C)[2], unsigned (&o)[2][2]) const {
    if (GATHER_) {
      const int cnt = cn[u.a];
#pragma unroll
      for (int h = 0; h < 2; ++h)
#pragma unroll
        for (int i = 0; i < 2; ++i) { int pos = u.b * 256 + h * 128 + R[i]; pos = pos < cnt ? pos : cnt - 1; const int tok = ltok[u.a * ECAP + pos] >> 1;
          o[h][i] = (unsigned)(tok * lda + C[i]) * 2u; }
    } else {
#pragma unroll
      for (int h = 0; h < 2; ++h)
#pragma unroll
        for (int i = 0; i < 2; ++i) o[h][i] = (unsigned)(R[i] * lda + C[i]) * 2u;
    }
  }
};

struct EpiGU {
  bf16_t* HID; const float* rs2; const int* ltok; const LAS int* cn; bool dry; int* flg;
  __device__ __forceinline__ void operator()(const f32x4 (&acc)[2][2][4][2], const g8::Unit& u, int wr, int wc, int fr, int fq) const {
    asm volatile("" : "+v"(fr), "+v"(fq));
    const int e = u.a, mt = u.b, pn = u.c, rt = u.d; const int cnt = cn[e];
    const __amdgpu_buffer_rsrc_t rsrc = mk_rsrc(HID);
    float rsa[8];
#pragma unroll
    for (int ri = 0; ri < 8; ++ri) { int pos = mt * 256 + EPI_ROW(ri); pos = pos < cnt ? pos : cnt - 1; rsa[ri] = rs2[e * ECAP + pos]; }
#pragma unroll
    for (int half = 0; half < 2; ++half) {
      EPI_FENCE();
#pragma unroll
      for (int q = 0; q < 4; ++q) {
        const int ri = half * 4 + q, ai = ri >> 2, m = ri & 3;
        const int r = EPI_ROW(ri), pos = mt * 256 + r;
        if (pos < cnt) {
          const float rs = rsa[ri] * (MOE_FP8 ? 1.f / (F8_SH * F8_SWGU) : 1.f);
          f32x4 h0, h1;
#pragma unroll
          for (int j = 0; j < 4; ++j) {
            const float g0 = acc[ai][0][m][0][j] * rs, u0 = acc[ai][1][m][0][j] * rs, g1 = acc[ai][0][m][1][j] * rs, u1 = acc[ai][1][m][1][j] * rs;
            h0[j] = g0 * __builtin_amdgcn_rcpf(1.f + __expf(-g0)) * u0; h1[j] = g1 * __builtin_amdgcn_rcpf(1.f + __expf(-g1)) * u1;
          }
#if MOE_FP8
          __builtin_amdgcn_raw_buffer_store_b64(pk8_fp8(h0, h1, F8_SHID), rsrc, (int)((unsigned)((rt * 256 + r) * 256 + pn * 128 + wc * 32 + 8 * fq)), 0, 16);
#else
          { const u32x4 w_ = pack8(h0, h1); if (!dry || w_.x == 0x12345679u) __builtin_amdgcn_raw_buffer_store_b128(w_, rsrc, (int)((unsigned)(((rt * 256 + r) * 256 + pn * 128 + wc * 32 + 8 * fq) * 2)), 0, 16); }
#endif
        }
      }
    }
    asm volatile("s_waitcnt vmcnt(0)" ::: "memory");
    if (fr == 0 && fq == 0) __hip_atomic_fetch_add(flg + rt, 1, __ATOMIC_RELAXED, __HIP_MEMORY_SCOPE_AGENT);
  }
};

struct EpiDown {
  unsigned char* Y8; unsigned char* SC8; const int* ltok; const float* lgate; const LAS int* cn; bool dry;
  __device__ __forceinline__ void operator()(const f32x4 (&acc)[2][2][4][2], const g8::Unit& u, int wr, int wc, int fr, int fq) const {
    asm volatile("" : "+v"(fr), "+v"(fq));
    const int e = u.a, mt = u.b, pn = u.c; const int cnt = cn[e];
    const bool odd = fq & 1;
#pragma unroll
    for (int hf = 0; hf < 2; ++hf) {
      EPI_FENCE();
      int ds[4]; float gv[4];
#pragma unroll
      for (int q = 0; q < 4; ++q) { int pos = mt * 256 + EPI_ROW(hf * 4 + q); pos = pos < cnt ? pos : cnt - 1; ds[q] = ltok[e * ECAP + pos]; gv[q] = lgate[e * ECAP + pos]; }
#pragma unroll
      for (int q = 0; q < 4; ++q) {
        const int ri = hf * 4 + q, ai = ri >> 2, m = ri & 3;
        const int pos = mt * 256 + EPI_ROW(ri);
        EPI_FENCE();
        const float g = gv[q] * (MOE_FP8 ? 1.f / (F8_SHID * F8_SWD) : 1.f);
        f32x4 yq[2][2]; float mx = 0.f;
#pragma unroll
        for (int bj = 0; bj < 2; ++bj)
#pragma unroll
          for (int n = 0; n < 2; ++n) { yq[bj][n] = acc[ai][bj][m][n] * g;
#pragma unroll
            for (int jj = 0; jj < 4; ++jj) mx = fmaxf(mx, fabsf(yq[bj][n][jj])); }
        mx = fmaxf(mx, __shfl_xor(mx, 16)); mx = fmaxf(mx, __shfl_xor(mx, 32));
        int ex; (void)frexpf(fmaxf(mx, 1e-30f), &ex);
        const float sc = ldexpf(1.f, 8 - ex);
        u32x2 pk[2];
#pragma unroll
        for (int bj = 0; bj < 2; ++bj) {
          int lo = __builtin_amdgcn_cvt_pk_fp8_f32(yq[bj][0][0] * sc, yq[bj][0][1] * sc, 0, false); lo = __builtin_amdgcn_cvt_pk_fp8_f32(yq[bj][0][2] * sc, yq[bj][0][3] * sc, lo, true);
          int hi = __builtin_amdgcn_cvt_pk_fp8_f32(yq[bj][1][0] * sc, yq[bj][1][1] * sc, 0, false); hi = __builtin_amdgcn_cvt_pk_fp8_f32(yq[bj][1][2] * sc, yq[bj][1][3] * sc, hi, true);
          pk[bj].x = (unsigned)lo; pk[bj].y = (unsigned)hi; }
        const u32x2 snd = odd ? pk[0] : pk[1]; u32x2 rcv;
        rcv.x = (unsigned)__shfl_xor((int)snd.x, 16); rcv.y = (unsigned)__shfl_xor((int)snd.y, 16);
        u32x4 o; if (odd) { o.x = rcv.x; o.y = rcv.y; o.z = pk[1].x; o.w = pk[1].y; } else { o.x = pk[0].x; o.y = pk[0].y; o.z = rcv.x; o.w = rcv.y; }
        if (pos < cnt && (!dry || o.x == 0x12345679u)) {
          *(u32x4*)(Y8 + (size_t)ds[q] * 1024 + pn * 256 + wc * 64 + (odd ? 32 : 0) + 8 * (fq & 2)) = o;
          if (fq == 0) SC8[(size_t)ds[q] * 16 + pn * 4 + wc] = (unsigned char)(ex + 128);
        }
      }
    }
  }
};

__device__ __forceinline__ int inproj_src_col(int L) {
  if (L < 1024) return L;
  if (L < 1536) return 1040 + (L - 1024);
  if (L < 1920) return 1552 + (L - 1536);
  if (L < 2176) return 1936 + (L - 1920);
  if (L < 2208) return 2192 + (L - 2176);
  if (L < 2224) return 1024 + (L - 2208);
  return -1;
}
__device__ __forceinline__ void tr_item(const float* src, int ld, int cbase, int nvalid, bool permute, const float* kscale, int k0, bf16_t* dst, int K, LAS float* scr, int lane) {
  if (nvalid > 0) {
    f32x4 v[8];
#pragma unroll
    for (int i = 0; i < 8; ++i) v[i] = __builtin_nontemporal_load((const f32x4*)(src + (size_t)(k0 + i * 8 + (lane >> 3)) * ld + cbase + (lane & 7) * 4));
#pragma unroll
    for (int i = 0; i < 8; ++i) { const int kk = i * 8 + (lane >> 3); const float sc = kscale ? kscale[k0 + kk] : 1.f; LAS float* w = scr + kk * 33 + (lane & 7) * 4;
      w[0] = v[i].x * sc; w[1] = v[i].y * sc; w[2] = v[i].z * sc; w[3] = v[i].w * sc; }
  }
  LDS_WAIT();
  const int c = lane & 7;
#pragma unroll
  for (int j = 0; j < 4; ++j) { const int n = (lane >> 3) + 8 * j; const int sc_ = permute ? perm32(n) : n; const LAS float* s = scr + (8 * c) * 33 + sc_;
    u32x4 o = {0u, 0u, 0u, 0u};
    if (sc_ < nvalid) { o.x = pk2(s[0 * 33], s[1 * 33]); o.y = pk2(s[2 * 33], s[3 * 33]); o.z = pk2(s[4 * 33], s[5 * 33]); o.w = pk2(s[6 * 33], s[7 * 33]); }
    *(u32x4*)(dst + (size_t)n * K + 8 * c) = o; }
  LDS_WAIT();
}
__device__ __forceinline__ void tr_item8(const float* src, int ld, int cbase, const float* kscale, float gscale, int k0, unsigned char* dst, int K8, LAS float* scr, int lane) {
  f32x4 v[8];
#pragma unroll
  for (int i = 0; i < 8; ++i) v[i] = __builtin_nontemporal_load((const f32x4*)(src + (size_t)(k0 + i * 8 + (lane >> 3)) * ld + cbase + (lane & 7) * 4));
#pragma unroll
  for (int i = 0; i < 8; ++i) { const int kk = i * 8 + (lane >> 3); const float sc = kscale ? kscale[k0 + kk] : 1.f; LAS float* w = scr + kk * 33 + (lane & 7) * 4;
    w[0] = v[i].x * sc; w[1] = v[i].y * sc; w[2] = v[i].z * sc; w[3] = v[i].w * sc; }
  LDS_WAIT();
  const int c = lane & 7;
#pragma unroll
  for (int j = 0; j < 4; ++j) { const int n = (lane >> 3) + 8 * j; const LAS float* s = scr + (8 * c) * 33 + perm32(n);
    const f32x4 a = {s[0 * 33], s[1 * 33], s[2 * 33], s[3 * 33]}, b = {s[4 * 33], s[5 * 33], s[6 * 33], s[7 * 33]};
    *(u32x2*)(dst + (size_t)n * K8 + 8 * c) = pk8_fp8(a, b, gscale); }
  LDS_WAIT();
}
__device__ __forceinline__ void tr_item_s(const float* src, int ld, int col, const float* kscale, int k0, bf16_t* dst, int K, LAS float* scr, int lane) {
#pragma unroll 8
  for (int i = 0; i < 32; ++i) { const int kk = 2 * i + (lane >> 5); float v = 0.f;
    if (col >= 0) { v = src[(size_t)(k0 + kk) * ld + col]; if (kscale) v *= kscale[k0 + kk]; }
    scr[kk * 33 + (lane & 31)] = v; }
  LDS_WAIT();
  const int c = lane & 7;
#pragma unroll
  for (int j = 0; j < 4; ++j) { const int n = (lane >> 3) + 8 * j; const LAS float* s = scr + (8 * c) * 33 + n;
    u32x4 o; o.x = pk2(s[0 * 33], s[1 * 33]); o.y = pk2(s[2 * 33], s[3 * 33]); o.z = pk2(s[4 * 33], s[5 * 33]); o.w = pk2(s[6 * 33], s[7 * 33]);
    *(u32x4*)(dst + (size_t)n * K + 8 * c) = o; }
  LDS_WAIT();
}

__device__ __forceinline__ void conv_gu_item(const Params& p, int r, LAS float* scr, int lane) {
  const int e = r / 256, kb = (r % 256) / 16, nb = r % 16;
  const int pn = nb >> 3, bj = (nb >> 2) & 1;
  const float* src = (bj ? p.in[18] : p.in[17]) + (size_t)e * 1024 * 256;
#if MOE_FP8
  tr_item8(src, 256, 128 * pn + 32 * (nb & 3), p.in[12], F8_SWGU, kb * 64, p.ws + WS_WGU + ((size_t)e * 512 + nb * 32) * 1024 + kb * 64, 1024, scr, lane);
#else
  tr_item(src, 256, 128 * pn + 32 * (nb & 3), 32, true, p.in[12], kb * 64, (bf16_t*)(p.ws + WS_WGU) + ((size_t)e * 512 + nb * 32) * 1024 + kb * 64, 1024, scr, lane);
#endif
}
__device__ __forceinline__ int glog8(int nb) { return (nb & ~7) + 2 * (nb & 3) + ((nb >> 2) & 1); }
__device__ __forceinline__ void conv_d_item(const Params& p, int r, LAS float* scr, int lane) {
  const int e = r / 128, kb = (r % 128) / 32, nb = r % 32;
#if MOE_FP8
  tr_item8(p.in[19] + (size_t)e * 256 * 1024, 1024, 32 * glog8(nb), nullptr, F8_SWD, kb * 64, p.ws + WS_WD + ((size_t)e * 1024 + nb * 32) * 256 + kb * 64, 256, scr, lane);
#else
  tr_item(p.in[19] + (size_t)e * 256 * 1024, 1024, 32 * glog8(nb), 32, true, nullptr, kb * 64, (bf16_t*)(p.ws + WS_WD) + ((size_t)e * 1024 + nb * 32) * 256 + kb * 64, 256, scr, lane);
#endif
}
constexpr int CONV_GU_P0 = 2048, CONV_GU_P1 = 4096, CONV_GU_P2 = 2048;
constexpr int CONV_D_P1 = 4096;

__device__ __forceinline__ void p0_prologue(const Params& p, LAS unsigned char* lds, int G, int vb) {
  const int tid = threadIdx.x, lane = tid & 63, wave = tid >> 6;
  LAS float* scr = (LAS float*)(lds + wave * 8704);
  const int gw = vb * 8 + wave, NGW = G * 8;
  unsigned char* ws = p.ws;
  const float* attn_nw = p.in[2]; const float* w_in = p.in[3];
  const float* qnw = p.in[7]; const float* w_uq = p.in[8]; const float* kvnw = p.in[9]; const float* w_ukv = p.in[10];
  const float* w_out = p.in[11]; const float* fnw = p.in[12]; const float* rgw = p.in[13]; const float* rew = p.in[15];
  const float* ewg = p.in[17]; const float* ewu = p.in[18]; const float* ewd = p.in[19];
  constexpr int I_IN = 16 * 72, I_UQ = 6 * 24, I_UKV = 4 * 32, I_OUT = 16 * 32, I_R = 16 * 2, I_GU = 32 * 16 * 16, I_D = 32 * 4 * 32;
  const int n = lane & 31;
  const int NITEMS = I_IN + I_UQ + I_UKV + I_OUT + I_R + ((G == 256) ? CONV_GU_P0 : I_GU + I_D);
  auto xconv = [&]() {
    const float* x = p.in[0]; bf16_t* XB = (bf16_t*)(ws + WS_XB); float* rs1 = (float*)(ws + WS_RS1);
    f32x4 v[4], w[4];
    { const int m = gw, m2 = m + NGW;
      const f32x4* xr = (const f32x4*)(x + (size_t)(m < NTOK ? m : 0) * DM) + lane; const f32x4* xr2 = (const f32x4*)(x + (size_t)(m2 < NTOK ? m2 : 0) * DM) + lane;
#pragma unroll
      for (int j = 0; j < 4; ++j) { v[j] = __builtin_nontemporal_load(xr + 64 * j); w[j] = __builtin_nontemporal_load(xr2 + 64 * j); } }
#pragma unroll 1
    for (int m = gw; m < NTOK; m += 2 * NGW) {
      const int m2 = m + NGW; const bool has2 = m2 < NTOK;
      const int mn = m + 2 * NGW, mn2 = mn + NGW;
      f32x4 nv[4], nw[4];
      { const f32x4* xr = (const f32x4*)(x + (size_t)(mn < NTOK ? mn : m) * DM) + lane; const f32x4* xr2 = (const f32x4*)(x + (size_t)(mn2 < NTOK ? mn2 : m) * DM) + lane;
#pragma unroll
        for (int j = 0; j < 4; ++j) { nv[j] = __builtin_nontemporal_load(xr + 64 * j); nw[j] = __builtin_nontemporal_load(xr2 + 64 * j); } }
      float s = 0.f, s2 = 0.f;
#pragma unroll
      for (int j = 0; j < 4; ++j) { s += (v[j].x * v[j].x + v[j].y * v[j].y) + (v[j].z * v[j].z + v[j].w * v[j].w); s2 += (w[j].x * w[j].x + w[j].y * w[j].y) + (w[j].z * w[j].z + w[j].w * w[j].w); }
      s = wave_sum(s); s2 = wave_sum(s2);
      if (lane == 0) { rs1[m] = rsqrtf(s * (1.f / DM) + EPS); if (has2) rs1[m2] = rsqrtf(s2 * (1.f / DM) + EPS); }
      u32x2* o8 = (u32x2*)(XB + (size_t)m * DM) + lane; u32x2* o82 = (u32x2*)(XB + (size_t)m2 * DM) + lane;
#pragma unroll
      for (int j = 0; j < 4; ++j) { u32x2 q; q.x = pk2(v[j].x, v[j].y); q.y = pk2(v[j].z, v[j].w); o8[64 * j] = q; }
      if (has2) {
#pragma unroll
        for (int j = 0; j < 4; ++j) { u32x2 q; q.x = pk2(w[j].x, w[j].y); q.y = pk2(w[j].z, w[j].w); o82[64 * j] = q; }
      }
#pragma unroll
      for (int j = 0; j < 4; ++j) { v[j] = nv[j]; w[j] = nw[j]; }
    }
  };
  auto wconv = [&]() {
  for (int it = gw; it < NITEMS; it += NGW) {
    int r = it;
    if (r < I_IN) { const int kb = r / 72, nb = r % 72; const int c0 = inproj_src_col(32 * nb); const int nv = (nb < 69) ? 32 : (nb == 69 ? 16 : 0);
      tr_item(w_in, 2224, c0 < 0 ? 0 : c0, nv, nb != 68, attn_nw, kb * 64, (bf16_t*)(ws + WS_WIN) + (size_t)(nb * 32) * 1024 + kb * 64, 1024, scr, lane); continue; }
    r -= I_IN;
    if (r < I_UQ) { const int kb = r / 24, nb = r % 24;
      tr_item(w_uq, 768, 32 * nb, 32, (nb % 3) != 2, qnw, kb * 64, (bf16_t*)(ws + WS_WUQ) + (size_t)(nb * 32) * 384 + kb * 64, 384, scr, lane); continue; }
    r -= I_UQ;
    if (r < I_UKV) { const int kb = r / 32, nb = r % 32;
      tr_item(w_ukv, 1024, 32 * nb, 32, true, kvnw, kb * 64, (bf16_t*)(ws + WS_WUKV) + (size_t)(nb * 32) * 256 + kb * 64, 256, scr, lane); continue; }
    r -= I_UKV;
    if (r < I_OUT) { const int kb = r / 32, nb = r % 32;
      tr_item8(w_out, 1024, 32 * nb, nullptr, F8_SWO, kb * 64, ws + WS_WOUT + (size_t)(nb * 32) * 1024 + kb * 64, 1024, scr, lane); continue; }
    r -= I_OUT;
    if (r < I_R) { const int kb = r / 2, nb = r % 2; const int Rr = nb * 32 + n;
      const float* src = (Rr < 4) ? rgw : rew; const int ld = (Rr < 4) ? 4 : 32; const int col = (Rr < 4) ? Rr : (Rr < 36 ? Rr - 4 : -1);
      tr_item_s(src, ld, col, fnw, kb * 64, (bf16_t*)(ws + WS_WR) + (size_t)(nb * 32) * 1024 + kb * 64, 1024, scr, lane); continue; }
    r -= I_R;
    if (r < I_GU) { conv_gu_item(p, r, scr, lane); continue; }
    r -= I_GU;
    conv_d_item(p, r, scr, lane);
  }
  };
  if (wave & 1) { xconv(); wconv(); } else { wconv(); xconv(); }
  const int gt = vb * 512 + tid, NGT = G * 512;
  const int* pos = (const int*)p.in[1]; f32x2* CS = (f32x2*)(ws + WS_CS);
  const float inv = powf(10000.0f, -(float)(gt & 15) / 16.0f);
  for (int i = gt; i < NTOK * 16; i += NGT) {
    const int row = i >> 4;
    const float ang = (float)pos[row] * inv;
    const double rev = (double)ang * 0.15915494309189535; const float frc = (float)(rev - floor(rev));
    CS[i] = (f32x2){__builtin_amdgcn_cosf(frc), __builtin_amdgcn_sinf(frc)};
  }
  if (gt < NEXP) ((int*)(ws + WS_CNT))[gt] = 0;
  if (gt < 512) ((int*)(ws + WS_FLG))[gt] = 0;
  if (gt < 4096) { const int dd = gt >> 4, rr = gt & 15; ((bf16_t*)(ws + WS_GUT))[gt] = (bf16_t)(pk2(p.in[4][rr * 256 + dd], 0.f) & 0xffffu); }
#if !ENABLE_GLA || !ENABLE_MLA
  { u32x4* Y = (u32x4*)(ws + WS_Y); for (int i = gt; i < NTOK * 1024 / 8; i += NGT) Y[i] = (u32x4){0u, 0u, 0u, 0u}; }
#endif
}

constexpr int AT_KSTR = 208;
constexpr int AT_KBUF = 64 * AT_KSTR, AT_VBUF = 8192;
constexpr int AT_KOFF = 0, AT_VOFF = 2 * AT_KBUF;
typedef short v4i16_t __attribute__((ext_vector_type(4)));
__device__ __forceinline__ s16x4 vtr(const LAS unsigned char* p) { return __builtin_bit_cast(s16x4, __builtin_amdgcn_ds_read_tr16_b64_v4i16((LAS v4i16_t*)p)); }

template <bool DO_NEXT>
__device__ __forceinline__ void attn_step(const LAS unsigned char* Kn, const LAS unsigned char* Vc, const bf16x8 (&qf)[6], f32x16& pc0, f32x16& pc1, f32x16& pn0, f32x16& pn1,
                                          f32x16& o0, f32x16& o1, float& mrun, float& lrun, const bool first, const bool diag, const int kb, const int qabs, const int r32, const int hi, const int voffl) {
  const LAS unsigned char* Kb = Kn + r32 * AT_KSTR + hi * 16;
  bf16x8 kf[6];
#pragma unroll
  for (int d0 = 0; d0 < 3; ++d0) { kf[2 * d0] = *(const LAS bf16x8*)(Kb + d0 * 32); kf[2 * d0 + 1] = *(const LAS bf16x8*)(Kb + 32 * AT_KSTR + d0 * 32); }
  __builtin_amdgcn_sched_barrier(0);
  if (diag) {
#pragma unroll
    for (int r = 0; r < 16; ++r) { const int kv = kb + 4 * hi + (r & 3) + 8 * (r >> 2); if (kv > qabs) pc0[r] = -INFINITY; if (kv + 32 > qabs) pc1[r] = -INFINITY; }
  }
  float ma = fmaxf(fmaxf(pc0[0], pc0[1]), pc1[0]), mb = fmaxf(fmaxf(pc0[2], pc0[3]), pc1[1]);
  ma = fmaxf(fmaxf(ma, pc1[2]), pc1[3]);
#pragma unroll
  for (int r = 4; r < 16; r += 4) { ma = fmaxf(fmaxf(ma, pc0[r]), pc0[r + 1]); mb = fmaxf(fmaxf(mb, pc0[r + 2]), pc0[r + 3]); ma = fmaxf(fmaxf(ma, pc1[r]), pc1[r + 1]); mb = fmaxf(fmaxf(mb, pc1[r + 2]), pc1[r + 3]); }
  float mt = fmaxf(ma, mb);
  { auto rr = __builtin_amdgcn_permlane32_swap(__float_as_uint(mt), __float_as_uint(mt), false, false); mt = fmaxf(__uint_as_float(rr[0]), __uint_as_float(rr[1])); }
  if (first || __any(mt > 8.0f)) {
    const float dl = first ? mt : fmaxf(mt, 0.f);
    mrun += dl;
    const float alpha = __builtin_amdgcn_exp2f(-dl);
    lrun *= alpha;
#pragma unroll
    for (int r = 0; r < 16; ++r) { pc0[r] -= dl; pc1[r] -= dl; o0[r] *= alpha; o1[r] *= alpha; }
  }
  const LAS unsigned char* Vb = Vc + voffl;
  f32x16 negm;
#pragma unroll
  for (int r = 0; r < 16; ++r) negm[r] = -mrun;
  if (DO_NEXT) {
#pragma unroll
    for (int d0 = 0; d0 < 3; ++d0) {
      pn0 = __builtin_amdgcn_mfma_f32_32x32x16_bf16(kf[2 * d0], qf[d0], d0 ? pn0 : negm, 0, 0, 0);
      pn1 = __builtin_amdgcn_mfma_f32_32x32x16_bf16(kf[2 * d0 + 1], qf[d0], d0 ? pn1 : negm, 0, 0, 0);
    }
  }
  __builtin_amdgcn_sched_barrier(0);
#pragma unroll
  for (int d0 = 3; d0 < 6; ++d0) { kf[2 * (d0 - 3)] = *(const LAS bf16x8*)(Kb + d0 * 32); kf[2 * (d0 - 3) + 1] = *(const LAS bf16x8*)(Kb + 32 * AT_KSTR + d0 * 32); }
  s16x4 vl[4], vh[4];
#pragma unroll
  for (int ks = 0; ks < 2; ++ks) { vl[2 * ks] = vtr(Vb + ks * 1024); vh[2 * ks] = vtr(Vb + ks * 1024 + 512); vl[2 * ks + 1] = vtr(Vb + 4096 + ks * 1024); vh[2 * ks + 1] = vtr(Vb + 4096 + ks * 1024 + 512); }
  __builtin_amdgcn_sched_barrier(0);
#pragma unroll
  for (int r = 0; r < 16; ++r) { pc0[r] = __builtin_amdgcn_exp2f(pc0[r]); pc1[r] = __builtin_amdgcn_exp2f(pc1[r]); }
  if (DO_NEXT) {
#pragma unroll
    for (int d0 = 3; d0 < 6; ++d0) {
      pn0 = __builtin_amdgcn_mfma_f32_32x32x16_bf16(kf[2 * (d0 - 3)], qf[d0], pn0, 0, 0, 0);
      pn1 = __builtin_amdgcn_mfma_f32_32x32x16_bf16(kf[2 * (d0 - 3) + 1], qf[d0], pn1, 0, 0, 0);
    }
  }
  float sacc = pc0[0] + pc1[0];
#pragma unroll
  for (int r = 1; r < 16; ++r) { sacc += pc0[r]; sacc += pc1[r]; if ((r & 1) == 1) asm volatile("" : "+v"(sacc)); }
  lrun += sacc;
  u32x4 pw[4];
#pragma unroll
  for (int s = 0; s < 2; ++s) {
    pw[s] = (u32x4){pk2(pc0[8 * s + 0], pc0[8 * s + 1]), pk2(pc0[8 * s + 2], pc0[8 * s + 3]), pk2(pc0[8 * s + 4], pc0[8 * s + 5]), pk2(pc0[8 * s + 6], pc0[8 * s + 7])};
    pw[2 + s] = (u32x4){pk2(pc1[8 * s + 0], pc1[8 * s + 1]), pk2(pc1[8 * s + 2], pc1[8 * s + 3]), pk2(pc1[8 * s + 4], pc1[8 * s + 5]), pk2(pc1[8 * s + 6], pc1[8 * s + 7])};
  }
  s16x4 wl[4], wh[4];
#pragma unroll
  for (int ks = 2; ks < 4; ++ks) { wl[2 * (ks - 2)] = vtr(Vb + ks * 1024); wh[2 * (ks - 2)] = vtr(Vb + ks * 1024 + 512); wl[2 * (ks - 2) + 1] = vtr(Vb + 4096 + ks * 1024); wh[2 * (ks - 2) + 1] = vtr(Vb + 4096 + ks * 1024 + 512); }
  __builtin_amdgcn_sched_barrier(0);
#pragma unroll
  for (int ks = 0; ks < 2; ++ks) {
    const bf16x8 vf0 = {vl[2 * ks][0], vl[2 * ks][1], vl[2 * ks][2], vl[2 * ks][3], vh[2 * ks][0], vh[2 * ks][1], vh[2 * ks][2], vh[2 * ks][3]};
    const bf16x8 vf1 = {vl[2 * ks + 1][0], vl[2 * ks + 1][1], vl[2 * ks + 1][2], vl[2 * ks + 1][3], vh[2 * ks + 1][0], vh[2 * ks + 1][1], vh[2 * ks + 1][2], vh[2 * ks + 1][3]};
    const bf16x8 pf = __builtin_bit_cast(bf16x8, pw[ks]);
    o0 = __builtin_amdgcn_mfma_f32_32x32x16_bf16(vf0, pf, o0, 0, 0, 0);
    o1 = __builtin_amdgcn_mfma_f32_32x32x16_bf16(vf1, pf, o1, 0, 0, 0);
  }
#pragma unroll
  for (int ks = 2; ks < 4; ++ks) { const int q = 2 * (ks - 2);
    const bf16x8 vf0 = {wl[q][0], wl[q][1], wl[q][2], wl[q][3], wh[q][0], wh[q][1], wh[q][2], wh[q][3]};
    const bf16x8 vf1 = {wl[q + 1][0], wl[q + 1][1], wl[q + 1][2], wl[q + 1][3], wh[q + 1][0], wh[q + 1][1], wh[q + 1][2], wh[q + 1][3]};
    const bf16x8 pf = __builtin_bit_cast(bf16x8, pw[ks]);
    o0 = __builtin_amdgcn_mfma_f32_32x32x16_bf16(vf0, pf, o0, 0, 0, 0);
    o1 = __builtin_amdgcn_mfma_f32_32x32x16_bf16(vf1, pf, o1, 0, 0, 0);
  }
}
__device__ __forceinline__ void attn_qk0(const LAS unsigned char* Kt, const bf16x8 (&qf)[6], f32x16& p0, f32x16& p1, const int r32, const int hi) {
  const LAS unsigned char* Kb = Kt + r32 * AT_KSTR + hi * 16;
  const f32x16 z = {};
#pragma unroll
  for (int d0 = 0; d0 < 6; ++d0) {
    const bf16x8 a0 = *(const LAS bf16x8*)(Kb + d0 * 32), a1 = *(const LAS bf16x8*)(Kb + 32 * AT_KSTR + d0 * 32);
    p0 = __builtin_amdgcn_mfma_f32_32x32x16_bf16(a0, qf[d0], d0 ? p0 : z, 0, 0, 0);
    p1 = __builtin_amdgcn_mfma_f32_32x32x16_bf16(a1, qf[d0], d0 ? p1 : z, 0, 0, 0);
  }
}

template <int MODE>
__device__ __forceinline__ void attn_unit(const Params& p, LAS unsigned char* lds, int b, int h, int qb) {
  int tid_ = threadIdx.x; asm volatile("" : "+v"(tid_));
  const int tid = tid_, lane = tid & 63, r32 = lane & 31, hi = lane >> 5; const int wid = __builtin_amdgcn_readfirstlane(tid >> 6);
  const bf16_t* QB = (const bf16_t*)(p.ws + WS_QB); const bf16_t* KVB = (const bf16_t*)(p.ws + WS_KVB); const bf16_t* PROJ = (const bf16_t*)(p.ws + WS_PROJ);
  bf16_t* Y = (bf16_t*)(p.ws + WS_Y);
  const size_t rowbase = (size_t)b * SEQ; const int q0 = qb * 256;
  bf16x8 qf[6];
  { const bf16_t* qrow = QB + (rowbase + q0 + wid * 32 + r32) * 768 + h * 96 + hi * 8;
#pragma unroll
    for (int d0 = 0; d0 < 6; ++d0) qf[d0] = *(const bf16x8*)(qrow + d0 * 16); }
  f32x16 o0 = {}, o1 = {}; float mrun = 0.f, lrun = 0.f;
  const int NT = 4 * (qb + 1);
  const int id0 = tid, id1 = (tid < 256) ? tid + 512 : tid;
  const int kv0 = id0 / 12, c0 = id0 % 12, kv1 = id1 / 12, c1 = id1 % 12;
  const bf16_t* ks0 = (c0 < 8) ? KVB + (rowbase + kv0) * 1024 + h * 128 + c0 * 8 : PROJ + (rowbase + kv0) * NP + KR_OFF + (c0 - 8) * 8;
  const size_t kstr0 = (c0 < 8) ? (size_t)64 * 1024 : (size_t)64 * NP;
  const bf16_t* ks1 = (c1 < 8) ? KVB + (rowbase + kv1) * 1024 + h * 128 + c1 * 8 : PROJ + (rowbase + kv1) * NP + KR_OFF + (c1 - 8) * 8;
  const size_t kstr1 = (c1 < 8) ? (size_t)64 * 1024 : (size_t)64 * NP;
  const int kd0 = kv0 * AT_KSTR + c0 * 16, kd1 = kv1 * AT_KSTR + c1 * 16;
  const int vkv = tid >> 3, vc = tid & 7;
  const bf16_t* vs = KVB + (rowbase + vkv) * 1024 + h * 128 + 64 + vc * 8;
  const int vd = (vc >> 2) * 4096 + vkv * 64 + (vc & 3) * 16;
  u32x4 kA0 = {}, kA1 = {}, vA = {}, kB0 = {}, kB1 = {}, vB = {};
#define AT_LOADK(K0, K1, u) do { if (MODE == 2) break; const int u_ = (MODE == 1) ? 0 : ((u) < NT ? (u) : NT - 1); K0 = *(const u32x4*)(ks0 + (size_t)u_ * kstr0); K1 = *(const u32x4*)(ks1 + (size_t)u_ * kstr1); } while (0)
#define AT_LOADV(V, u) do { if (MODE == 2) break; const int u_ = (MODE == 1) ? 0 : ((u) < NT ? (u) : NT - 1); V = *(const u32x4*)(vs + (size_t)u_ * 64 * 1024); } while (0)
#define AT_STOREK(K0, K1, buf) do { *(LAS u32x4*)(lds + AT_KOFF + (buf) * AT_KBUF + kd0) = K0; *(LAS u32x4*)(lds + AT_KOFF + (buf) * AT_KBUF + kd1) = K1; } while (0)
#define AT_STOREV(V, buf) do { *(LAS u32x4*)(lds + AT_VOFF + (buf) * AT_VBUF + vd) = V; } while (0)
  AT_LOADK(kA0, kA1, 0); AT_LOADV(vA, 0); AT_LOADK(kB0, kB1, 1);
  AT_STOREK(kA0, kA1, 0); AT_STOREV(vA, 0); AT_STOREK(kB0, kB1, 1);
  AT_LOADK(kA0, kA1, 2); AT_LOADV(vB, 1); AT_LOADK(kB0, kB1, 3); AT_LOADV(vA, 2);
  LBAR();
  const int qabs = q0 + wid * 32 + r32;
  const int voffl = ((lane >> 4) & 1) * 32 + (lane & 3) * 8 + (4 * hi + ((lane & 15) >> 2)) * 64;
  const int wlast = q0 + wid * 32 + 31;
  f32x16 pa0, pa1, pb0, pb1;
  if (wid >= 4) __builtin_amdgcn_s_setprio(1);
  attn_qk0(lds + AT_KOFF, qf, pa0, pa1, r32, hi);
  LBAR();
#pragma unroll 1
  for (int t = 0; t < NT; t += 2) {
    if (MODE != 3 && t * 64 <= wlast) {
      attn_step<true>(lds + AT_KOFF + AT_KBUF, lds + AT_VOFF, qf, pa0, pa1, pb0, pb1, o0, o1, mrun, lrun, t == 0, t >= NT - 4, t * 64, qabs, r32, hi, voffl);
    }
    AT_STOREK(kA0, kA1, 0); AT_STOREV(vB, 1);
    AT_LOADK(kA0, kA1, t + 4); AT_LOADV(vB, t + 3);
    LBAR();
    if (MODE != 3 && (t + 1) * 64 <= wlast) {
      attn_step<true>(lds + AT_KOFF, lds + AT_VOFF + AT_VBUF, qf, pb0, pb1, pa0, pa1, o0, o1, mrun, lrun, false, t + 1 >= NT - 4, (t + 1) * 64, qabs, r32, hi, voffl);
    }
    AT_STOREK(kB0, kB1, 1); AT_STOREV(vA, 0);
    AT_LOADK(kB0, kB1, t + 5); AT_LOADV(vA, t + 4);
    LBAR();
  }
#undef AT_LOADK
#undef AT_LOADV
#undef AT_STOREK
#undef AT_STOREV
  __builtin_amdgcn_s_setprio(0);
  lrun += __shfl_xor(lrun, 32);
  const float inv = __builtin_amdgcn_rcpf(lrun) * F8_SY;
  unsigned char* dst = (unsigned char*)(p.ws + WS_Y) + (rowbase + q0 + wid * 32 + r32) * 1024 + 512 + h * 64 + 8 * hi;
#pragma unroll
  for (int half = 0; half < 2; ++half)
#pragma unroll
    for (int t = 0; t < 2; ++t) {
      const f32x16& o = half ? o1 : o0;
      unsigned pc[2];
#pragma unroll
      for (int e = 0; e < 2; ++e) { const int g = 2 * t + e;
        pc[e] = pk4_fp8(o[4 * g] * inv, o[4 * g + 1] * inv, o[4 * g + 2] * inv, o[4 * g + 3] * inv); }
      const unsigned snd = hi ? pc[0] : pc[1];
      auto rr = __builtin_amdgcn_permlane32_swap(snd, snd, false, false); const unsigned oth = hi ? rr[0] : rr[1];
      u32x2 w8; if (hi) { w8.x = oth; w8.y = pc[1]; } else { w8.x = pc[0]; w8.y = oth; }
      if (MODE == 0 || w8.x == 0x12345679u) *(u32x2*)(dst + 32 * half + 16 * t) = w8;
    }
}

template <int MODE>
__device__ __forceinline__ void attn_phase(const Params& p, LAS unsigned char* lds, int G, int vb) {
  if (G == 256) {
    const int bh = vb >> 2, s = vb & 3;
#pragma unroll 1
    for (int i = 0; i < 4; ++i) { const int qb = (i == 0) ? 15 - s : (i == 1) ? 8 + s : (i == 2) ? 7 - s : s; attn_unit<MODE>(p, lds, bh >> 3, bh & 7, qb); }
  } else {
#pragma unroll 1
    for (int u = vb; u < 1024; u += G) { const int qb = 15 - (u >> 6), bh = u & 63; attn_unit<MODE>(p, lds, bh >> 3, bh & 7, qb); }
  }
}

constexpr int GL_BC = 0;
constexpr int GL_QE = 17408;
constexpr int GL_KE = 26624;
constexpr int GL_KD = 35840;
constexpr int GL_V = 44032;
constexpr int GL_ST = 60416;
constexpr int GL_RED = 78848;
constexpr int GL_TOT = 80896;
__device__ __forceinline__ int crow(int r, int hi) { return (r & 3) + 8 * (r >> 2) + 4 * hi; }
#define GLA_RI(v_) ((G == 256) ? ((((4 * (((v_) & 255) >> 5) + (((v_) >> 8) >> 1)) << 6) + 2 * ((v_) & 31) + (((v_) >> 8) & 1))) : (v_))

__device__ __forceinline__ void gla_gates_mfma(const bf16x8 lrA, const bf16x8 guB, const float bias_d, LAS float* bc, LAS float* tot0, int dt, int jt, int r32, int hi) {
  const f32x16 zero = {};
  const f32x16 z = __builtin_amdgcn_mfma_f32_32x32x16_bf16(lrA, guB, zero, 0, 0, 0);
  float la[16];
#pragma unroll
  for (int r = 0; r < 16; ++r) { const float zz = z[r] + bias_d; la[r] = (fminf(zz, 0.f) - __logf(1.f + __expf(-fabsf(zz)))) * (1.f / 16.f); }
  float s[4], o[4];
#pragma unroll
  for (int g = 0; g < 4; ++g) { la[4 * g + 1] += la[4 * g]; la[4 * g + 2] += la[4 * g + 1]; la[4 * g + 3] += la[4 * g + 2]; s[g] = la[4 * g + 3]; }
#pragma unroll
  for (int g = 0; g < 4; ++g) { auto rr = __builtin_amdgcn_permlane32_swap(__float_as_uint(s[g]), __float_as_uint(s[g]), false, false); o[g] = __uint_as_float(hi ? rr[0] : rr[1]); }
  float off = 0.f;
#pragma unroll
  for (int g = 0; g < 4; ++g) { const float add = off + (hi ? o[g] : 0.f);
#pragma unroll
    for (int q = 0; q < 4; ++q) la[4 * g + q] += add;
    off += s[g] + o[g]; }
#pragma unroll
  for (int r = 0; r < 16; ++r) bc[(32 * jt + crow(r, hi)) * 68 + 32 * dt + r32] = la[r];
  if (jt == 0 && hi == 0) tot0[32 * dt + r32] = off;
}

__device__ __forceinline__ bf16x8 trfrag(const LAS unsigned char* p, int off_lo, int off_hi) {
  const s16x4 l = vtr(p + off_lo), h = vtr(p + off_hi);
  return (bf16x8){l[0], l[1], l[2], l[3], h[0], h[1], h[2], h[3]};
}

__device__ __forceinline__ void gla_a_phase(const Params& p, LAS unsigned char* lds, int G, int vb) {
  const int tid = threadIdx.x, lane = tid & 63, r32 = lane & 31, hi = lane >> 5; const int wid = __builtin_amdgcn_readfirstlane(tid >> 6);
  const bf16_t* PROJ = (const bf16_t*)(p.ws + WS_PROJ); const bf16_t* GUT = (const bf16_t*)(p.ws + WS_GUT);
  bf16_t* UPD = (bf16_t*)(p.ws + WS_Y); float* DEC = (float*)(p.ws + WS_DEC); const float* gbias = p.in[5];
  LAS float* bc = (LAS float*)(lds + GL_BC);
  const int j = tid >> 3, c = tid & 7;
  u32x4 kqA, v0A, v1A, lrA = {}, guA = {}, kqB, v0B, v1B, lrB = {}, guB = {}; float gbA = 0.f, gbB = 0.f;
  LAS float* tot0 = (LAS float*)(lds + GL_TOT);
#define GLA_A_LOAD(item_, KQ, V0, V1, LR, GU, GB) do { const int ri_ = GLA_RI(item_); const int n_ = ri_ & 63, bh_ = ri_ >> 6, h_ = bh_ & 3, b_ = bh_ >> 2; const size_t r0_ = (size_t)b_ * SEQ + n_ * 64; \
    if (wid < 4) { LR = *(const u32x4*)(PROJ + (r0_ + 32 * (wid >> 1) + r32) * NP + LR_OFF + 8 * hi); \
      GU = *(const u32x4*)(GUT + (h_ * 64 + 32 * (wid & 1) + r32) * 16 + 8 * hi); GB = gbias[h_ * 64 + 32 * (wid & 1) + r32]; } \
    KQ = __builtin_nontemporal_load((const u32x4*)(PROJ + (r0_ + j) * NP + K_OFF + h_ * 64 + c * 8)); \
    V0 = __builtin_nontemporal_load((const u32x4*)(PROJ + (r0_ + (tid >> 4)) * NP + V_OFF + h_ * 128 + (tid & 15) * 8)); \
    V1 = __builtin_nontemporal_load((const u32x4*)(PROJ + (r0_ + 32 + (tid >> 4)) * NP + V_OFF + h_ * 128 + (tid & 15) * 8)); } while (0)
#define GLA_A_BODY(item_, KQ, V0, V1, LR, GU, GB) do { \
    if (wid < 4) gla_gates_mfma(__builtin_bit_cast(bf16x8, LR), __builtin_bit_cast(bf16x8, GU), GB, bc, tot0, wid & 1, wid >> 1, r32, hi); \
    LBAR();                                     \
    { \
      const unsigned kk[4] = {KQ.x, KQ.y, KQ.z, KQ.w}; float kd[8]; \
      _Pragma("unroll") \
      for (int i = 0; i < 8; ++i) { const int d = c * 8 + i; const float kv = (i & 1) ? bfhi(kk[i >> 1]) : bflo(kk[i >> 1]); const float t0 = tot0[d]; \
        kd[i] = kv * __expf((bc[63 * 68 + d] + t0) - (bc[j * 68 + d] + (j >= 32 ? t0 : 0.f))); } \
      *(LAS u32x4*)(lds + GL_KD + (c >> 2) * 4096 + j * 64 + (c & 3) * 16) = (u32x4){pk2(kd[0], kd[1]), pk2(kd[2], kd[3]), pk2(kd[4], kd[5]), pk2(kd[6], kd[7])}; \
      const int jj = tid >> 4, cc = tid & 15; \
      *(LAS u32x4*)(lds + GL_V + (cc >> 2) * 4096 + jj * 64 + (cc & 3) * 16) = V0; \
      *(LAS u32x4*)(lds + GL_V + (cc >> 2) * 4096 + (32 + jj) * 64 + (cc & 3) * 16) = V1; \
      if (tid < 64) DEC[(size_t)GLA_RI(item_) * 64 + tid] = __expf(bc[63 * 68 + tid] + tot0[tid]); \
    } \
    if ((item_) + 2 * G < 2048) GLA_A_LOAD((item_) + 2 * G, KQ, V0, V1, LR, GU, GB);           \
    LBAR(); \
    { const int vt = wid >> 1, dt = wid & 1; f32x16 acc = {}; \
      const int lo = ((lane >> 4) & 1) * 32 + (lane & 3) * 8 + (8 * hi + ((lane & 15) >> 2)) * 64; \
      _Pragma("unroll") \
      for (int ks = 0; ks < 4; ++ks) { \
        const bf16x8 a = trfrag(lds + GL_V + vt * 4096, lo + ks * 1024, lo + ks * 1024 + 256); \
        const bf16x8 bb = trfrag(lds + GL_KD + dt * 4096, lo + ks * 1024, lo + ks * 1024 + 256); \
        acc = __builtin_amdgcn_mfma_f32_32x32x16_bf16(a, bb, acc, 0, 0, 0); \
      } \
      bf16_t* dst = UPD + (size_t)GLA_RI(item_) * 8192 + 32 * dt + r32; \
      _Pragma("unroll") \
      for (int r = 0; r < 16; ++r) dst[(size_t)(32 * vt + crow(r, hi)) * 64] = (bf16_t)(pk2(acc[r], 0.f) & 0xffffu); \
    } } while (0)
  int item = vb;
  if (item < 2048) GLA_A_LOAD(item, kqA, v0A, v1A, lrA, guA, gbA);
  if (item + G < 2048) GLA_A_LOAD(item + G, kqB, v0B, v1B, lrB, guB, gbB);
#pragma unroll 1
  for (; item < 2048; item += 2 * G) {
    GLA_A_BODY(item, kqA, v0A, v1A, lrA, guA, gbA);
    if (item + G < 2048) GLA_A_BODY(item + G, kqB, v0B, v1B, lrB, guB, gbB);
  }
  LBAR();
#undef GLA_A_LOAD
#undef GLA_A_BODY
}

__device__ __forceinline__ void gla_scan(const Params& p, int G, int vb) {
  const bf16_t* UPD = (const bf16_t*)(p.ws + WS_Y); const float* DEC = (const float*)(p.ws + WS_DEC); bf16_t* SPT = (bf16_t*)(p.ws + WS_SPT);
  for (int idx = vb * 512 + threadIdx.x; idx < 32 * 4096; idx += G * 512) {
    const int bh = idx >> 12, vd = (idx & 4095) * 2, d = vd & 63;
    float S0 = 0.f, S1 = 0.f;
#pragma unroll 16
    for (int n = 0; n < 64; ++n) { const size_t item = (size_t)bh * 64 + n;
      const unsigned uw = *(const unsigned*)(UPD + item * 8192 + vd); const f32x2 dc = *(const f32x2*)(DEC + item * 64 + d);
      *(unsigned*)(SPT + item * 8192 + vd) = pk2(S0, S1); S0 = dc.x * S0 + bflo(uw); S1 = dc.y * S1 + bfhi(uw); }
  }
}

__device__ __forceinline__ void gla_scan_block(const Params& p, LAS unsigned char* lds, int bh) {
  const bf16_t* UPD = (const bf16_t*)(p.ws + WS_Y); const float* DEC = (const float*)(p.ws + WS_DEC); bf16_t* SPT = (bf16_t*)(p.ws + WS_SPT);
  const int tid = threadIdx.x, d8 = tid & 7;
  LAS float* dl = (LAS float*)lds;
  for (int i = tid; i < 1024; i += 512) *(LAS f32x4*)(dl + 4 * i) = *(const f32x4*)(DEC + (size_t)bh * 4096 + 4 * i);
  __syncthreads();
  const size_t base = (size_t)bh * 64 * 8192 + (size_t)tid * 8;
  f32x4 S[4] = {};
#pragma unroll 1
  for (int n0 = 0; n0 < 64; n0 += 8) {
    u32x4 u[8][2];
#pragma unroll
    for (int k = 0; k < 8; ++k) { u[k][0] = __builtin_nontemporal_load((const u32x4*)(UPD + base + (size_t)(n0 + k) * 8192)); u[k][1] = __builtin_nontemporal_load((const u32x4*)(UPD + base + (size_t)(n0 + k) * 8192 + 4096)); }
#pragma unroll
    for (int k = 0; k < 8; ++k) {
      const f32x4 da = *(LAS f32x4*)(dl + (n0 + k) * 64 + d8 * 8), db = *(LAS f32x4*)(dl + (n0 + k) * 64 + d8 * 8 + 4);
      *(u32x4*)(SPT + base + (size_t)(n0 + k) * 8192) = pack8(S[0], S[1]);
      *(u32x4*)(SPT + base + (size_t)(n0 + k) * 8192 + 4096) = pack8(S[2], S[3]);
#pragma unroll
      for (int r = 0; r < 2; ++r) { const u32x4 w = u[k][r];
        S[2 * r][0] = da[0] * S[2 * r][0] + bflo(w.x); S[2 * r][1] = da[1] * S[2 * r][1] + bfhi(w.x);
        S[2 * r][2] = da[2] * S[2 * r][2] + bflo(w.y); S[2 * r][3] = da[3] * S[2 * r][3] + bfhi(w.y);
        S[2 * r + 1][0] = db[0] * S[2 * r + 1][0] + bflo(w.z); S[2 * r + 1][1] = db[1] * S[2 * r + 1][1] + bfhi(w.z);
        S[2 * r + 1][2] = db[2] * S[2 * r + 1][2] + bflo(w.w); S[2 * r + 1][3] = db[3] * S[2 * r + 1][3] + bfhi(w.w); }
    }
  }
  __syncthreads();
}

template <int MODE>
__device__ __forceinline__ void gla_c_phase(const Params& p, LAS unsigned char* lds, int G, int vb, int k0, int k1) {
  int tid_ = threadIdx.x; asm volatile("" : "+v"(tid_));
  const int tid = tid_, lane = tid & 63, r32 = lane & 31, hi = lane >> 5; const int wid = __builtin_amdgcn_readfirstlane(tid >> 6);
  const bf16_t* PROJ = (const bf16_t*)(p.ws + WS_PROJ); const bf16_t* GUT = (const bf16_t*)(p.ws + WS_GUT); const bf16_t* SPT = (const bf16_t*)(p.ws + WS_SPT);
  bf16_t* Y = (bf16_t*)(p.ws + WS_Y); const float* gbias = p.in[5]; const float* gnw = p.in[6];
  LAS float* bc = (LAS float*)(lds + GL_BC); LAS bf16_t* QE = (LAS bf16_t*)(lds + GL_QE); LAS bf16_t* KE = (LAS bf16_t*)(lds + GL_KE); LAS bf16_t* ST = (LAS bf16_t*)(lds + GL_ST);
  LAS float* red = (LAS float*)(lds + GL_RED);
  const int j = tid >> 3, c = tid & 7;
  const int it = wid & 1, vt = wid >> 1;
  u32x4 qq, kq, v0, v1, s0, s1, lr0 = {}, gub = {}; float gbs = 0.f; u32x2 og[4];
  LAS float* tot0 = (LAS float*)(lds + GL_TOT);
#define GLA_C_LOAD(item_) do { const int ri_ = GLA_RI(item_); const int n_ = ri_ & 63, bh_ = ri_ >> 6, h_ = bh_ & 3, b_ = bh_ >> 2; const size_t r0_ = (size_t)b_ * SEQ + n_ * 64; \
    if (wid < 4) { lr0 = *(const u32x4*)(PROJ + (r0_ + 32 * (wid >> 1) + r32) * NP + LR_OFF + 8 * hi); \
      gub = *(const u32x4*)(GUT + (h_ * 64 + 32 * (wid & 1) + r32) * 16 + 8 * hi); gbs = gbias[h_ * 64 + 32 * (wid & 1) + r32]; } \
    qq = *(const u32x4*)(PROJ + (r0_ + j) * NP + Q_OFF + h_ * 64 + c * 8); \
    kq = *(const u32x4*)(PROJ + (r0_ + j) * NP + K_OFF + h_ * 64 + c * 8); \
    v0 = *(const u32x4*)(PROJ + (r0_ + (tid >> 4)) * NP + V_OFF + h_ * 128 + (tid & 15) * 8); \
    v1 = *(const u32x4*)(PROJ + (r0_ + 32 + (tid >> 4)) * NP + V_OFF + h_ * 128 + (tid & 15) * 8); \
    s0 = *(const u32x4*)(SPT + (size_t)ri_ * 8192 + (size_t)tid * 8); s1 = *(const u32x4*)(SPT + (size_t)ri_ * 8192 + 4096 + (size_t)tid * 8); \
    _Pragma("unroll") for (int g_ = 0; g_ < 4; ++g_) og[g_] = *(const u32x2*)(PROJ + (r0_ + 32 * it + r32) * NP + OG_OFF + h_ * 128 + 32 * vt + 8 * g_ + 4 * hi); } while (0)
  f32x4 nwr[4];
  { const float* gnw_l = gnw; asm volatile("" : "+v"(gnw_l));
#pragma unroll
  for (int g = 0; g < 4; ++g) nwr[g] = *(const f32x4*)(gnw_l + 32 * vt + 8 * g + 4 * hi); }
  int item = vb + k0 * G; const int iend = vb + (k1 < 64 ? k1 : 64) * G;
  if (item < iend && item < 2048) GLA_C_LOAD(item);
#define GLA_C_LOAD_NEXT(it_) do { if (MODE != 2) GLA_C_LOAD(it_); } while (0)
#pragma unroll 1
  for (; item < iend && item < 2048; item += G) {
    const int ri = GLA_RI(item); const int n = ri & 63, bh = ri >> 6, h = bh & 3, b = bh >> 2; const size_t r0 = (size_t)b * SEQ + n * 64;
    if (wid < 4) gla_gates_mfma(__builtin_bit_cast(bf16x8, lr0), __builtin_bit_cast(bf16x8, gub), gbs, bc, tot0, wid & 1, wid >> 1, r32, hi);
    LBAR();
    {
      const unsigned q4[4] = {qq.x, qq.y, qq.z, qq.w}, k4[4] = {kq.x, kq.y, kq.z, kq.w}; float qv[8], kv[8];
#pragma unroll
      for (int i = 0; i < 8; ++i) { const float bb = bc[j * 68 + c * 8 + i] + (j >= 32 ? tot0[c * 8 + i] : 0.f);
        qv[i] = ((i & 1) ? bfhi(q4[i >> 1]) : bflo(q4[i >> 1])) * 0.125f * __expf(bb);
        kv[i] = ((i & 1) ? bfhi(k4[i >> 1]) : bflo(k4[i >> 1])) * __expf(-bb); }
      *(LAS u32x4*)(QE + j * 72 + c * 8) = (u32x4){pk2(qv[0], qv[1]), pk2(qv[2], qv[3]), pk2(qv[4], qv[5]), pk2(qv[6], qv[7])};
      *(LAS u32x4*)(KE + j * 72 + c * 8) = (u32x4){pk2(kv[0], kv[1]), pk2(kv[2], kv[3]), pk2(kv[4], kv[5]), pk2(kv[6], kv[7])};
      const int jj = tid >> 4, cc = tid & 15;
      *(LAS u32x4*)(lds + GL_V + (cc >> 2) * 4096 + jj * 64 + (cc & 3) * 16) = v0;
      *(LAS u32x4*)(lds + GL_V + (cc >> 2) * 4096 + (32 + jj) * 64 + (cc & 3) * 16) = v1;
      *(LAS u32x4*)(ST + (tid >> 3) * 72 + (tid & 7) * 8) = s0;
      *(LAS u32x4*)(ST + (64 + (tid >> 3)) * 72 + (tid & 7) * 8) = s1;
    }
    u32x2 ogc[4];
#pragma unroll
    for (int g = 0; g < 4; ++g) ogc[g] = og[g];
    if (item + G < iend && item + G < 2048) GLA_C_LOAD_NEXT(item + G);
    LBAR();
    f32x16 acc = {};
    {
      bf16x8 qf[4];
#pragma unroll
      for (int ks = 0; ks < 4; ++ks) qf[ks] = *(const LAS bf16x8*)(QE + (32 * it + r32) * 72 + 16 * ks + 8 * hi);
      const int i_abs = 32 * it + r32;
      const int lo = ((lane >> 4) & 1) * 32 + (lane & 3) * 8 + (4 * hi + ((lane & 15) >> 2)) * 64;
#pragma unroll
      for (int jt = 0; jt < 2; ++jt) {
        if (jt <= it) {
          f32x16 at = {};
#pragma unroll
          for (int ks = 0; ks < 4; ++ks) {
            const bf16x8 a = *(const LAS bf16x8*)(KE + (32 * jt + r32) * 72 + 16 * ks + 8 * hi);
            at = __builtin_amdgcn_mfma_f32_32x32x16_bf16(a, qf[ks], at, 0, 0, 0);
          }
#pragma unroll
          for (int r = 0; r < 16; ++r) if (32 * jt + crow(r, hi) > i_abs) at[r] = 0.f;
#pragma unroll
          for (int s = 0; s < 2; ++s) {
            const u32x4 pw = (u32x4){pk2(at[8 * s + 0], at[8 * s + 1]), pk2(at[8 * s + 2], at[8 * s + 3]), pk2(at[8 * s + 4], at[8 * s + 5]), pk2(at[8 * s + 6], at[8 * s + 7])};
            const int ks = 2 * jt + s;
            const bf16x8 vf = trfrag(lds + GL_V + vt * 4096, lo + ks * 1024, lo + ks * 1024 + 512);
            acc = __builtin_amdgcn_mfma_f32_32x32x16_bf16(vf, __builtin_bit_cast(bf16x8, pw), acc, 0, 0, 0);
          }
        }
      }
#pragma unroll
      for (int ks = 0; ks < 4; ++ks) {
        const bf16x8 a = *(const LAS bf16x8*)(ST + (32 * vt + r32) * 72 + 16 * ks + 8 * hi);
        acc = __builtin_amdgcn_mfma_f32_32x32x16_bf16(a, qf[ks], acc, 0, 0, 0);
      }
    }
    float sq = 0.f;
#pragma unroll
    for (int r = 0; r < 16; ++r) sq += acc[r] * acc[r];
    red[(32 * it + r32) * 8 + vt * 2 + hi] = sq;
    LBAR();
    {
      const LAS f32x4* rr = (const LAS f32x4*)(red + (32 * it + r32) * 8);
      const f32x4 ra = rr[0], rb = rr[1];
      const float tot = ((ra[0] + ra[1]) + (ra[2] + ra[3])) + ((rb[0] + rb[1]) + (rb[2] + rb[3]));
      const float rinv = rsqrtf(tot * (1.f / 128.f) + EPS);
      unsigned char* dst = (unsigned char*)Y + (r0 + 32 * it + r32) * 1024 + h * 128 + 32 * vt + 8 * hi;
      unsigned pc[4];
#pragma unroll
      for (int g = 0; g < 4; ++g) {
        const f32x4 nw = nwr[g];
        const float o0 = bflo(ogc[g].x), o1 = bfhi(ogc[g].x), o2 = bflo(ogc[g].y), o3 = bfhi(ogc[g].y);
        const float y0 = acc[4 * g + 0] * rinv * nw[0] * (o0 * __builtin_amdgcn_rcpf(1.f + __expf(-o0)));
        const float y1 = acc[4 * g + 1] * rinv * nw[1] * (o1 * __builtin_amdgcn_rcpf(1.f + __expf(-o1)));
        const float y2 = acc[4 * g + 2] * rinv * nw[2] * (o2 * __builtin_amdgcn_rcpf(1.f + __expf(-o2)));
        const float y3 = acc[4 * g + 3] * rinv * nw[3] * (o3 * __builtin_amdgcn_rcpf(1.f + __expf(-o3)));
        pc[g] = pk4_fp8(y0 * F8_SY, y1 * F8_SY, y2 * F8_SY, y3 * F8_SY);
      }
#pragma unroll
      for (int t = 0; t < 2; ++t) {
        const unsigned snd = hi ? pc[2 * t] : pc[2 * t + 1];
        auto rr = __builtin_amdgcn_permlane32_swap(snd, snd, false, false); const unsigned oth = hi ? rr[0] : rr[1];
        u32x2 w8; if (hi) { w8.x = oth; w8.y = pc[2 * t + 1]; } else { w8.x = pc[2 * t]; w8.y = oth; }
        if (MODE == 0 || w8.x == 0x12345679u) *(u32x2*)(dst + 16 * t) = w8;
      }
    }
  }
  LBAR();
#undef GLA_C_LOAD
}

constexpr int RT_LG = 0;
constexpr int RT_HIST = 8 * 16 * 49 * 4;
constexpr int RT_BASE = RT_HIST + 128;
__device__ __forceinline__ void router_phase(const Params& p, LAS unsigned char* lds, int G, int vb) {
  const int tid = threadIdx.x, lane = tid & 63, wave = tid >> 6;
  const bf16_t* HB = (const bf16_t*)(p.ws + WS_XB); const bf16_t* WrT = (const bf16_t*)(p.ws + WS_WR);
  float* RS2 = (float*)(p.ws + WS_RS2); int* cnt = (int*)(p.ws + WS_CNT); int* LTOK = (int*)(p.ws + WS_LTOK); float* LGATE = (float*)(p.ws + WS_LGATE);
  const float* gbias = p.in[14]; const float* ebias = p.in[16];
  LAS float* lg = (LAS float*)(lds + RT_LG) + wave * 16 * 49; LAS int* hist = (LAS int*)(lds + RT_HIST); LAS int* basee = (LAS int*)(lds + RT_BASE);
  for (int base = vb * 8; base < NTOK / 16; base += G * 8) {
    if (tid < 32) hist[tid] = 0;
    const int r0 = (base + wave) * 16;
    f32x4 acc[3] = {{0.f, 0.f, 0.f, 0.f}, {0.f, 0.f, 0.f, 0.f}, {0.f, 0.f, 0.f, 0.f}};
    const bf16_t* arow = HB + (size_t)(r0 + (lane & 15)) * 1024 + (lane >> 4) * 8;
    const bf16_t* brow = WrT + (size_t)(lane & 15) * 1024 + (lane >> 4) * 8;
    float hsq = 0.f;
#pragma unroll 8
    for (int kk = 0; kk < 32; ++kk) {
      const bf16x8 a = *(const bf16x8*)(arow + kk * 32);
      { const u32x4 aw = __builtin_bit_cast(u32x4, a); const float e0 = bflo(aw.x), e1 = bfhi(aw.x), e2 = bflo(aw.y), e3 = bfhi(aw.y), e4 = bflo(aw.z), e5 = bfhi(aw.z), e6 = bflo(aw.w), e7 = bfhi(aw.w);
        hsq += ((e0 * e0 + e1 * e1) + (e2 * e2 + e3 * e3)) + ((e4 * e4 + e5 * e5) + (e6 * e6 + e7 * e7)); }
#pragma unroll
      for (int n = 0; n < 3; ++n) { const bf16x8 bb = *(const bf16x8*)(brow + (size_t)n * 16 * 1024 + kk * 32); acc[n] = __builtin_amdgcn_mfma_f32_16x16x32_bf16(a, bb, acc[n], 0, 0, 0); }
    }
    hsq += __shfl_xor(hsq, 16); hsq += __shfl_xor(hsq, 32);
#pragma unroll
    for (int n = 0; n < 3; ++n)
#pragma unroll
      for (int r = 0; r < 4; ++r) lg[((lane >> 4) * 4 + r) * 49 + 16 * n + (lane & 15)] = acc[n][r];
    __syncthreads();
    int e1 = 0, e2 = 0, lp1 = 0, lp2 = 0; float g1 = 0.f, g2 = 0.f, rsk = 0.f; const int tok = r0 + lane;
    if (lane < 16) {
      const float rs = rsqrtf(hsq * (1.f / 1024.f) + EPS);
      RS2[tok] = rs; rsk = rs;
      float gl[4]; int gs = 0;
#pragma unroll
      for (int i = 0; i < 4; ++i) gl[i] = lg[lane * 49 + i] * rs + gbias[i];
#pragma unroll
      for (int i = 1; i < 4; ++i) if (gl[i] > gl[gs]) gs = i;
      float den = 0.f;
#pragma unroll
      for (int i = 0; i < 4; ++i) den += __expf(gl[i] - gl[gs]);
      const float pg = 1.f / den;
      float el[8];
#pragma unroll
      for (int i = 0; i < 8; ++i) el[i] = lg[lane * 49 + 4 + gs * 8 + i] * rs + ebias[gs * 8 + i];
      int i1 = 0;
#pragma unroll
      for (int i = 1; i < 8; ++i) if (el[i] > el[i1]) i1 = i;
      int i2 = (i1 == 0) ? 1 : 0;
#pragma unroll
      for (int i = 0; i < 8; ++i) if (i != i1 && el[i] > el[i2]) i2 = i;
      const float t = __expf(el[i2] - el[i1]);
      g1 = pg / (1.f + t); g2 = pg * t / (1.f + t);
      e1 = gs * 8 + i1; e2 = gs * 8 + i2;
      lp1 = atomicAdd((int*)(hist + e1), 1); lp2 = atomicAdd((int*)(hist + e2), 1);
    }
    __syncthreads();
    if (tid < 32) { const int hc = hist[tid]; basee[tid] = hc ? atomicAdd(cnt + tid, hc) : 0; }
    __syncthreads();
    if (lane < 16) {
      const int p1 = e1 * ECAP + basee[e1] + lp1, p2 = e2 * ECAP + basee[e2] + lp2;
      LTOK[p1] = tok * 2; LGATE[p1] = g1; LTOK[p2] = tok * 2 + 1; LGATE[p2] = g2;
      float* LRS2 = (float*)(p.ws + WS_LRS2); LRS2[p1] = rsk; LRS2[p2] = rsk;
    }
    __syncthreads();
  }
}

__device__ __forceinline__ void final_phase(const Params& p, int G, int vb, float pc1, float pc2) {
  const int lane = threadIdx.x & 63, wave = threadIdx.x >> 6;
  const float* fw = p.in[20]; const unsigned char* Y8 = p.ws + WS_PROJ; const unsigned char* SC8 = p.ws + WS_SC8; const bf16_t* HB = (const bf16_t*)(p.ws + WS_XB);
  const int sh = 8 * (lane >> 4);
  for (int m = vb * 8 + wave; m < NTOK; m += G * 8) {
    f32x4* orow = (f32x4*)(p.out + (size_t)m * DM) + lane;
    f32x4 v[4]; float s = 0.f;
#if ENABLE_MOE
    const u32x4 sca = *(const u32x4*)(SC8 + (size_t)(2 * m) * 16), scb = *(const u32x4*)(SC8 + (size_t)(2 * m + 1) * 16);
    const unsigned scaw[4] = {sca.x, sca.y, sca.z, sca.w}, scbw[4] = {scb.x, scb.y, scb.z, scb.w};
#endif
#pragma unroll
    for (int j = 0; j < 4; ++j) {
      const u32x2 hh = __builtin_nontemporal_load((const u32x2*)(HB + (size_t)m * 1024) + lane + 64 * j);
      v[j] = (f32x4){bflo(hh.x), bfhi(hh.x), bflo(hh.y), bfhi(hh.y)};
#if ENABLE_MOE
      const int a = __builtin_nontemporal_load((const int*)(Y8 + (size_t)(2 * m) * 1024) + lane + 64 * j), b = __builtin_nontemporal_load((const int*)(Y8 + (size_t)(2 * m + 1) * 1024) + lane + 64 * j);
      const float fa = ldexpf(1.f, (int)((scaw[j] >> sh) & 0xffu) - 136), fb = ldexpf(1.f, (int)((scbw[j] >> sh) & 0xffu) - 136);
      v[j].x += __builtin_amdgcn_cvt_f32_fp8(a, 0) * fa + __builtin_amdgcn_cvt_f32_fp8(b, 0) * fb;
      v[j].y += __builtin_amdgcn_cvt_f32_fp8(a, 1) * fa + __builtin_amdgcn_cvt_f32_fp8(b, 1) * fb;
      v[j].z += __builtin_amdgcn_cvt_f32_fp8(a, 2) * fa + __builtin_amdgcn_cvt_f32_fp8(b, 2) * fb;
      v[j].w += __builtin_amdgcn_cvt_f32_fp8(a, 3) * fa + __builtin_amdgcn_cvt_f32_fp8(b, 3) * fb;
#endif
      s += (v[j].x * v[j].x + v[j].y * v[j].y) + (v[j].z * v[j].z + v[j].w * v[j].w);
    }
    s = wave_sum(s);
    const float rs = rsqrtf(s * (1.f / DM) + EPS);
#pragma unroll
    for (int j = 0; j < 4; ++j) { const f32x4 w = *((const f32x4*)fw + lane + 64 * j); f32x4 o = v[j] * rs * w;
#ifdef PROBE_T1
      o = o + pc1;
#endif
      __builtin_nontemporal_store(o, orow + 64 * j); }
  }
}


#define XB_TMO      128
#define XB_XCNT(j)  (256  + 64 * (j))
#define XB_XSUB(j)  (1280 + 64 * (j))
#define XB_XGEN(j)  (2304 + 64 * (j))
#define XB_TOP      3328
#define XB_TOPGEN   3392
#define XB2_XSUB(j) (3456 + 64 * (j))
#define XB2_TOP     4480
#define XB2_TOPGEN  4544
#define XB_LSUB(j)  (5888 + 64 * (j))
#define XB_LSUB2(j) (6912 + 64 * (j))
#define XB_SPIN_CAP (1u << 22)
__device__ __forceinline__ unsigned xb_ld(unsigned* p)              { return __hip_atomic_load(p, __ATOMIC_RELAXED, __HIP_MEMORY_SCOPE_AGENT); }
__device__ __forceinline__ unsigned xb_add(unsigned* p, unsigned v) { return __hip_atomic_fetch_add(p, v, __ATOMIC_RELAXED, __HIP_MEMORY_SCOPE_AGENT); }
__device__ __forceinline__ unsigned xb_xcc_id() { return (unsigned)__builtin_amdgcn_s_getreg((3 << 11) | 20) & 0xFu; }
#define XB_SPIN(cond, bar) do { unsigned _sp = 0; while (cond) { __builtin_amdgcn_s_sleep(1); \
    if ((++_sp & 255u) == 0u) { if (xb_ld(&(bar)[XB_TMO])) break; if (_sp > XB_SPIN_CAP) { atomicAdd(&(bar)[XB_TMO], 1u); break; } } } } while (0)
struct XcdBarrier { unsigned* bar; unsigned x; volatile LAS unsigned* st; };
__device__ __forceinline__ XcdBarrier xcd_barrier_post(unsigned* bar, volatile LAS unsigned* st) {
  XcdBarrier b; b.bar = bar; b.x = xb_xcc_id(); b.st = st;
  if (threadIdx.x == 0) st[2] = xb_add(&bar[XB_XCNT(b.x)], 1u);
  return b;
}
__device__ __forceinline__ void xcd_barrier_complete(unsigned* bar, unsigned x, unsigned& nloc, unsigned& nx) {
  const unsigned G = gridDim.x * gridDim.y * gridDim.z;
  unsigned sum, cnt, mine, sp = 0u;
  for (;;) {
    sum = 0u; cnt = 0u; mine = 0u;
#pragma unroll
    for (unsigned j = 0; j < 16; ++j) { const unsigned c = xb_ld(&bar[XB_XCNT(j)]); sum += c; cnt += (c > 0u) ? 1u : 0u; mine = (j == x) ? c : mine; }
    if (sum == G) break;
    __builtin_amdgcn_s_sleep(1);
    if ((++sp & 255u) == 0u) { if (xb_ld(&bar[XB_TMO])) break; if (sp > XB_SPIN_CAP) { atomicAdd(&bar[XB_TMO], 1u); break; } }
  }
  nloc = mine > 0u ? mine : 1u; nx = cnt > 0u ? cnt : 1u;
}
__device__ __forceinline__ void xcd_barrier(const XcdBarrier& b) {
  asm volatile("s_waitcnt vmcnt(0)" ::: "memory");
  __syncthreads();
  if (threadIdx.x == 0) {
    unsigned* bar = b.bar;
    __builtin_amdgcn_s_waitcnt(0);
    unsigned nloc = b.st[0], nx = b.st[1];
    if (nloc == 0u) { xcd_barrier_complete(bar, b.x, nloc, nx); b.st[0] = nloc; b.st[1] = nx; }
    const unsigned old = xb_add(&bar[XB_XSUB(b.x)], 1u);
    const unsigned gen = b.st[4]; b.st[4] = gen + 1u;
    if (old + 1u == (gen + 1u) * nloc) {
      __builtin_amdgcn_fence(__ATOMIC_RELEASE, "agent");
      asm volatile("s_waitcnt vmcnt(0)" ::: "memory");
      const unsigned og = xb_add(&bar[XB_TOP], 1u);
      const unsigned tg = gen;
      if (og + 1u == (tg + 1u) * nx) xb_add(&bar[XB_TOPGEN], 1u);
      else XB_SPIN(xb_ld(&bar[XB_TOPGEN]) == tg, bar);
      xb_add(&bar[XB_XGEN(b.x)], 1u);
      __builtin_amdgcn_fence(__ATOMIC_ACQUIRE, "agent");
      asm volatile("s_waitcnt vmcnt(0)" ::: "memory");
    } else {
      XB_SPIN(xb_ld(&bar[XB_XGEN(b.x)]) == gen, bar);
      __builtin_amdgcn_fence(__ATOMIC_ACQUIRE, "agent");
      asm volatile("s_waitcnt vmcnt(0)" ::: "memory");
    }
  }
  __syncthreads();
}

__device__ __forceinline__ void xcd_arrive2(const XcdBarrier& b) {
  asm volatile("s_waitcnt vmcnt(0)" ::: "memory");
  __syncthreads();
  if (threadIdx.x == 0) {
    unsigned* bar = b.bar;
    const unsigned nloc = b.st[0], nx = b.st[1];
    const unsigned old = xb_add(&bar[XB2_XSUB(b.x)], 1u);
    if (old + 1u == nloc) {
      __builtin_amdgcn_fence(__ATOMIC_RELEASE, "agent");
      asm volatile("s_waitcnt vmcnt(0)" ::: "memory");
      const unsigned og = xb_add(&bar[XB2_TOP], 1u);
      if (og + 1u == nx) xb_add(&bar[XB2_TOPGEN], 1u);
    }
  }
}
__device__ __forceinline__ void xcd_wait2(const XcdBarrier& b) {
  if (threadIdx.x == 0) {
    unsigned* bar = b.bar;
    XB_SPIN(xb_ld(&bar[XB2_TOPGEN]) == 0u, bar);
    __builtin_amdgcn_fence(__ATOMIC_ACQUIRE, "agent");
    asm volatile("s_waitcnt vmcnt(0)" ::: "memory");
  }
  __syncthreads();
}

__device__ __forceinline__ void xcd_local_barrier(const XcdBarrier& b) {
  asm volatile("s_waitcnt vmcnt(0)" ::: "memory");
  __syncthreads();
  if (threadIdx.x == 0) {
    unsigned* bar = b.bar;
    const unsigned gen = b.st[6]; b.st[6] = gen + 1u; const unsigned nloc = b.st[0];
    xb_add(&bar[XB_LSUB(b.x)], 1u);
    XB_SPIN(xb_ld(&bar[XB_LSUB(b.x)]) < (gen + 1u) * nloc, bar);
    __builtin_amdgcn_fence(__ATOMIC_ACQUIRE, "agent");
    asm volatile("s_waitcnt vmcnt(0)" ::: "memory");
  }
  __syncthreads();
}
__device__ __forceinline__ void xcd_local_arrive2(const XcdBarrier& b) {
  asm volatile("s_waitcnt vmcnt(0)" ::: "memory");
  __syncthreads();
  if (threadIdx.x == 0) xb_add(&b.bar[XB_LSUB2(b.x)], 1u);
}
__device__ __forceinline__ void xcd_local_wait2(const XcdBarrier& b) {
  if (threadIdx.x == 0) { unsigned* bar = b.bar; const unsigned nloc = b.st[0]; XB_SPIN(xb_ld(&bar[XB_LSUB2(b.x)]) < nloc, bar);
    __builtin_amdgcn_fence(__ATOMIC_ACQUIRE, "agent"); asm volatile("s_waitcnt vmcnt(0)" ::: "memory"); }
  __syncthreads();
}

constexpr int LDS_CTL = 131072;
constexpr int LDS_BYTES = 131072 + 1024 + 8192;

__global__ void __launch_bounds__(512) fwd(Params p, int ph_lo, int ph_hi) {
  extern __shared__ __attribute__((aligned(16))) unsigned char lds_raw[];
  LAS unsigned char* lds = (LAS unsigned char*)lds_raw;
  cg::grid_group grid = cg::this_grid();
  const int G = gridDim.x, bx = blockIdx.x;
  int vb = bx;
  int crr = bx;
  unsigned char* ws = p.ws;
#ifndef PHMASK
#define PHMASK 0x3ff
#endif
#define PH(k) (((PHMASK >> (k)) & 1) && ph_lo <= (k) && (k) < ph_hi)
#ifdef PROBE_T1
  LAS unsigned long long* tsx = (LAS unsigned long long*)(lds + LDS_CTL + 512);
  if (threadIdx.x == 0) tsx[0] = __builtin_amdgcn_s_memrealtime();
#define SEAM(k) do { if (PH(k) && PH((k) + 1)) grid.sync(); if (threadIdx.x == 0) tsx[(k) + 1] = __builtin_amdgcn_s_memrealtime(); } while (0)
#else
#define SEAM(k) do { if (PH(k) && PH((k) + 1)) xcd_barrier(xbar); } while (0)
#endif
  volatile LAS unsigned* xst = (volatile LAS unsigned*)(lds + LDS_CTL + 768);
  if (threadIdx.x == 0) { xst[0] = 0u; xst[1] = 0u; xst[4] = 0u; xst[6] = 0u; xst[7] = 0u; }
  XcdBarrier xbar = xcd_barrier_post((unsigned*)(ws + WS_BAR), xst);
  if (PH(0)) for (int rep = 0; rep < ((REPEAT_PHASE == 0) ? 2 : 1); ++rep) { if (rep) grid.sync(); p0_prologue(p, lds, G, vb); }
  SEAM(0);
  {
    volatile LAS unsigned* xs = xst;
    if (threadIdx.x == 0) { unsigned pre = 0u, okc = 0u, bad = 0u;
      for (unsigned j = 0; j < 16; ++j) { const unsigned c_ = xb_ld(&xbar.bar[XB_XCNT(j)]); if (j < xbar.x) pre += c_; if (c_ == 32u) ++okc; else if (c_ != 0u) bad = 1u; }
      xs[3] = pre + xs[2]; xs[7] = (G == 256 && okc == 8u && !bad) ? 1u : 0u; }
    __syncthreads();
    if (G % 8 == 0) { vb = (int)xs[3]; if (vb >= G) vb = bx; const int per = G / 8; crr = (vb % per) * 8 + vb / per; }
  }
  const bool xlocal = (xst[7] != 0u);
#define SEAML(k) do { if (PH(k) && PH((k) + 1)) { if (xlocal) xcd_local_barrier(xbar); else xcd_barrier(xbar); } } while (0)
  if (PH(1)) for (int rep = 0; rep < NREP(1); ++rep) {
    if (rep) grid.sync();
    g8::DenseSched S; S.init(ws + WS_XB, 1024, ws + WS_WIN, 1024, NTOK, NP, G, crr);
    EpiInproj E{(bf16_t*)(ws + WS_PROJ), (const float*)(ws + WS_RS1), (float*)(ws + WS_SSQP), (const f32x2*)(ws + WS_CS)};
    g8::gemm_phase(lds, 1024, S, E);
    if (G == 256 && crr >= 128 && rep == 0) {
      LAS float* scr = (LAS float*)(lds + (threadIdx.x >> 6) * 8704);
      for (int r = (crr - 128) * 8 + (threadIdx.x >> 6); r < CONV_GU_P1; r += 1024) conv_gu_item(p, CONV_GU_P0 + r, scr, threadIdx.x & 63);
      for (int r = (crr - 128) * 8 + (threadIdx.x >> 6); r < CONV_D_P1; r += 1024) conv_d_item(p, r, scr, threadIdx.x & 63);
      __syncthreads();
    }
  }
  SEAML(1);
  const bool split23 = (G == 256);
  const int Gg = split23 ? 224 : G;
#define P2_GEMMS(DRY) do { \
    { g8::DenseSched S; S.init((const bf16_t*)(ws + WS_PROJ) + CQ_OFF, NP, ws + WS_WUQ, 384, NTOK, 768, Gg, crr); \
      EpiUq E{(bf16_t*)(ws + WS_QB), (const float*)(ws + WS_SSQP), (const f32x2*)(ws + WS_CS), DRY}; \
      g8::gemm_phase(lds, 384, S, E); } \
    { g8::DenseSched S; S.init((const bf16_t*)(ws + WS_PROJ) + CKV_OFF, NP, ws + WS_WUKV, 256, NTOK, 1024, Gg, split23 ? (crr + 64) % 224 : crr);     \
      EpiUkv E{(bf16_t*)(ws + WS_KVB), (const float*)(ws + WS_SSQP), DRY}; \
      g8::gemm_phase(lds, 256, S, E); } } while (0)
#define P2_GLA() gla_a_phase(p, lds, G, vb)
#define P4_GLA() gla_c_phase<0>(p, lds, G, vb, 0, 1 << 20)
  if (PH(2)) {
#if ENABLE_GLA
    P2_GLA();
#endif
#if REPEAT_PHASE == 2
    grid.sync();
    P2_GLA();
#endif
  }
  if (PH(2) && PH(3)) {
    if (xlocal) { xcd_local_arrive2(xbar); if (crr >= 224) xcd_local_wait2(xbar); }
    else { xcd_arrive2(xbar); if (!(G == 256) || crr >= 224) xcd_wait2(xbar); } }
  if (PH(3)) {
#if ENABLE_MLA
    if (!split23 || crr < 224) P2_GEMMS(false);
#endif
#if ENABLE_GLA
    if (!split23) gla_scan(p, G, vb);
    else if (crr >= 224) {
      gla_scan_block(p, lds, 4 * (crr & 7) + ((crr - 224) >> 3));
      LAS float* scr_ = (LAS float*)(lds + (threadIdx.x >> 6) * 8704);
      for (int r_ = (crr - 224) * 8 + (threadIdx.x >> 6); r_ < CONV_GU_P2; r_ += 256) conv_gu_item(p, CONV_GU_P0 + CONV_GU_P1 + r_, scr_, threadIdx.x & 63);
      for (int r_ = CONV_D_P1 + (crr - 224) * 8 + (threadIdx.x >> 6); r_ < 4096; r_ += 256) conv_d_item(p, r_, scr_, threadIdx.x & 63);
      __syncthreads();
    }
#endif
#if REPEAT_PHASE == 3
    grid.sync();
    if ((REPEAT_SUB & 1) && (!split23 || crr < 224)) P2_GEMMS(true);
    if ((REPEAT_SUB & 2) && split23 && crr >= 224) {
      gla_scan_block(p, lds, crr - 224);
      if (REPEAT_SUB & 4) { LAS float* scr_ = (LAS float*)(lds + (threadIdx.x >> 6) * 8704);
      for (int r_ = (crr - 224) * 8 + (threadIdx.x >> 6); r_ < CONV_GU_P2; r_ += 256) conv_gu_item(p, CONV_GU_P0 + CONV_GU_P1 + r_, scr_, threadIdx.x & 63);
      for (int r_ = CONV_D_P1 + (crr - 224) * 8 + (threadIdx.x >> 6); r_ < 4096; r_ += 256) conv_d_item(p, r_, scr_, threadIdx.x & 63);
      __syncthreads(); }
    }
#endif
  }
  SEAML(3);
  if (PH(4)) {
#if ENABLE_MLA && ENABLE_GLA
    if (G == 256) {
      const int bh = vb >> 2, s4 = vb & 3;
      const int odd = vb & 1;
#pragma unroll 1
      for (int k = 0; k < 6; ++k) {
        const int g0 = (s4 >> 1) + (s4 & 1), g1 = g0 + 3;
        if (k == g0) gla_c_phase<0>(p, lds, G, vb, 0, 4);
        else if (k == g1) gla_c_phase<0>(p, lds, G, vb, 4, 8);
        else { const int i = k - (k > g0) - (k > g1); const int qb = (i == 0) ? 15 - s4 : (i == 1) ? 8 + s4 : (i == 2) ? 7 - s4 : s4; attn_unit<0>(p, lds, bh >> 3, bh & 7, qb); } }
      (void)odd;
    } else { attn_phase<0>(p, lds, G, vb); P4_GLA(); }
#elif ENABLE_MLA
    attn_phase<0>(p, lds, G, vb);
#else
    { u32x4* Yz = (u32x4*)(ws + WS_Y); for (int i = vb * 512 + threadIdx.x; i < NTOK * 64; i += G * 512) Yz[(size_t)(i >> 6) * 128 + 64 + (i & 63)] = (u32x4){0u, 0u, 0u, 0u}; }
#endif
#if ENABLE_GLA && !ENABLE_MLA
    P4_GLA();
#endif
#if REPEAT_PHASE == 4
    grid.sync();
#ifndef ATTN_PROBE_MODE
#define ATTN_PROBE_MODE 0
#endif
    if (REPEAT_SUB & 1) attn_phase<ATTN_PROBE_MODE>(p, lds, G, vb);
#ifndef GLA_PROBE_MODE
#define GLA_PROBE_MODE 0
#endif
    if (REPEAT_SUB & 2) gla_c_phase<GLA_PROBE_MODE>(p, lds, G, vb, 0, 1 << 20);
#endif
  }
  SEAML(4);
  if (PH(5)) for (int rep = 0; rep < NREP(5); ++rep) {
    if (rep) grid.sync();
    g8::DenseSchedG S; S.init(ws + WS_Y, 512, ws + WS_WOUT, 512, NTOK, 1024, G, crr);
    EpiWout E{p.in[0], (bf16_t*)(ws + WS_XB), ws + WS_H8};
    g8::gemm_phase<W_OUT_F8MODE>(lds, 512, S, E);
  }
  SEAML(5);
#if ENABLE_MOE
  if (PH(6)) router_phase(p, lds, G, vb);
  SEAM(6);
  if (PH(7) || PH(8)) {
    LAS int* tb = (LAS int*)(lds + LDS_CTL); LAS int* cn = (LAS int*)(lds + LDS_CTL + 256);
    if (threadIdx.x == 0) { const int* cnt = (const int*)(ws + WS_CNT); int acc = 0;
      for (int e = 0; e < NEXP; ++e) { const int c = cnt[e]; cn[e] = c; tb[e] = acc; acc += (c + 255) >> 8; }
      tb[NEXP] = acc; }
    __syncthreads();
    const int T = tb[NEXP];
    if (PH(7)) for (int rep = 0; rep < NREP(7); ++rep) {
      if (rep) grid.sync();
#if MOE_FP8
      MoeSched<true> S; S.A = (const char*)(ws + WS_H8); S.B = (const char*)(ws + WS_WGU); S.lda = 512; S.ldb = 512; S.ncol = 2; S.total = T * 2; S.G = G; S.c = vb;
      S.tb = tb; S.cn = cn; S.ltok = (const int*)(ws + WS_LTOK); S.bstride = (size_t)512 * 1024; S.n1 = 0; S.r = 0; S.flg = nullptr;
#else
      MoeSched<true> S; S.A = (const char*)(ws + WS_XB); S.B = (const char*)(ws + WS_WGU); S.lda = 1024; S.ldb = 1024; S.ncol = 2; S.total = T * 2; S.G = G; S.c = vb;
      S.tb = tb; S.cn = cn; S.ltok = (const int*)(ws + WS_LTOK); S.bstride = (size_t)512 * 1024 * 2; S.n1 = 0; S.r = 0; S.flg = nullptr;
#endif
      EpiGU E{(bf16_t*)(ws + WS_QB), (const float*)(ws + WS_LRS2), (const int*)(ws + WS_LTOK), cn, rep > 0 && P8_DRY, (int*)(ws + WS_FLG)};
      g8::gemm_phase<MOE_FP8 ? 2 : 0>(lds, MOE_FP8 ? 512 : 1024, S, E);
    }
    if (PH(8)) for (int rep = 0; rep < NREP(8); ++rep) {
      if (rep) grid.sync();
#if MOE_FP8
      MoeSched<false> S; S.A = (const char*)(ws + WS_QB); S.B = (const char*)(ws + WS_WD); S.lda = 128; S.ldb = 128; S.ncol = 4; S.total = T * 4; S.G = G; S.c = vb;
      S.tb = tb; S.cn = cn; S.ltok = (const int*)(ws + WS_LTOK); S.bstride = (size_t)1024 * 256;
#else
      MoeSched<false> S; S.A = (const char*)(ws + WS_QB); S.B = (const char*)(ws + WS_WD); S.lda = 256; S.ldb = 256; S.ncol = 4; S.total = T * 4; S.G = G; S.c = vb;
      S.tb = tb; S.cn = cn; S.ltok = (const int*)(ws + WS_LTOK); S.bstride = (size_t)1024 * 256 * 2;
#endif
      { const int rr_ = (T * 2) % G, n0_ = (T * 4 + 2 * rr_ + G - 1) / G; S.r = rr_; S.n1 = n0_ > 2 ? n0_ - 2 : 0; S.flg = (const int*)(ws + WS_FLG); }
      EpiDown E{ws + WS_PROJ, ws + WS_SC8, (const int*)(ws + WS_LTOK), (const float*)(ws + WS_LGATE), cn, rep > 0 && P8_DRY};
      g8::gemm_phase<MOE_FP8 ? 1 : 0>(lds, MOE_FP8 ? 128 : 256, S, E);
    }
  }
  SEAM(8);
#endif
#ifdef PROBE_T1
  __syncthreads();
  const float probe_c1 = 0.1f * log2f((float)(tsx[PROBE_T1 + 1] - tsx[PROBE_T1]) * 0.01f), probe_c2 = 0.f;
  if (PH(9)) final_phase(p, G, vb, probe_c1, probe_c2);
#else
#ifdef EXTRA_SYNCS
  for (int i = 0; i < EXTRA_SYNCS; ++i) grid.sync();
#endif
  if (PH(9)) final_phase(p, G, vb, 0.f, 0.f);
#endif
#undef PH
#undef SEAM
#undef SEAML
}

extern "C" void kernel_launch(void* const* d_in, const int* in_sizes, int n_in, void* d_out, int out_size,
                              void* d_ws, size_t ws_size, hipStream_t stream) {
  static int grid_blocks = 0;
  if (grid_blocks == 0) {
    if (n_in != 21 || ws_size < WS_END) { fprintf(stderr, "kernel_launch: unexpected n_in %d or ws_size %zu (< %zu)\n", n_in, ws_size, (size_t)WS_END); grid_blocks = -1; return; }
    int dev = 0, cus = 0, per_cu = 0;
    hipGetDevice(&dev);
    hipDeviceGetAttribute(&cus, hipDeviceAttributeMultiprocessorCount, dev);
    hipFuncSetAttribute((const void*)fwd, hipFuncAttributeMaxDynamicSharedMemorySize, LDS_BYTES);
    hipOccupancyMaxActiveBlocksPerMultiprocessor(&per_cu, (const void*)fwd, 512, LDS_BYTES);
    if (per_cu < 1) { fprintf(stderr, "kernel_launch: occupancy query says %d blocks/CU\n", per_cu); per_cu = 1; }
    grid_blocks = cus;
  }
  if (grid_blocks < 0) return;
  Params p{};
  for (int i = 0; i < 21; ++i) p.in[i] = (const float*)d_in[i];
  p.out = (float*)d_out; p.ws = (unsigned char*)d_ws;
  int lo = 0, hi = 10;
  void* args[] = {&p, &lo, &hi};
  hipMemsetAsync((unsigned char*)d_ws + WS_BAR, 0, XCD_BAR_WORDS * sizeof(unsigned), stream);
  hipError_t e = hipLaunchCooperativeKernel((void*)fwd, dim3(grid_blocks), dim3(512), args, LDS_BYTES, stream);
  if (e != hipSuccess) fprintf(stderr, "cooperative launch failed: %s (grid %d)\n", hipGetErrorString(e), grid_blocks);
}
```
